# Optimizing an MI355X kernel written in HIP

```python
import math
import jax, jax.numpy as jnp
from jax import lax
import numpy as np

D_MODEL = 2048
BATCH = 8
SEQ = 4096
DEPTH = 4
DEC_BATCH = 4
DEC_SEQ = 4096
PAST_LEN = 128

N_MIXERS = 2
MIX_WIDTH = 3 * D_MODEL // 4
MEM_WIDTH = D_MODEL // 4
HEAD_DIM = 128
N_Q_HEADS = MIX_WIDTH // HEAD_DIM
N_KV_HEADS = 4
GQA_GROUP = N_Q_HEADS // N_KV_HEADS
KV_WIDTH = N_KV_HEADS * HEAD_DIM
WINDOW = 128
BLOCK = 128
ROPE_THETA = 10000.0
N_MEM = 256
N_MEM_HEADS = 4
MEM_HEAD_DIM = MEM_WIDTH // N_MEM_HEADS
SSM_GROUP = 16
SSM_GROUPS = MIX_WIDTH // SSM_GROUP
SSM_STATE = 64
SSM_CHUNK = 128
D_FF = 4 * D_MODEL
ALPHA = (2 * DEPTH) ** 0.25
BETA = (8 * DEPTH) ** -0.25
N_SSM_LAYERS = (DEPTH + 1) // 2
N_ATTN_LAYERS = DEPTH // 2
LN_EPS = 1e-5

kernel_name = 'hybrid_s5_window_gqa_memory_encoder'


def layer_norm(x, g, b):
    xf = x.astype(jnp.float32)
    mu = xf.mean(-1, keepdims=True)
    var = jnp.mean(jnp.square(xf - mu), -1, keepdims=True)
    return ((xf - mu) * lax.rsqrt(var + LN_EPS) * g.astype(jnp.float32) + b.astype(jnp.float32)).astype(x.dtype)


def _ssm_combine(left, right):
    a_l, b_l = left
    a_r, b_r = right
    return a_r * a_l, a_r * b_l + b_r


def s5_scan(u, lam_re, lam_im, log_dt, b_re, b_im, c_re, c_im):
    bsz, L = u.shape[0], u.shape[1]
    f32 = jnp.float32
    lam = lax.complex(lam_re.astype(f32), lam_im.astype(f32))
    dt = jnp.exp(log_dt.astype(f32))[:, None]
    lam_bar = jnp.exp(lam * dt)
    b_bar = ((lam_bar - 1.0) / lam)[..., None] * lax.complex(b_re.astype(f32), b_im.astype(f32))
    cmat = lax.complex(c_re.astype(f32), c_im.astype(f32))
    n_chunks = L // SSM_CHUNK
    uc = u.astype(f32).reshape(bsz, n_chunks, SSM_CHUNK, SSM_GROUPS, SSM_GROUP).swapaxes(0, 1)

    def step(carry, u_blk):
        bu = jnp.einsum('gpc,btgc->btgp', b_bar, u_blk)
        a = jnp.broadcast_to(lam_bar, bu.shape)
        a_cum, h = lax.associative_scan(_ssm_combine, (a, bu), axis=1)
        h = h + a_cum * carry[:, None]
        y = jnp.einsum('gcp,btgp->btgc', cmat, h).real
        return h[:, -1], y

    carry0 = jnp.zeros((bsz, SSM_GROUPS, SSM_STATE), jnp.complex64)
    _, ys = lax.scan(step, carry0, uc)
    return ys.swapaxes(0, 1).reshape(bsz, L, SSM_GROUPS, SSM_GROUP)


def s5_mixer(u, lam_re, lam_im, log_dt, b_re, b_im, c_re, c_im, d_skip, w_glu):
    bsz, L, _ = u.shape
    ug = u.reshape(bsz, L, SSM_GROUPS, SSM_GROUP)
    y_f = s5_scan(ug, lam_re[0], lam_im[0], log_dt[0], b_re[0], b_im[0], c_re[0], c_im[0])
    y_b = jnp.flip(s5_scan(jnp.flip(ug, 1), lam_re[1], lam_im[1], log_dt[1],
                           b_re[1], b_im[1], c_re[1], c_im[1]), 1)
    y = (y_f + y_b).reshape(bsz, L, MIX_WIDTH) + d_skip.astype(jnp.float32) * u.astype(jnp.float32)
    z = jax.nn.gelu(y).astype(u.dtype)
    a, g = jnp.split(z @ w_glu, 2, axis=-1)
    return a * jax.nn.sigmoid(g)


def rope_tables(L):
    inv_freq = ROPE_THETA ** (-jnp.arange(0, HEAD_DIM, 2, dtype=jnp.float32) / HEAD_DIM)
    ang = jnp.arange(L, dtype=jnp.float32)[:, None] * inv_freq[None, :]
    return jnp.cos(ang), jnp.sin(ang)


def apply_rope(x, cos, sin):
    x1, x2 = jnp.split(x.astype(jnp.float32), 2, axis=-1)
    c = cos[None, :, None, :]
    s = sin[None, :, None, :]
    return jnp.concatenate([x1 * c - x2 * s, x2 * c + x1 * s], axis=-1).astype(x.dtype)


def windowed_gqa(q, k, v, sink):
    bsz, L = q.shape[0], q.shape[1]
    nb = L // BLOCK
    qb = q.reshape(bsz, nb, BLOCK, N_KV_HEADS, GQA_GROUP, HEAD_DIM)

    def band(t):
        tb = t.reshape(bsz, nb, BLOCK, N_KV_HEADS, HEAD_DIM)
        tp = jnp.pad(tb, ((0, 0), (1, 1), (0, 0), (0, 0), (0, 0)))
        return jnp.concatenate([tp[:, :-2], tp[:, 1:-1], tp[:, 2:]], axis=2)

    kb, vb = band(k), band(v)
    s = jnp.einsum('bnqhgd,bnkhd->bnhgqk', qb, kb, preferred_element_type=jnp.float32) * (HEAD_DIM ** -0.5)
    qpos = jnp.arange(L).reshape(nb, BLOCK)
    kpos = (jnp.arange(nb)[:, None] - 1) * BLOCK + jnp.arange(3 * BLOCK)[None, :]
    rel = kpos[:, None, :] - qpos[:, :, None]
    valid = (jnp.abs(rel) <= WINDOW) & (kpos[:, None, :] >= 0) & (kpos[:, None, :] < L)
    s = jnp.where(valid[None, :, None, None], s, -1e30)
    sk = sink.astype(jnp.float32).reshape(N_KV_HEADS, GQA_GROUP)[None, None, :, :, None, None]
    m = jnp.maximum(s.max(-1, keepdims=True), sk)
    p = jnp.exp(s - m)
    p = p / (p.sum(-1, keepdims=True) + jnp.exp(sk - m))
    o = jnp.einsum('bnhgqk,bnkhd->bnqhgd', p.astype(v.dtype), vb)
    return o.reshape(bsz, L, N_Q_HEADS * HEAD_DIM)


def memory_attention(qm, mem, w_mem_kv):
    bsz, L = qm.shape[0], qm.shape[1]
    q = qm.reshape(bsz, L, N_MEM_HEADS, MEM_HEAD_DIM)
    k, v = jnp.split(mem @ w_mem_kv, 2, axis=-1)
    k = k.reshape(bsz, N_MEM, N_MEM_HEADS, MEM_HEAD_DIM)
    v = v.reshape(bsz, N_MEM, N_MEM_HEADS, MEM_HEAD_DIM)
    s = jnp.einsum('bqhd,bkhd->bhqk', q, k, preferred_element_type=jnp.float32) * (MEM_HEAD_DIM ** -0.5)
    p = jax.nn.softmax(s, axis=-1)
    o = jnp.einsum('bhqk,bkhd->bqhd', p.astype(v.dtype), v)
    return o.reshape(bsz, L, MEM_WIDTH)


def trunk(x, mem, ssm_w_in, ssm_lam_re, ssm_lam_im, ssm_log_dt, ssm_b_re, ssm_b_im,
          ssm_c_re, ssm_c_im, ssm_d, ssm_w_glu, attn_w_in, attn_sink, w_mem_kv, w_out,
          ln1_g, ln1_b, w_ff1, w_ff2, ln2_g, ln2_b):
    L = x.shape[1]
    cos, sin = rope_tables(L)
    bsz = x.shape[0]
    for i in range(DEPTH):
        j = i // N_MIXERS
        if i % N_MIXERS == 0:
            proj = x @ ssm_w_in[j]
            u, qm = proj[..., :MIX_WIDTH], proj[..., MIX_WIDTH:]
            y_mix = s5_mixer(u, ssm_lam_re[j], ssm_lam_im[j], ssm_log_dt[j], ssm_b_re[j], ssm_b_im[j],
                             ssm_c_re[j], ssm_c_im[j], ssm_d[j], ssm_w_glu[j])
        else:
            proj = x @ attn_w_in[j]
            q = proj[..., :MIX_WIDTH].reshape(bsz, L, N_Q_HEADS, HEAD_DIM)
            k = proj[..., MIX_WIDTH:MIX_WIDTH + KV_WIDTH].reshape(bsz, L, N_KV_HEADS, HEAD_DIM)
            v = proj[..., MIX_WIDTH + KV_WIDTH:MIX_WIDTH + 2 * KV_WIDTH].reshape(bsz, L, N_KV_HEADS, HEAD_DIM)
            qm = proj[..., MIX_WIDTH + 2 * KV_WIDTH:]
            y_mix = windowed_gqa(apply_rope(q, cos, sin), apply_rope(k, cos, sin), v, attn_sink[j])
        y_mem = memory_attention(qm, mem, w_mem_kv[i])
        mix = jnp.concatenate([y_mix.astype(x.dtype), y_mem.astype(x.dtype)], axis=-1) @ w_out[i]
        x = layer_norm(ALPHA * x + mix, ln1_g[i], ln1_b[i])
        h = jnp.square(jax.nn.relu(x @ w_ff1[i]))
        x = layer_norm(ALPHA * x + h @ w_ff2[i], ln2_g[i], ln2_b[i])
    return x


def setup_inputs(seed: int = 0) -> dict:
    key = jax.random.key(seed)
    ks = iter(jax.random.split(key, 32))
    f32 = jnp.float32

    def nrm(shape, scale):
        return jax.random.normal(next(ks), shape, f32) * scale

    nS, nA, G, P, C = N_SSM_LAYERS, N_ATTN_LAYERS, SSM_GROUPS, SSM_STATE, SSM_GROUP
    inp = {}
    inp['x_prompt'] = nrm((BATCH, SEQ, D_MODEL), 1.0)
    inp['x_sample'] = nrm((DEC_BATCH, DEC_SEQ, D_MODEL), 1.0)
    inp['mem_prompt'] = nrm((BATCH, N_MEM, D_MODEL), 1.0)
    inp['mem_sample'] = nrm((DEC_BATCH, N_MEM, D_MODEL), 1.0)
    inp['ssm_w_in'] = nrm((nS, D_MODEL, MIX_WIDTH + MEM_WIDTH), D_MODEL ** -0.5)
    inp['ssm_lam_re'] = -0.5 + nrm((nS, 2, G, P), 0.01)
    inp['ssm_lam_im'] = jnp.broadcast_to(jnp.pi * jnp.arange(P, dtype=f32), (nS, 2, G, P)) + nrm((nS, 2, G, P), 0.01)
    inp['ssm_log_dt'] = jax.random.uniform(next(ks), (nS, 2, G), f32, math.log(1e-3), math.log(1e-1))
    inp['ssm_b_re'] = nrm((nS, 2, G, P, C), (2 * C) ** -0.5)
    inp['ssm_b_im'] = nrm((nS, 2, G, P, C), (2 * C) ** -0.5)
    inp['ssm_c_re'] = nrm((nS, 2, G, C, P), (2 * P) ** -0.5)
    inp['ssm_c_im'] = nrm((nS, 2, G, C, P), (2 * P) ** -0.5)
    inp['ssm_d'] = nrm((nS, MIX_WIDTH), 1.0)
    inp['ssm_w_glu'] = nrm((nS, MIX_WIDTH, 2 * MIX_WIDTH), MIX_WIDTH ** -0.5)
    inp['attn_w_in'] = nrm((nA, D_MODEL, MIX_WIDTH + 2 * KV_WIDTH + MEM_WIDTH), D_MODEL ** -0.5)
    inp['attn_sink'] = nrm((nA, N_Q_HEADS), 0.5)
    inp['w_mem_kv'] = nrm((DEPTH, D_MODEL, 2 * MEM_WIDTH), D_MODEL ** -0.5)
    inp['w_out'] = nrm((DEPTH, D_MODEL, D_MODEL), BETA * D_MODEL ** -0.5)
    inp['ln1_g'] = 1.0 + nrm((DEPTH, D_MODEL), 0.02)
    inp['ln1_b'] = nrm((DEPTH, D_MODEL), 0.02)
    inp['w_ff1'] = nrm((DEPTH, D_MODEL, D_FF), D_MODEL ** -0.5)
    inp['w_ff2'] = nrm((DEPTH, D_FF, D_MODEL), BETA * D_FF ** -0.5)
    inp['ln2_g'] = 1.0 + nrm((DEPTH, D_MODEL), 0.02)
    inp['ln2_b'] = nrm((DEPTH, D_MODEL), 0.02)
    return inp


def reference(x_prompt, x_sample, mem_prompt, mem_sample, ssm_w_in, ssm_lam_re, ssm_lam_im, ssm_log_dt,
              ssm_b_re, ssm_b_im, ssm_c_re, ssm_c_im, ssm_d, ssm_w_glu, attn_w_in, attn_sink, w_mem_kv,
              w_out, ln1_g, ln1_b, w_ff1, w_ff2, ln2_g, ln2_b):
    y_prompt = trunk(x_prompt, mem_prompt, ssm_w_in, ssm_lam_re, ssm_lam_im, ssm_log_dt, ssm_b_re, ssm_b_im,
                     ssm_c_re, ssm_c_im, ssm_d, ssm_w_glu, attn_w_in, attn_sink, w_mem_kv, w_out,
                     ln1_g, ln1_b, w_ff1, w_ff2, ln2_g, ln2_b)
    y_sample = trunk(x_sample, mem_sample, ssm_w_in, ssm_lam_re, ssm_lam_im, ssm_log_dt, ssm_b_re, ssm_b_im,
                     ssm_c_re, ssm_c_im, ssm_d, ssm_w_glu, attn_w_in, attn_sink, w_mem_kv, w_out,
                     ln1_g, ln1_b, w_ff1, w_ff2, ln2_g, ln2_b)
    return (y_prompt, y_sample)
```

```cpp
#include <hip/hip_runtime.h>
#include <cstdio>
#include <cstdint>

#ifndef MK_MULTI
#define MK_MULTI 0
#endif

#define GAS __attribute__((address_space(1)))
#define LAS __attribute__((address_space(3)))
typedef unsigned short bf16_t;
typedef short bf16x8 __attribute__((ext_vector_type(8)));
typedef float f32x4 __attribute__((ext_vector_type(4)));
typedef float f32x2 __attribute__((ext_vector_type(2)));
typedef unsigned u32x4 __attribute__((ext_vector_type(4)));
typedef unsigned u32x2 __attribute__((ext_vector_type(2)));
typedef int i32x4 __attribute__((ext_vector_type(4)));

constexpr int DM = 2048, NBATCH = 12, SEQ = 4096, MTOK = NBATCH * SEQ;
constexpr int MROWS_PROMPT = 8 * SEQ;
constexpr int MIXW = 1536, MEMW = 512, HD = 128, NQH = 12, NKVH = 4, KVW = 512, NMEM = 256;
constexpr int SSG = 96, SSP = 64, SSC = 16, DFF = 8192;
constexpr int NMEMROWS = NBATCH * NMEM;
constexpr float ALPHA = 1.6817928305074290f;
constexpr float LN_EPS = 1e-5f;
constexpr int NWAVES = 8;

constexpr size_t MiB = 1u << 20;
constexpr size_t WS_CTL = 0, CTL_ZERO_BYTES = 3 * MiB;
constexpr size_t WS_STATS = 1 * MiB;
constexpr size_t WS_PART = 3 * MiB;
constexpr size_t WS_CSBW = 2 * MiB;
constexpr size_t WS_ROPE = 6 * MiB;
constexpr size_t WS_POW = 8 * MiB;
constexpr size_t WS_BBAR = 12 * MiB;
constexpr size_t WS_KT = 16 * MiB;
constexpr size_t WS_MEMKV = 24 * MiB;
constexpr size_t WS_WIN = 48 * MiB;
constexpr size_t WS_WGLU = 60 * MiB;
constexpr size_t WS_WOUT = 69 * MiB;
constexpr size_t WS_WFF1 = 77 * MiB;
constexpr size_t WS_WFF2 = 109 * MiB;
constexpr size_t WS_SWG = 141 * MiB;
constexpr size_t WS_SWY = 153 * MiB;
constexpr size_t WS_XB = 177 * MiB;
constexpr size_t WS_R1 = 369 * MiB;
constexpr size_t WS_END = 993 * MiB;
constexpr size_t R1_UH = 0;
constexpr size_t R1_G = 288 * MiB;
constexpr size_t R1_Z = 432 * MiB;
constexpr size_t R1_QM = 576 * MiB;
constexpr size_t R1_CONCAT = 0;
constexpr size_t R1_Q = 192 * MiB;
constexpr size_t R1_K = 336 * MiB;
constexpr size_t R1_V = 384 * MiB;
#ifndef NSPLIT
#define NSPLIT 2
#endif
constexpr size_t R1_H = 0;
constexpr size_t R1_MEMB = 0;
constexpr size_t R1_WMKV = 16 * MiB;
constexpr int CW_BAR = 4096;

constexpr int RING_BYTES = 131072;
constexpr int LDSCTL_OFF = RING_BYTES, MISC_OFF = LDSCTL_OFF + 320;
constexpr int LDS_BYTES = 163840;
constexpr int FOLD_SLOT_OFF = LDSCTL_OFF + 9216;

#define LDS_WAIT() asm volatile("s_waitcnt lgkmcnt(0)" ::: "memory")
#define VM_WAIT() asm volatile("s_waitcnt vmcnt(0)" ::: "memory")
__device__ __forceinline__ unsigned f2bf(float f) { unsigned u = __builtin_bit_cast(unsigned, f); return (u + 0x7fffu + ((u >> 16) & 1u)) >> 16; }
__device__ __forceinline__ unsigned pk2(float lo, float hi) { return f2bf(lo) | (f2bf(hi) << 16); }
__device__ __forceinline__ float bf2f(unsigned short b) { return __builtin_bit_cast(float, ((unsigned)b) << 16); }
__device__ __forceinline__ float bflo(unsigned w) { return __builtin_bit_cast(float, w << 16); }
__device__ __forceinline__ float bfhi(unsigned w) { return __builtin_bit_cast(float, w & 0xffff0000u); }

namespace pg8 {
constexpr int BM = 256, BK = 64, HALF = 128, HTB = HALF * BK * 2, NXCD = 8, WGM = 4;
__host__ __device__ __forceinline__ int lds_byte(int r, int c) { const int st = (r >> 4) * 2 + (c >> 5), rr = r & 15, cc = c & 31, ob = rr * 64 + cc * 2; return st * 1024 + (ob ^ (((ob >> 9) & 1) << 5)); }
__host__ __device__ __forceinline__ void stage_rc(int b, int& R, int& C) { const int st = b / 1024, sb = b % 1024, swz = sb ^ (((sb >> 9) & 1) << 5); R = (st >> 1) * 16 + swz / 64; C = (st & 1) * 32 + (swz % 64) / 2; }
__host__ __device__ __forceinline__ int perm32(int rho) { const int n = rho >> 4, i = rho & 15; return 8 * (i >> 2) + 4 * n + (i & 3); }

struct Unit { int pm, pn; };
struct GemmPlain {
    const bf16_t* A; const bf16_t* Bt; int K, lda;
    __device__ __forceinline__ const char* a_tile(const Unit& u) const { return (const char*)(A + (size_t)u.pm * BM * lda); }
    __device__ __forceinline__ const char* b_tile(const Unit& u) const { return (const char*)(Bt + (size_t)u.pn * BM * K); }
};
struct GemmSsm {
    const bf16_t* A; const bf16_t* Bt; int K, lda;
    __device__ __forceinline__ const char* a_tile(const Unit& u) const { return (const char*)(A + (size_t)(u.pm * SSG + u.pn) * 256 * 512); }
    __device__ __forceinline__ const char* b_tile(const Unit& u) const { return (const char*)(Bt + (size_t)u.pn * 256 * K); }
};
struct StaticOrder {
    int nM, nN, nwg, G, c;
    __device__ void init(int M, int N, int G_, int c_) { nM = M / BM; nN = N / BM; nwg = nM * nN; G = G_; c = c_; }
    __device__ bool next(int i, Unit& u) const {
        const long L = (long)i * G + c; if (L >= nwg) return false;
        int wgid = (int)L; { const int q = nwg / NXCD, r = nwg % NXCD, xcd = wgid % NXCD, off = wgid / NXCD; wgid = (xcd < r ? xcd * (q + 1) : r * (q + 1) + (xcd - r) * q) + off; }
        const int nig = WGM * nN, gid = wgid / nig, fm = gid * WGM, gsz = (nM - fm) < WGM ? (nM - fm) : WGM;
        u.pm = fm + ((wgid % nig) % gsz); u.pn = (wgid % nig) / gsz; return true;
    }
    __device__ __forceinline__ void a_ready(const Unit&) const {}
    __device__ __forceinline__ void done(const Unit&) const {}
};
struct SsmOrder {
    int G, c;
    __device__ bool next(int i, Unit& u) const { const int L = i * G + c; if (L >= NBATCH * SSG) return false; u.pm = L % NBATCH; u.pn = L / NBATCH; return true; }
    __device__ __forceinline__ void a_ready(const Unit&) const {}
    __device__ __forceinline__ void done(const Unit&) const {}
};
typedef __bf16 bf16x2_t __attribute__((ext_vector_type(2)));
__device__ __forceinline__ unsigned cvt_pk_bf16(float lo, float hi) { const f32x2 v = {lo, hi}; return __builtin_bit_cast(unsigned, __builtin_convertvector(v, bf16x2_t)); }

#ifndef RELAX
#define RELAX 0
#endif
template <class E, class = void> struct EpiPre { static constexpr bool v = false; };
template <class E> struct EpiPre<E, decltype((void)E::PRE)> { static constexpr bool v = E::PRE; };
#ifndef STAGGER
#define STAGGER 0
#endif
#ifndef SPLITST
#define SPLITST 0
#endif
template <class Epi, class GM, class Sched, int PROBE = 0>
__device__ __forceinline__ void gemm_phase(LAS unsigned char* lds, int wave, const GM g, const Sched& S, const Epi& E) {
    int lane_; asm volatile("v_mbcnt_lo_u32_b32 %0, -1, 0\n\tv_mbcnt_hi_u32_b32 %0, -1, %0" : "=v"(lane_));
    const int wid = wave, lane = lane_, tid = wid * 64 + lane, wr = wid >> 2, wc = wid & 3, fr = lane & 15, fq = lane >> 4;
    const int K = g.K, nt = K / BK;
    unsigned voffA[2], voffB[2];
#pragma unroll
    for (int i = 0; i < 2; ++i) { int R, C; stage_rc(tid * 16 + i * 8192, R, C); const int Rb = Epi::PERM ? ((R & ~31) + perm32(R & 31)) : R;
        voffA[i] = (unsigned)(R * g.lda + C) * 2u; voffB[i] = (unsigned)(Rb * K + C) * 2u; }
    const size_t kstep = (size_t)(BK * 2);
    const size_t hstepA = (size_t)HALF * g.lda * 2, hstepB = (size_t)HALF * K * 2;
    const unsigned ldsw = (unsigned)wid * 1024u;
    const int aoff = lds_byte(wr * 64 + fr, fq * 8), boff = lds_byte(wc * 32 + fr, fq * 8);
#define PG8_SA(b, h) (((b) * 2 + (h)) * HTB)
#define PG8_SB(b, h) ((4 + (b) * 2 + (h)) * HTB)
#define PG8_STAGE(bufoff, gbase, voff) do { if (PROBE < 2 || (PROBE == 4 && (bufoff) >= 4 * HTB) || (PROBE == 5 && (bufoff) < 4 * HTB)) _Pragma("unroll") for (int _i = 0; _i < 2; ++_i) \
        __builtin_amdgcn_global_load_lds((const unsigned*)((const char*)(gbase) + (voff)[_i]), (LAS unsigned*)(lds + (bufoff) + ldsw + _i * 8192), 16, 0, 0); } while (0)
#define PG8_LDA(dst, b, h) do { _Pragma("unroll") for (int m = 0; m < 4; ++m) _Pragma("unroll") for (int k = 0; k < 2; ++k) dst[m][k] = *(const LAS bf16x8*)(lds + PG8_SA(b, h) + aoff + m * 2048 + k * 1024); } while (0)
#define PG8_LDB(dst, b, h) do { _Pragma("unroll") for (int n = 0; n < 2; ++n) _Pragma("unroll") for (int k = 0; k < 2; ++k) dst[n][k] = *(const LAS bf16x8*)(lds + PG8_SB(b, h) + boff + n * 2048 + k * 1024); } while (0)
#define PG8_MMA(ai, bj, At, Bt) do { __builtin_amdgcn_s_setprio(1); _Pragma("unroll") for (int m = 0; m < 4; ++m) _Pragma("unroll") for (int n = 0; n < 2; ++n) _Pragma("unroll") for (int k = 0; k < 2; ++k) \
        acc[ai][bj][m][n] = __builtin_amdgcn_mfma_f32_16x16x32_bf16(Bt[n][k], At[m][k], acc[ai][bj][m][n], 0, 0, 0); __builtin_amdgcn_s_setprio(0); } while (0)
#define PG8_WAIT_V(n) asm volatile("s_waitcnt vmcnt(" #n ")" ::: "memory")
#define PG8_WAIT_L(n) asm volatile("s_waitcnt lgkmcnt(" #n ")" ::: "memory")
#define PG8_BAR __builtin_amdgcn_s_barrier()
#define PG8_SCHED __builtin_amdgcn_sched_barrier(0)
    Unit cur, nxt; int ui = 0;
    if (!S.next(0, cur)) return;
    f32x4 acc[2][2][4][2];
#pragma unroll
    for (int a = 0; a < 2; ++a)
#pragma unroll
        for (int b = 0; b < 2; ++b)
#pragma unroll
            for (int m = 0; m < 4; ++m)
#pragma unroll
                for (int n = 0; n < 2; ++n) acc[a][b][m][n] = (f32x4){0.f, 0.f, 0.f, 0.f};
    bf16x8 At[4][2], B0[2][2], B1[2][2];
    const char* cA = g.a_tile(cur); const char* cB = g.b_tile(cur);
    S.a_ready(cur);
    if (STAGGER > 0) { const int grp = (blockIdx.x >> 3) & 7; for (int i = 0; i < grp; ++i) __builtin_amdgcn_s_sleep(STAGGER); }
    PG8_STAGE(PG8_SB(0, 0), cB, voffB); PG8_STAGE(PG8_SB(0, 1), cB + hstepB, voffB); PG8_STAGE(PG8_SA(0, 0), cA, voffA); PG8_STAGE(PG8_SA(0, 1), cA + hstepA, voffA);
    PG8_STAGE(PG8_SB(1, 0), cB + kstep, voffB); PG8_STAGE(PG8_SA(1, 0), cA + kstep, voffA); PG8_STAGE(PG8_SB(1, 1), cB + hstepB + kstep, voffB);
    if (wr == 1) PG8_BAR;
    PG8_WAIT_V(6); PG8_BAR;
    PG8_BAR;
    for (;;) {
        const bool has_next = S.next(ui + 1, nxt);
        const char* nA = has_next ? g.a_tile(nxt) : cA; const char* nB = has_next ? g.b_tile(nxt) : cB;
        if constexpr (EpiPre<Epi>::v) E.prefetch(lds, cur, ui & 1, wid, lane);
#define PG8_TRIP(W12) do { \
            const bool last = (t == nt - 2); \
            const char* a1 = cA + (size_t)(t + 1) * kstep; \
            const char* a2 = last ? nA : cA + (size_t)(t + 2) * kstep; const char* b2 = last ? nB : cB + (size_t)(t + 2) * kstep; \
            const char* a3 = a2 + kstep; const char* b3 = b2 + kstep; \
            if (last && has_next) S.a_ready(nxt); \
            PG8_LDB(B0, 0, 0); PG8_LDB(B1, 0, 1); PG8_SCHED; PG8_LDA(At, 0, 0); PG8_STAGE(PG8_SA(1, 1), a1 + hstepA, voffA); \
            W12; PG8_WAIT_L(0); PG8_BAR; PG8_MMA(0, 0, At, B0); PG8_MMA(0, 1, At, B1); PG8_BAR; PG8_SCHED; \
            PG8_LDA(At, 0, 1); PG8_STAGE(PG8_SB(0, 0), b2, voffB); PG8_STAGE(PG8_SB(0, 1), b2 + hstepB, voffB); if (!SPLITST) PG8_STAGE(PG8_SA(0, 0), a2, voffA); \
            if (SPLITST) PG8_WAIT_V(6); else { W12; } PG8_WAIT_L(0); PG8_BAR; if (SPLITST) { PG8_STAGE(PG8_SA(0, 0), a2, voffA); PG8_SCHED; } PG8_MMA(1, 0, At, B0); PG8_MMA(1, 1, At, B1); PG8_BAR; PG8_SCHED; \
            PG8_LDB(B0, 1, 0); PG8_LDB(B1, 1, 1); PG8_SCHED; PG8_LDA(At, 1, 0); PG8_STAGE(PG8_SA(0, 1), a2 + hstepA, voffA); \
            PG8_WAIT_V(8); PG8_WAIT_L(0); PG8_BAR; PG8_MMA(0, 0, At, B0); PG8_MMA(0, 1, At, B1); PG8_BAR; PG8_SCHED; \
            PG8_LDA(At, 1, 1); PG8_STAGE(PG8_SB(1, 0), b3, voffB); PG8_STAGE(PG8_SB(1, 1), b3 + hstepB, voffB); if (!SPLITST) PG8_STAGE(PG8_SA(1, 0), a3, voffA); \
            if (SPLITST) PG8_WAIT_V(6); else PG8_WAIT_V(8); PG8_WAIT_L(0); PG8_BAR; if (SPLITST) { PG8_STAGE(PG8_SA(1, 0), a3, voffA); PG8_SCHED; } PG8_MMA(1, 0, At, B0); PG8_MMA(1, 1, At, B1); PG8_BAR; PG8_SCHED; \
        } while (0)
#define PG8_W12_16 asm volatile("s_waitcnt vmcnt(24)\n\ts_cmp_lg_u32 %0, 0\n\ts_cbranch_scc1 1f\n\ts_waitcnt vmcnt(8)\n1:" :: "s"(relax) : "scc", "memory")
#define PG8_W12_32 asm volatile("s_waitcnt vmcnt(40)\n\ts_cmp_lg_u32 %0, 0\n\ts_cbranch_scc1 1f\n\ts_waitcnt vmcnt(8)\n1:" :: "s"(relax) : "scc", "memory")
        for (int t = 0; t < nt; t += 2) {
            const int relax = __builtin_amdgcn_readfirstlane((RELAX && Epi::NST > 0 && ui > 0 && t == 0) ? 1 : 0);
            if constexpr (!RELAX || Epi::NST < 16) { PG8_TRIP(PG8_WAIT_V(8)); } else if constexpr (Epi::NST >= 32) { PG8_TRIP(PG8_W12_32); } else { PG8_TRIP(PG8_W12_16); }
        }
#undef PG8_TRIP
#undef PG8_W12_16
#undef PG8_W12_32
        if (wr == 0) PG8_BAR;
        if (PROBE >= 1) {
#pragma unroll
            for (int a = 0; a < 2; ++a)
#pragma unroll
                for (int b = 0; b < 2; ++b)
#pragma unroll
                    for (int m = 0; m < 4; ++m)
#pragma unroll
                        for (int n = 0; n < 2; ++n) asm volatile("" :: "v"(acc[a][b][m][n]));
        } else
        { int fr_ = fr, fq_ = fq; asm volatile("" : "+v"(fr_), "+v"(fq_)); if constexpr (EpiPre<Epi>::v) E.run(acc, cur, wr, wc, fr_, fq_, lds + FOLD_SLOT_OFF + (ui & 1) * 4096); else E(acc, cur, wr, wc, fr_, fq_); }
        S.done(cur);
        if (!has_next) break;
#pragma unroll
        for (int a = 0; a < 2; ++a)
#pragma unroll
            for (int b = 0; b < 2; ++b)
#pragma unroll
                for (int m = 0; m < 4; ++m)
#pragma unroll
                    for (int n = 0; n < 2; ++n) acc[a][b][m][n] = (f32x4){0.f, 0.f, 0.f, 0.f};
        cur = nxt; cA = nA; cB = nB; ++ui;
        if (wr == 1) PG8_BAR;
    }
    PG8_WAIT_V(0);
    PG8_BAR;
#undef PG8_SA
#undef PG8_SB
#undef PG8_STAGE
#undef PG8_LDA
#undef PG8_LDB
#undef PG8_MMA
#undef PG8_WAIT_V
#undef PG8_WAIT_L
#undef PG8_BAR
#undef PG8_SCHED
}

typedef const f32x4 (&AccRef)[2][2][4][2];
#define EPI_ROWS_BEGIN _Pragma("unroll") for (int ai = 0; ai < 2; ++ai) _Pragma("unroll") for (int m = 0; m < 4; ++m) { const int r = u.pm * BM + ai * HALF + wr * 64 + m * 16 + fr;
#define EPI_ROWS_END }
__device__ __forceinline__ u32x4 pack8(f32x4 v0, f32x4 v1) { u32x4 w; w.x = cvt_pk_bf16(v0[0], v0[1]); w.y = cvt_pk_bf16(v0[2], v0[3]); w.z = cvt_pk_bf16(v1[0], v1[1]); w.w = cvt_pk_bf16(v1[2], v1[3]); return w; }

struct Fold { const float* st; const float* cs; const float* bw; };
__device__ __forceinline__ void row_stats(const float* st, int r, float& mu, float& rs) { const f32x2 sq = *(const f32x2*)(st + 2 * (size_t)r); mu = sq.x; rs = sq.y; }
struct EpiPlainBf16 {
    static constexpr bool PERM = true; static constexpr int NST = 16;
    bf16_t* O; int ldc;
    __device__ __forceinline__ void operator()(AccRef acc, const Unit& u, int wr, int wc, int fr, int fq) const {
        const int c0 = u.pn * BM + wc * 32 + 8 * fq;
        EPI_ROWS_BEGIN  bf16_t* rowp = O + (size_t)r * ldc + c0;
#pragma unroll
            for (int bj = 0; bj < 2; ++bj) *(u32x4*)(rowp + bj * HALF) = pack8(acc[ai][bj][m][0], acc[ai][bj][m][1]);  EPI_ROWS_END
    }
};
#define FOLD_COLS() f32x4 csv[2][2], bwv[2][2]; if (FOLD) { _Pragma("unroll") for (int bj = 0; bj < 2; ++bj) _Pragma("unroll") for (int n = 0; n < 2; ++n) { \
        const i32x4 ci_ = *(const i32x4*)(fo.cs + cfull + bj * HALF + 4 * n), bi_ = *(const i32x4*)(fo.bw + cfull + bj * HALF + 4 * n); \
        csv[bj][n] = __builtin_convertvector(ci_, f32x4) * 5.9604644775390625e-08f; bwv[bj][n] = __builtin_convertvector(bi_, f32x4) * 5.9604644775390625e-08f; } } \
    f32x2 stv[2][4]; if (FOLD) { _Pragma("unroll") for (int ai = 0; ai < 2; ++ai) _Pragma("unroll") for (int m = 0; m < 4; ++m) stv[ai][m] = *(const f32x2*)(fo.st + 2 * (size_t)(u.pm * BM + ai * HALF + wr * 64 + m * 16 + fr)); }
#define FOLD_ROW() const float mu = FOLD ? stv[ai][m].x : 0.f, rs = FOLD ? stv[ai][m].y : 1.f;
#define FOLD_COLS_LDS() f32x4 csv[2][2], bwv[2][2]; f32x2 stv[2][4]; if (FOLD) { _Pragma("unroll") for (int bj = 0; bj < 2; ++bj) _Pragma("unroll") for (int n = 0; n < 2; ++n) { \
        const i32x4 ci_ = *(const LAS i32x4*)(slot + (cl + bj * HALF + 4 * n) * 4), bi_ = *(const LAS i32x4*)(slot + 1024 + (cl + bj * HALF + 4 * n) * 4); \
        csv[bj][n] = __builtin_convertvector(ci_, f32x4) * 5.9604644775390625e-08f; bwv[bj][n] = __builtin_convertvector(bi_, f32x4) * 5.9604644775390625e-08f; } \
        _Pragma("unroll") for (int ai = 0; ai < 2; ++ai) _Pragma("unroll") for (int m = 0; m < 4; ++m) stv[ai][m] = *(const LAS f32x2*)(slot + 2048 + (ai * HALF + wr * 64 + m * 16 + fr) * 8); }
#define FOLD_COLS_LDS_F() f32x4 csv[2][2], bwv[2][2]; f32x2 stv[2][4]; if (FOLD) { _Pragma("unroll") for (int bj = 0; bj < 2; ++bj) _Pragma("unroll") for (int n = 0; n < 2; ++n) { \
        csv[bj][n] = *(const LAS f32x4*)(slot + (cl + bj * HALF + 4 * n) * 4); bwv[bj][n] = *(const LAS f32x4*)(slot + 1024 + (cl + bj * HALF + 4 * n) * 4); } \
        _Pragma("unroll") for (int ai = 0; ai < 2; ++ai) _Pragma("unroll") for (int m = 0; m < 4; ++m) stv[ai][m] = *(const LAS f32x2*)(slot + 2048 + (ai * HALF + wr * 64 + m * 16 + fr) * 8); }
#define FOLD_PREFETCH() static constexpr bool PRE = FOLD; \
    __device__ __forceinline__ void prefetch(LAS unsigned char* lds, const Unit& u, int par, int wid, int lane) const { \
        if (wid < 4) { const char* src = wid == 0 ? (const char*)(fo.cs + u.pn * BM) : wid == 1 ? (const char*)(fo.bw + u.pn * BM) : (const char*)(fo.st + 2 * (size_t)(u.pm * BM + (wid - 2) * HALF)); \
            __builtin_amdgcn_global_load_lds((const unsigned*)(src + lane * 16), (LAS unsigned*)(lds + FOLD_SLOT_OFF + par * 4096 + wid * 1024), 16, 0, 0); } }
#define FOLDV(bj, n) (FOLD ? (acc[ai][bj][m][n] - csv[bj][n] * mu) * rs + bwv[bj][n] : acc[ai][bj][m][n])
template <bool FOLD> struct EpiInSsm {
    static constexpr bool PERM = true; static constexpr int NST = 16;
    bf16_t* UH; bf16_t* QM; Fold fo;
    FOLD_PREFETCH()
    __device__ __forceinline__ void operator()(AccRef acc, const Unit& u, int wr, int wc, int fr, int fq) const { run(acc, u, wr, wc, fr, fq, nullptr); }
    __device__ __forceinline__ void run(AccRef acc, const Unit& u, int wr, int wc, int fr, int fq, const LAS unsigned char* slot) const {
        const int cl = wc * 32 + 8 * fq; const bool isu = u.pn < 6;
        FOLD_COLS_LDS()
        const int ou = ((((u.pm >> 4) * SSG + u.pn * 16 + wc * 2 + (fq >> 1)) * 256 + (u.pm & 15) * 16 + wr * 4) * 512 + fr * 16 + 8 * (fq & 1));
        const int oq = (u.pm * BM + wr * 64 + fr) * MEMW + (u.pn * BM + wc * 32 + 8 * fq - MIXW);
        char* const obase = isu ? (char*)UH : (char*)QM; const unsigned bo = 2u * (unsigned)(isu ? ou : oq);
        const unsigned sm = isu ? 1024u : 16384u, sai = isu ? 8192u : 131072u, sbj = isu ? 2097152u : 256u;
        EPI_ROWS_BEGIN  (void)r; FOLD_ROW()
#pragma unroll
            for (int bj = 0; bj < 2; ++bj) *(u32x4*)(obase + (bo + ai * sai + m * sm + bj * sbj)) = pack8(FOLDV(bj, 0), FOLDV(bj, 1));  EPI_ROWS_END
    }
};
template <bool FOLD> struct EpiInAttn {
    static constexpr bool PERM = true; static constexpr int NST = 16;
    unsigned char* r1; const float* rope; Fold fo;
    FOLD_PREFETCH()
    __device__ __forceinline__ void operator()(AccRef acc, const Unit& u, int wr, int wc, int fr, int fq) const { run(acc, u, wr, wc, fr, fq, nullptr); }
    __device__ __forceinline__ void run(AccRef acc, const Unit& u, int wr, int wc, int fr, int fq, const LAS unsigned char* slot) const {
        const int ct = u.pn * BM + wc * 32 + 8 * fq, cl = wc * 32 + 8 * fq; const bool ro = u.pn < 8;
        const size_t boff = R1_Q + (size_t)(u.pn >= 6) * (R1_K - R1_Q) + (size_t)(u.pn >= 8) * (R1_V - R1_K) + (size_t)(u.pn >= 10) * (R1_QM - R1_V);
        bf16_t* base = (bf16_t*)(r1 + boff); const int ld = u.pn < 6 ? MIXW : KVW;
        const int c0 = ct - (u.pn >= 6) * MIXW - (u.pn >= 8) * KVW - (u.pn >= 10) * KVW;
        const int i0 = 16 * wc + 4 * fq;
        FOLD_COLS_LDS()
#ifndef RP_DIST
#define RP_DIST 2
#endif
        f32x4 rc0[8], rc1[8];
#define RP_LOAD(s) do { const int pos_ = (u.pm * BM + ((s) >> 2) * HALF + wr * 64 + ((s) & 3) * 16 + fr) & 4095; rc0[s] = *(const f32x4*)(rope + (size_t)(pos_ * 64 + i0) * 2); rc1[s] = *(const f32x4*)(rope + (size_t)(pos_ * 64 + i0) * 2 + 4); } while (0)
#pragma unroll
        for (int s = 0; s < RP_DIST; ++s) RP_LOAD(s);
        EPI_ROWS_BEGIN  if (ai * 4 + m + RP_DIST < 8) RP_LOAD(ai * 4 + m + RP_DIST);
            f32x4 cs0 = rc0[ai * 4 + m], cs1 = rc1[ai * 4 + m];
            if (!ro) { cs0 = (f32x4){1.f, 0.f, 1.f, 0.f}; cs1 = cs0; }
            bf16_t* rowp = base + (size_t)r * ld + c0; FOLD_ROW()
#pragma unroll
            for (int bj = 0; bj < 2; ++bj) { const f32x4 v0 = FOLDV(bj, 0), v1 = FOLDV(bj, 1); f32x4 o0, o1;
                o0[0] = v0[0] * cs0[0] - v0[1] * cs0[1]; o0[1] = v0[1] * cs0[0] + v0[0] * cs0[1]; o0[2] = v0[2] * cs0[2] - v0[3] * cs0[3]; o0[3] = v0[3] * cs0[2] + v0[2] * cs0[3];
                o1[0] = v1[0] * cs1[0] - v1[1] * cs1[1]; o1[1] = v1[1] * cs1[0] + v1[0] * cs1[1]; o1[2] = v1[2] * cs1[2] - v1[3] * cs1[3]; o1[3] = v1[3] * cs1[2] + v1[2] * cs1[3];
                *(u32x4*)(rowp + bj * HALF) = pack8(o0, o1); }  EPI_ROWS_END
#undef RP_LOAD
    }
};
struct EpiG1 {
    static constexpr bool PERM = true; static constexpr int NST = 16;
    bf16_t* G;
    __device__ __forceinline__ void operator()(AccRef acc, const Unit& u, int wr, int wc, int fr, int fq) const {
        char* base = (char*)(G + (size_t)(u.pm * SSG + u.pn) * 65536); const unsigned bo = 2u * (unsigned)((wr * 64 + fr) * 256 + wc * 32 + 8 * fq);
#pragma unroll
        for (int ai = 0; ai < 2; ++ai)
#pragma unroll
            for (int m = 0; m < 4; ++m)
#pragma unroll
                for (int bj = 0; bj < 2; ++bj) *(u32x4*)(base + (bo + 2u * (unsigned)((ai * HALF + m * 16) * 256 + bj * HALF))) = pack8(acc[ai][bj][m][0], acc[ai][bj][m][1]);
    }
};
__device__ __forceinline__ f32x4 gelu_tanh4(f32x4 x) {
    const f32x4 t = x * (x * x * (-2.885390081777927f * 0.7978845608028654f * 0.044715f) + (-2.885390081777927f * 0.7978845608028654f));
    f32x4 r;
#pragma unroll
    for (int j = 0; j < 4; ++j) r[j] = __builtin_amdgcn_rcpf(1.0f + __builtin_amdgcn_exp2f(t[j]));
    return x * r;
}
struct EpiG2 {
    static constexpr bool PERM = true; static constexpr int NST = 16;
    bf16_t* Z;
    __device__ __forceinline__ void operator()(AccRef acc, const Unit& u, int wr, int wc, int fr, int fq) const {
        const int c0 = wc * 32 + 8 * fq;
#pragma unroll
        for (int ai = 0; ai < 2; ++ai)
#pragma unroll
            for (int m = 0; m < 4; ++m) { const int kk = ai * HALF + wr * 64 + m * 16 + fr;
#pragma unroll
                for (int bj = 0; bj < 2; ++bj) { const int c = c0 + bj * HALF; f32x4 v0 = acc[ai][bj][m][0], v1 = acc[ai][bj][m][1];
                    v0 = gelu_tanh4(v0); v1 = gelu_tanh4(v1);
                    bf16_t* p = Z + (size_t)(u.pm * SEQ + kk * 16 + (c >> 4)) * MIXW + u.pn * 16 + (c & 15);
                    *(u32x4*)p = pack8(v0, v1); } }
    }
};
struct EpiGlu {
    static constexpr bool PERM = true; static constexpr int NST = 16;
    bf16_t* O;
    __device__ __forceinline__ void operator()(AccRef acc, const Unit& u, int wr, int wc, int fr, int fq) const {
        const int c0 = u.pn * BM + wc * 32 + 8 * fq;
        EPI_ROWS_BEGIN  bf16_t* rowp = O + (size_t)r * DM;
#pragma unroll
            for (int bj = 0; bj < 2; ++bj) { const int q4 = (c0 + bj * HALF) >> 1; const f32x4 a = acc[ai][bj][m][0], gt = acc[ai][bj][m][1]; float o[4];
#pragma unroll
                for (int j = 0; j < 4; ++j) o[j] = a[j] * __builtin_amdgcn_rcpf(1.0f + __builtin_amdgcn_exp2f(-1.4426950408889634f * gt[j]));
                u32x2 w; w.x = cvt_pk_bf16(o[0], o[1]); w.y = cvt_pk_bf16(o[2], o[3]); *(u32x2*)(rowp + q4) = w; }  EPI_ROWS_END
    }
};
template <int MODE> struct EpiResidB {
    static constexpr bool PERM = true; static constexpr int NST = 16;
    const float* xa; const float* xb2; int split; const float* stp; const float* gam; const float* bet;
    bf16_t* vb; float* part; int row_off; LAS unsigned char* lds;
    static constexpr bool PRE = MODE == 1;
    __device__ __forceinline__ void prefetch(LAS unsigned char* lds_, const Unit& u, int par, int wid, int lane) const {
        if (wid < 4) { const char* src = wid == 0 ? (const char*)(gam + u.pn * BM) : wid == 1 ? (const char*)(bet + u.pn * BM) : (const char*)(stp + 2 * (size_t)(u.pm * BM + row_off + (wid - 2) * HALF));
            __builtin_amdgcn_global_load_lds((const unsigned*)(src + lane * 16), (LAS unsigned*)(lds_ + FOLD_SLOT_OFF + par * 4096 + wid * 1024), 16, 0, 0); } }
    __device__ __forceinline__ void operator()(AccRef acc, const Unit& u, int wr, int wc, int fr, int fq) const { run(acc, u, wr, wc, fr, fq, nullptr); }
    __device__ __forceinline__ void run(AccRef acc, const Unit& u, int wr, int wc, int fr, int fq, const LAS unsigned char* slot) const {
        const int c0 = u.pn * BM + wc * 32 + 8 * fq, cl = wc * 32 + 8 * fq;
        LAS f32x2* P = (LAS f32x2*)(lds + LDSCTL_OFF + 1024);
        f32x4 gv[2][2], bv[2][2];
        if (MODE == 1) {
#pragma unroll
            for (int bj = 0; bj < 2; ++bj)
#pragma unroll
                for (int n = 0; n < 2; ++n) { gv[bj][n] = *(const LAS f32x4*)(slot + (cl + bj * HALF + 4 * n) * 4); bv[bj][n] = *(const LAS f32x4*)(slot + 1024 + (cl + bj * HALF + 4 * n) * 4); } }
#ifndef RB_DIST
#define RB_DIST 8
#endif
        constexpr int DIST = MODE == 1 ? RB_DIST : 4;
        const int row0 = u.pm * BM + row_off;
        const char* xbase = MODE == 1 ? (const char*)vb : (row0 < split ? (const char*)xa : (const char*)(xb2 - (size_t)split * DM));
        const unsigned eo = (unsigned)((row0 + wr * 64 + fr) * DM + c0);
#define RB_EO(s) (eo + (unsigned)((((s) >> 3) * HALF + (((s) >> 1) & 3) * 16) * DM + ((s) & 1) * HALF))
#define RB_LOAD(s) do { if (MODE == 1) wq[s] = *(const u32x4*)(xbase + 2 * RB_EO(s)); else { xq0[s] = *(const f32x4*)(xbase + 4 * RB_EO(s)); xq1[s] = *(const f32x4*)(xbase + 4 * RB_EO(s) + 16); } } while (0)
        u32x4 wq[16]; f32x4 xq0[16], xq1[16];
#pragma unroll
        for (int s = 0; s < DIST; ++s) RB_LOAD(s);
        float s1 = 0.f, s2 = 0.f;
#pragma unroll
        for (int s = 0; s < 16; ++s) { const int ai = s >> 3, m = (s >> 1) & 3, bj = s & 1;
            if (s + DIST < 16) RB_LOAD(s + DIST);
            f32x2 st_ = {0.f, 1.f}; if (MODE == 1) st_ = *(const LAS f32x2*)(slot + 2048 + (ai * HALF + wr * 64 + m * 16 + fr) * 8);
            const float rs = st_.y, nmr = -st_.x * rs;
            f32x4 x0, x1;
            if (MODE == 1) { const u32x4 w = wq[s];
                x0 = (f32x4){bflo(w.x), bfhi(w.x), bflo(w.y), bfhi(w.y)}; x1 = (f32x4){bflo(w.z), bfhi(w.z), bflo(w.w), bfhi(w.w)};
                x0 = (x0 * rs + nmr) * gv[bj][0] + bv[bj][0]; x1 = (x1 * rs + nmr) * gv[bj][1] + bv[bj][1]; }
            else { x0 = xq0[s]; x1 = xq1[s]; }
            const f32x4 v0 = x0 * ALPHA + acc[ai][bj][m][0], v1 = x1 * ALPHA + acc[ai][bj][m][1];
            *(u32x4*)((char*)vb + 2 * RB_EO(s)) = pack8(v0, v1);
            { const f32x4 q = v0 + v1, q2 = v0 * v0 + v1 * v1; s1 += (q[0] + q[1]) + (q[2] + q[3]); s2 += (q2[0] + q2[1]) + (q2[2] + q2[3]); }
            if (bj == 1) { s1 += __shfl_xor(s1, 16); s1 += __shfl_xor(s1, 32); s2 += __shfl_xor(s2, 16); s2 += __shfl_xor(s2, 32);
                if (fq == 0) P[(ai * HALF + wr * 64 + m * 16 + fr) * 4 + wc] = (f32x2){s1, s2};
                s1 = 0.f; s2 = 0.f; } }
#undef RB_EO
#undef RB_LOAD
        asm volatile("s_waitcnt lgkmcnt(0)" ::: "memory"); __builtin_amdgcn_s_barrier(); asm volatile("" ::: "memory");
        if (wr == 0) { const int rl = wc * 64 + fq * 16 + fr; const f32x4 p01 = *(const LAS f32x4*)(P + rl * 4), p23 = *(const LAS f32x4*)(P + rl * 4 + 2);
            *(f32x2*)(part + ((size_t)(u.pm * BM + row_off + rl) * 8 + u.pn) * 2) = (f32x2){(p01[0] + p01[2]) + (p23[0] + p23[2]), (p01[1] + p01[3]) + (p23[1] + p23[3])}; }
    }
};
template <bool FOLD> struct EpiSqReluT {
    static constexpr bool PERM = true; static constexpr int NST = 16;
    bf16_t* O; int ldc; Fold fo;
    FOLD_PREFETCH()
    __device__ __forceinline__ void operator()(AccRef acc, const Unit& u, int wr, int wc, int fr, int fq) const { run(acc, u, wr, wc, fr, fq, nullptr); }
    __device__ __forceinline__ void run(AccRef acc, const Unit& u, int wr, int wc, int fr, int fq, const LAS unsigned char* slot) const {
        const int c0 = u.pn * BM + wc * 32 + 8 * fq, cl = wc * 32 + 8 * fq;
        FOLD_COLS_LDS_F()
        const unsigned bo = 2u * (unsigned)((u.pm * BM + wr * 64 + fr) * ldc + c0);
        EPI_ROWS_BEGIN  (void)r; FOLD_ROW()
#pragma unroll
            for (int bj = 0; bj < 2; ++bj) { f32x4 v0 = FOLDV(bj, 0), v1 = FOLDV(bj, 1);
#pragma unroll
                for (int j = 0; j < 4; ++j) { const float a = fmaxf(v0[j], 0.f), b = fmaxf(v1[j], 0.f); v0[j] = a * a; v1[j] = b * b; }
                *(u32x4*)((char*)O + (bo + 2u * (unsigned)((ai * HALF + m * 16) * ldc + bj * HALF))) = pack8(v0, v1); }  EPI_ROWS_END
    }
};
typedef EpiSqReluT<true> EpiSqRelu;
}

#define XB_TMO      128
#define XB_XCNT(j)  (256  + 64 * (j))
#define XB_XSUB(j)  (1280 + 64 * (j))
#define XB_XGEN(j)  (2304 + 64 * (j))
#define XB_TOP      3328
#define XB_TOPGEN   3392
#define XCD_BAR_WORDS 3456
#define XB_SPIN_CAP (1u << 22)
__device__ __forceinline__ unsigned xb_ld(unsigned* p)              { return __hip_atomic_load(p, __ATOMIC_RELAXED, __HIP_MEMORY_SCOPE_AGENT); }
__device__ __forceinline__ unsigned xb_add(unsigned* p, unsigned v) { return __hip_atomic_fetch_add(p, v, __ATOMIC_RELAXED, __HIP_MEMORY_SCOPE_AGENT); }
__device__ __forceinline__ unsigned xb_xcc_id() { return (unsigned)__builtin_amdgcn_s_getreg((3 << 11) | 20) & 0xFu; }
#define XB_SPIN(cond, bar) do { unsigned _sp = 0; while (cond) { __builtin_amdgcn_s_sleep(1); \
    if ((++_sp & 255u) == 0u) { if (xb_ld(&(bar)[XB_TMO])) break; if (_sp > XB_SPIN_CAP) { atomicAdd(&(bar)[XB_TMO], 1u); break; } } } } while (0)
struct XcdBarrier { unsigned* bar; unsigned x; volatile LAS unsigned* st; };
__device__ __forceinline__ XcdBarrier xcd_barrier_post(unsigned* bar, volatile LAS unsigned* st, bool leader) {
    XcdBarrier b; b.bar = bar; b.x = xb_xcc_id(); b.st = st;
    if (leader) (void)xb_add(&bar[XB_XCNT(b.x)], 1u);
    return b;
}
__device__ __forceinline__ void xcd_barrier_complete(unsigned* bar, unsigned x, unsigned& nloc, unsigned& nx) {
    const unsigned G = gridDim.x * gridDim.y * gridDim.z;
    unsigned sum, cnt, mine, sp = 0u;
    for (;;) {
        sum = 0u; cnt = 0u; mine = 0u;
#pragma unroll
        for (unsigned j = 0; j < 16; ++j) { const unsigned c = xb_ld(&bar[XB_XCNT(j)]); sum += c; cnt += (c > 0u) ? 1u : 0u; mine = (j == x) ? c : mine; }
        if (sum == G) break;
        __builtin_amdgcn_s_sleep(1);
        if ((++sp & 255u) == 0u) { if (xb_ld(&bar[XB_TMO])) break; if (sp > XB_SPIN_CAP) { atomicAdd(&bar[XB_TMO], 1u); break; } }
    }
    nloc = mine > 0u ? mine : 1u; nx = cnt > 0u ? cnt : 1u;
}
__device__ __forceinline__ void xcd_barrier(const XcdBarrier& b, bool leader) {
    asm volatile("s_waitcnt vmcnt(0)" ::: "memory");
    __syncthreads();
    if (leader) {
        unsigned* bar = b.bar;
        __builtin_amdgcn_s_waitcnt(0);
        unsigned nloc = b.st[0], nx = b.st[1];
        if (nloc == 0u) { xcd_barrier_complete(bar, b.x, nloc, nx); b.st[0] = nloc; b.st[1] = nx; }
        const unsigned old = xb_add(&bar[XB_XSUB(b.x)], 1u);
        const unsigned gen = old / nloc;
        if (old + 1u == (gen + 1u) * nloc) {
            __builtin_amdgcn_fence(__ATOMIC_RELEASE, "agent");
            asm volatile("s_waitcnt vmcnt(0)" ::: "memory");
            const unsigned og = xb_add(&bar[XB_TOP], 1u);
            const unsigned tg = og / nx;
            if (og + 1u == (tg + 1u) * nx) xb_add(&bar[XB_TOPGEN], 1u);
            else XB_SPIN(xb_ld(&bar[XB_TOPGEN]) == tg, bar);
            __builtin_amdgcn_fence(__ATOMIC_ACQUIRE, "agent");
            xb_add(&bar[XB_XGEN(b.x)], 1u);
            asm volatile("s_waitcnt vmcnt(0)" ::: "memory");
        } else {
            XB_SPIN(xb_ld(&bar[XB_XGEN(b.x)]) == gen, bar);
            __builtin_amdgcn_fence(__ATOMIC_ACQUIRE, "agent");
            asm volatile("s_waitcnt vmcnt(0)" ::: "memory");
        }
    }
    __syncthreads();
}

#define GB_CNT(g) (4096 + 64 * (g))
#define GB_GEN(g) (4608 + 64 * (g))
#define GB_FLAG   5120
__device__ __forceinline__ void group_barrier(unsigned* bar, bool leader) {
    asm volatile("s_waitcnt vmcnt(0)" ::: "memory");
    __syncthreads();
    if (leader) {
        const unsigned g = blockIdx.x & 7u, n = (gridDim.x + 7u - g) / 8u;
        const unsigned old = xb_add(&bar[GB_CNT(g)], 1u);
        const unsigned gen = old / n;
        if (old + 1u == (gen + 1u) * n) xb_add(&bar[GB_GEN(g)], 1u);
        else XB_SPIN(xb_ld(&bar[GB_GEN(g)]) == gen, bar);
        __builtin_amdgcn_fence(__ATOMIC_ACQUIRE, "agent");
        asm volatile("s_waitcnt vmcnt(0)" ::: "memory");
    }
    __syncthreads();
}

struct Args { const float* in[24]; float* out; unsigned char* ws; int lin_lo, lin_hi; };
typedef const __attribute__((address_space(4))) Args* CAP;
struct Frame {
    LAS unsigned char* lds; int tid, lane, wave, G, gw, NGW;
};
__device__ __forceinline__ int lane_id_opaque() { int l; asm volatile("v_mbcnt_lo_u32_b32 %0, -1, 0\n\tv_mbcnt_hi_u32_b32 %0, -1, %0" : "=v"(l)); return l; }
__device__ __forceinline__ float wave_sum(float v) {
#pragma unroll
    for (int o = 1; o < 64; o <<= 1) v += __shfl_xor(v, o);
    return v;
}
__device__ __forceinline__ void sincos_d(double x, double& s, double& c) {
    const double TWO_PI = 6.283185307179586476925286766559;
    const double n = __builtin_rint(x * (1.0 / TWO_PI)); const double r = x - n * TWO_PI, r2 = r * r;
    double ts = 1.0, tc = 1.0, ss = 1.0, cc = 1.0;
#pragma unroll 1
    for (int k = 1; k <= 14; ++k) { tc *= -r2 / (double)((2 * k - 1) * (2 * k)); ts *= -r2 / (double)((2 * k) * (2 * k + 1)); cc += tc; ss += ts; }
    s = ss * r; c = cc;
}

template <class RowMap>
__device__ __forceinline__ void transpose_item(const float* W, int K, int N, bf16_t* WT, const RowMap& rm, LAS float* scr, int item, int lane,
                                               const float* gam = nullptr, const float* bet = nullptr, float* cs = nullptr, float* bw = nullptr) {
    const int nblk = N / 32, kb = item / nblk, nb = item % nblk, k0 = 64 * kb, n0 = 32 * nb;
    const int r = lane >> 3, c4 = 4 * (lane & 7);
    f32x4 w[8];
#pragma unroll
    for (int i = 0; i < 8; ++i) w[i] = *(const f32x4*)(W + (size_t)(k0 + 8 * i + r) * N + n0 + c4);
    if (gam) {
        float gk[8], bk[8];
#pragma unroll
        for (int i = 0; i < 8; ++i) { gk[i] = gam[k0 + 8 * i + r]; bk[i] = bet[k0 + 8 * i + r]; }
        f32x4 acs = {0.f, 0.f, 0.f, 0.f}, abw = {0.f, 0.f, 0.f, 0.f};
#pragma unroll
        for (int i = 0; i < 8; ++i) { const int kk = 8 * i + r;
#pragma unroll
            for (int e = 0; e < 4; ++e) { const float gw = bf2f((unsigned short)f2bf(gk[i] * w[i][e])); scr[kk * 33 + c4 + e] = gw; acs[e] += gw; abw[e] += bk[i] * w[i][e]; } }
#pragma unroll
        for (int e = 0; e < 4; ++e) {
#pragma unroll
            for (int o = 8; o < 64; o <<= 1) { acs[e] += __shfl_xor(acs[e], o); abw[e] += __shfl_xor(abw[e], o); } }
        if (lane < 8) {
#pragma unroll
            for (int e = 0; e < 4; ++e) { const int rn = rm(n0 + c4 + e);
                __hip_atomic_fetch_add((int*)cs + rn, (int)rintf(acs[e] * 16777216.f), __ATOMIC_RELAXED, __HIP_MEMORY_SCOPE_AGENT); __hip_atomic_fetch_add((int*)bw + rn, (int)rintf(abw[e] * 16777216.f), __ATOMIC_RELAXED, __HIP_MEMORY_SCOPE_AGENT); } }
    } else {
#pragma unroll
        for (int i = 0; i < 8; ++i)
#pragma unroll
            for (int e = 0; e < 4; ++e) scr[(8 * i + r) * 33 + c4 + e] = w[i][e];
    }
    LDS_WAIT(); asm volatile("" ::: "memory");
    const int c = lane & 7;
#pragma unroll
    for (int j = 0; j < 4; ++j) { const int n = (lane >> 3) + 8 * j; const LAS float* s = scr + (8 * c) * 33 + n;
        u32x4 o; o.x = pk2(s[0 * 33], s[1 * 33]); o.y = pk2(s[2 * 33], s[3 * 33]); o.z = pk2(s[4 * 33], s[5 * 33]); o.w = pk2(s[6 * 33], s[7 * 33]);
        *(u32x4*)(WT + (size_t)rm(n0 + n) * K + k0 + 8 * c) = o; }
    LDS_WAIT(); asm volatile("" ::: "memory");
}
struct RowIdent { int off; __device__ __forceinline__ int operator()(int n) const { return n + off; } };
struct RowRope { __device__ __forceinline__ int operator()(int n) const { if (n >= MIXW + KVW) return n; const int d = n & 127, base = n - d; return base + (d < 64 ? 2 * d : 2 * (d - 64) + 1); } };
struct RowGlu { __device__ __forceinline__ int operator()(int n) const { const int e = n >= MIXW ? 1 : 0, cc = n - e * MIXW; return 8 * (cc >> 2) + 4 * e + (cc & 3); } };

__device__ __forceinline__ void cvt_rows(const Frame& F, const float* src, bf16_t* dst, size_t n8) {
    const size_t st = (size_t)F.G * 512;
    for (size_t i = (size_t)blockIdx.x * 512 + F.tid; i < n8; i += 4 * st) {
        f32x4 a[4], b[4];
#pragma unroll
        for (int u = 0; u < 4; ++u) { const size_t k = i + u * st < n8 ? i + u * st : i; a[u] = *(const f32x4*)(src + k * 8); b[u] = *(const f32x4*)(src + k * 8 + 4); }
#pragma unroll
        for (int u = 0; u < 4; ++u) if (i + u * st < n8) { u32x4 o; o.x = pk2(a[u][0], a[u][1]); o.y = pk2(a[u][2], a[u][3]); o.z = pk2(b[u][0], b[u][1]); o.w = pk2(b[u][2], b[u][3]);
            *(u32x4*)(dst + (i + u * st) * 8) = o; }
    }
}

__device__ __forceinline__ void phase_pr0(const Frame& F, CAP a) {
    unsigned char* ws = a->ws;
    bf16_t* XB = (bf16_t*)(ws + WS_XB);
    cvt_rows(F, a->in[0], XB, (size_t)MROWS_PROMPT * DM / 8);
    cvt_rows(F, a->in[1], XB + (size_t)MROWS_PROMPT * DM, (size_t)(MTOK - MROWS_PROMPT) * DM / 8);
    bf16_t* MEMB = (bf16_t*)(ws + WS_R1 + R1_MEMB);
    cvt_rows(F, a->in[2], MEMB, (size_t)8 * NMEM * DM / 8);
    cvt_rows(F, a->in[3], MEMB + (size_t)8 * NMEM * DM, (size_t)4 * NMEM * DM / 8);
    LAS float* scr = (LAS float*)(F.lds + F.wave * 16384);
    constexpr int I_MKV = (DM / 64) * (1024 / 32);
    for (int it = F.gw; it < 4 * I_MKV; it += F.NGW) { const int l = it / I_MKV, r = it % I_MKV;
        transpose_item(a->in[16] + (size_t)l * DM * 1024, DM, 1024, (bf16_t*)(ws + WS_R1 + R1_WMKV), RowIdent{l * 1024}, scr, r, F.lane); }
    float* rope = (float*)(ws + WS_ROPE);
    for (int i = blockIdx.x * 512 + F.tid; i < SEQ * 64; i += F.G * 512) { const int pos = i >> 6, f = i & 63;
        double inv = 1.0; const double rr = 0.86596432336006535;
        for (int k = 0; k < f; ++k) inv *= rr;
        double s, c; sincos_d((double)pos * inv, s, c); rope[2 * i] = (float)c; rope[2 * i + 1] = (float)s; }
    f32x2* POW = (f32x2*)(ws + WS_POW); f32x2* BBAR = (f32x2*)(ws + WS_BBAR);
    for (int i = blockIdx.x * 512 + F.tid; i < 2 * 2 * SSG * SSP; i += F.G * 512) {
        const int p = i & 63, gdj = i >> 6;
        const double lr = (double)a->in[5][i], li = (double)a->in[6][i];
        const double dt = (double)__expf(a->in[7][gdj]) ;
        double er; { const double x = lr * dt; double t = 1.0; er = 1.0;
#pragma unroll 1
            for (int k = 1; k <= 12; ++k) { t *= x / (double)k; er += t; } }
        double s1, c1; sincos_d(li * dt, s1, c1);
        const double br = er * c1, bi = er * s1;
        double pr = 1.0, pi_ = 0.0;
        for (int e = 0; e <= 16; ++e) { POW[(size_t)i * 17 + e] = (f32x2){(float)pr, (float)pi_}; const double nr = pr * br - pi_ * bi, ni = pr * bi + pi_ * br; pr = nr; pi_ = ni; }
        const double nr_ = br - 1.0, ni_ = bi, den = lr * lr + li * li; const double cr = (nr_ * lr + ni_ * li) / den, ci = (ni_ * lr - nr_ * li) / den;
        f32x4 brv[4], biv[4];
#pragma unroll
        for (int q = 0; q < 4; ++q) { brv[q] = *(const f32x4*)(a->in[8] + (size_t)i * 16 + 4 * q); biv[q] = *(const f32x4*)(a->in[9] + (size_t)i * 16 + 4 * q); }
#pragma unroll
        for (int c = 0; c < SSC; ++c) { const double b_r = (double)brv[c >> 2][c & 3], b_i = (double)biv[c >> 2][c & 3];
            BBAR[(size_t)i * 16 + c] = (f32x2){(float)(cr * b_r - ci * b_i), (float)(cr * b_i + ci * b_r)}; }
    }
}
__device__ __forceinline__ void phase_kt(const Frame& F, CAP a) {
    const f32x2* POW = (const f32x2*)(a->ws + WS_POW); const f32x2* BBAR = (const f32x2*)(a->ws + WS_BBAR); float* KT = (float*)(a->ws + WS_KT);
    for (int i = blockIdx.x * 512 + F.tid; i < 2 * 2 * SSG * 16 * 256; i += F.G * 512) {
        const int cp = i & 15, c = (i >> 4) & 15, tau = (i >> 8) & 15, gdj = i >> 12;
        const float* cre = a->in[10] + ((size_t)gdj * 16 + c) * 64; const float* cim = a->in[11] + ((size_t)gdj * 16 + c) * 64;
        float s = 0.f;
        for (int p = 0; p < SSP; ++p) { const f32x2 pw = POW[((size_t)gdj * 64 + p) * 17 + tau], bb = BBAR[((size_t)gdj * 64 + p) * 16 + cp];
            const float wr_ = pw.x * bb.x - pw.y * bb.y, wi_ = pw.x * bb.y + pw.y * bb.x;
            s += cre[p] * wr_ - cim[p] * wi_; }
        KT[i] = s;
    }
}
__device__ __forceinline__ void phase_wconv(const Frame& F, CAP a, int layer) {
    unsigned char* ws = a->ws; const int j = layer >> 1; const bool attn = layer & 1;
    LAS float* scr = (LAS float*)(F.lds + F.wave * 16384);
    float* csbw = (float*)(ws + WS_CSBW) + (size_t)layer * 32768;
    const int NIN = attn ? 3072 : 2048;
    const int I_IN = (DM / 64) * (NIN / 32), I_GLU = attn ? 0 : (MIXW / 64) * (3072 / 32), I_OUT = (DM / 64) * (DM / 32), I_F1 = (DM / 64) * (DFF / 32), I_F2 = (DFF / 64) * (DM / 32);
    const int NIT = I_IN + I_GLU + I_OUT + I_F1 + I_F2;
    for (int it = F.gw; it < NIT; it += F.NGW) {
        int r = it;
        if (r < I_IN) { const float* gp = layer > 0 ? a->in[22] + (size_t)(layer - 1) * DM : nullptr; const float* bp = layer > 0 ? a->in[23] + (size_t)(layer - 1) * DM : nullptr;
                        if (attn) transpose_item(a->in[14] + (size_t)j * DM * 3072, DM, 3072, (bf16_t*)(ws + WS_WIN), RowRope{}, scr, r, F.lane, gp, bp, csbw + 0, csbw + 8192);
                        else transpose_item(a->in[4] + (size_t)j * DM * DM, DM, DM, (bf16_t*)(ws + WS_WIN), RowIdent{0}, scr, r, F.lane, gp, bp, csbw + 0, csbw + 8192); continue; } r -= I_IN;
        if (r < I_GLU) { transpose_item(a->in[13] + (size_t)j * MIXW * 3072, MIXW, 3072, (bf16_t*)(ws + WS_WGLU), RowGlu{}, scr, r, F.lane); continue; } r -= I_GLU;
        if (r < I_OUT) { transpose_item(a->in[17] + (size_t)layer * DM * DM, DM, DM, (bf16_t*)(ws + WS_WOUT), RowIdent{0}, scr, r, F.lane); continue; } r -= I_OUT;
        if (r < I_F1) { transpose_item(a->in[20] + (size_t)layer * DM * DFF, DM, DFF, (bf16_t*)(ws + WS_WFF1), RowIdent{0}, scr, r, F.lane, a->in[18] + (size_t)layer * DM, a->in[19] + (size_t)layer * DM, csbw + 16384, csbw + 24576); continue; } r -= I_F1;
        transpose_item(a->in[21] + (size_t)layer * DFF * DM, DFF, DM, (bf16_t*)(ws + WS_WFF2), RowIdent{0}, scr, r, F.lane);
    }
    if (!attn) {
        const f32x2* POW = (const f32x2*)(ws + WS_POW) + (size_t)j * 2 * SSG * SSP * 17; const f32x2* BBAR = (const f32x2*)(ws + WS_BBAR) + (size_t)j * 2 * SSG * SSP * 16;
        const float* KT = (const float*)(ws + WS_KT) + (size_t)j * 2 * SSG * 4096;
        const float* CRE = a->in[10] + (size_t)j * 2 * SSG * 1024; const float* CIM = a->in[11] + (size_t)j * 2 * SSG * 1024; const float* DSK = a->in[12] + (size_t)j * MIXW;
        bf16_t* WG = (bf16_t*)(ws + WS_SWG); bf16_t* WY = (bf16_t*)(ws + WS_SWY);
        const int st = F.G * 512;
        for (int i0 = blockIdx.x * 512 + F.tid; i0 < SSG * 256 * 128; i0 += 4 * st) {
            unsigned o[4];
#pragma unroll
            for (int u = 0; u < 4; ++u) { const int i = i0 + u * st < SSG * 256 * 128 ? i0 + u * st : i0;
                const int k2 = (i & 127) * 2, n = (i >> 7) & 255, g = i >> 15; const int dir = n >> 7, comp = n & 1, p = (n & 127) >> 1, s = k2 >> 4, cp = k2 & 15;
                const int e = dir == 0 ? 15 - s : s; const size_t gd = (size_t)(dir * SSG + g) * 64 + p; const f32x2 pw = POW[gd * 17 + e];
                float v[2];
#pragma unroll
                for (int q = 0; q < 2; ++q) { const f32x2 bb = BBAR[gd * 16 + cp + q]; v[q] = comp == 0 ? pw.x * bb.x - pw.y * bb.y : pw.x * bb.y + pw.y * bb.x; }
                o[u] = pk2(v[0], v[1]); }
#pragma unroll
            for (int u = 0; u < 4; ++u) if (i0 + u * st < SSG * 256 * 128) *(unsigned*)(WG + (size_t)(i0 + u * st) * 2) = o[u];
        }
        for (int i0 = blockIdx.x * 512 + F.tid; i0 < SSG * 256 * 256; i0 += 4 * st) {
            unsigned o[4]; const int k2 = (i0 & 255) * 2;
            if (k2 < 256) { const int s = k2 >> 4, cp = k2 & 15;
#pragma unroll
                for (int u = 0; u < 4; ++u) { const int i = i0 + u * st < SSG * 256 * 256 ? i0 + u * st : i0; const int n = (i >> 8) & 255, g = i >> 16, t = n >> 4, c = n & 15;
                    const int df = t - s > 0 ? t - s : 0, db = s - t > 0 ? s - t : 0;
                    const f32x2 kf = *(const f32x2*)(KT + ((size_t)(0 * SSG + g) * 16 + df) * 256 + c * 16 + cp), kb = *(const f32x2*)(KT + ((size_t)(1 * SSG + g) * 16 + db) * 256 + c * 16 + cp);
                    const float dsk = DSK[g * 16 + c];
                    float v0 = 0.f, v1 = 0.f;
                    if (s <= t) { v0 += kf.x; v1 += kf.y; }
                    if (s >= t) { v0 += kb.x; v1 += kb.y; }
                    if (s == t && cp == c) v0 += dsk;
                    if (s == t && cp + 1 == c) v1 += dsk;
                    o[u] = pk2(v0, v1); }
            } else { const int dir = (k2 - 256) >> 7, p = ((k2 - 256) & 127) >> 1;
#pragma unroll
                for (int u = 0; u < 4; ++u) { const int i = i0 + u * st < SSG * 256 * 256 ? i0 + u * st : i0; const int n = (i >> 8) & 255, g = i >> 16, t = n >> 4, c = n & 15;
                    const int e = dir == 0 ? t + 1 : 16 - t;
                    const f32x2 pw = POW[((size_t)(dir * SSG + g) * 64 + p) * 17 + e]; const size_t ci = ((size_t)(dir * SSG + g) * 16 + c) * 64 + p; const float cr = CRE[ci], cim = CIM[ci];
                    o[u] = pk2(cr * pw.x - cim * pw.y, -(cr * pw.y + cim * pw.x)); }
            }
#pragma unroll
            for (int u = 0; u < 4; ++u) if (i0 + u * st < SSG * 256 * 256) *(unsigned*)(WY + (size_t)(i0 + u * st) * 2) = o[u];
        }
    }
}
__device__ __forceinline__ void phase_scan(const Frame& F, CAP a, int j) {
    unsigned char* ws = a->ws; const char* G = (const char*)(ws + WS_R1 + R1_G); char* UH = (char*)(ws + WS_R1 + R1_UH);
    const f32x2* POW = (const f32x2*)(ws + WS_POW) + (size_t)j * 2 * SSG * SSP * 17;
    for (int it = F.wave; ; it += NWAVES) { const int L = it * F.G + (int)blockIdx.x; if (L >= NBATCH * SSG) break;
        const int bg = (L % NBATCH) * SSG + L / NBATCH;
        const int g = bg % SSG, dir = F.lane >> 5, p0 = 2 * (F.lane & 31);
        const f32x2 la = POW[((size_t)(dir * SSG + g) * 64 + p0) * 17 + 16], lb = POW[((size_t)(dir * SSG + g) * 64 + p0 + 1) * 17 + 16];
        const char* gb = G + (size_t)bg * 131072; char* hb = UH + (size_t)bg * 262144 + 512;
        const int sg = dir == 0 ? 512 : -512, g0 = (dir == 0 ? 0 : 255 * 512) + 8 * F.lane, h0 = (dir == 0 ? 0 : 255 * 1024) + 8 * F.lane;
        float ar = 0.f, ai = 0.f, br = 0.f, bi = 0.f;
        u32x2 wa[16], wb[16];
#define SCAN_LOAD(w, kb) _Pragma("unroll") for (int i = 0; i < 16; ++i) w[i] = *(const u32x2*)(gb + (unsigned)(g0 + ((kb) + i) * sg));
#define SCAN_STEPS(w, kb) _Pragma("unroll") for (int i = 0; i < 16; ++i) { u32x2 o; o.x = pg8::cvt_pk_bf16(ar, ai); o.y = pg8::cvt_pk_bf16(br, bi); *(u32x2*)(hb + (unsigned)(h0 + ((kb) + i) * 2 * sg)) = o; \
            const float nar = la.x * ar - la.y * ai + bflo(w[i].x), nai = la.x * ai + la.y * ar + bfhi(w[i].x), nbr = lb.x * br - lb.y * bi + bflo(w[i].y), nbi = lb.x * bi + lb.y * br + bfhi(w[i].y); \
            ar = nar; ai = nai; br = nbr; bi = nbi; }
        SCAN_LOAD(wa, 0)
#pragma unroll 1
        for (int kb = 0; kb < 256; kb += 32) {
            SCAN_LOAD(wb, kb + 16)
            SCAN_STEPS(wa, kb)
            const int kn = kb + 32 < 256 ? kb + 32 : 240;
            SCAN_LOAD(wa, kn)
            SCAN_STEPS(wb, kb + 16)
        }
#undef SCAN_LOAD
#undef SCAN_STEPS
    }
}
__device__ __forceinline__ void phase_finalize(const Frame& F, const float* part, float* st, float* fx = nullptr) {
    if (fx) for (int i = blockIdx.x * 512 + F.tid; i < 16384; i += F.G * 512) fx[i] = (float)((const int*)fx)[i] * 5.9604644775390625e-08f;
    for (int r = blockIdx.x * 512 + F.tid; r < MTOK; r += F.G * 512) { const f32x4* p = (const f32x4*)(part + (size_t)r * 16); const f32x4 a0 = p[0], a1 = p[1], a2 = p[2], a3 = p[3];
        const float S = ((a0[0] + a0[2]) + (a1[0] + a1[2])) + ((a2[0] + a2[2]) + (a3[0] + a3[2])), Q = ((a0[1] + a0[3]) + (a1[1] + a1[3])) + ((a2[1] + a2[3]) + (a3[1] + a3[3]));
        const float mu = S * (1.0f / DM); *(f32x2*)(st + 2 * (size_t)r) = (f32x2){mu, 1.0f / sqrtf(Q * (1.0f / DM) - mu * mu + LN_EPS)}; }
}
template <class Sched> __device__ __forceinline__ void local_row_stats(const Frame& F, const Sched& S, const float* part, float* st, int row_off) {
    pg8::Unit u; int last = -1;
    for (int i = 0; S.next(i, u); ++i) { if (u.pm == last) continue; last = u.pm;
        if (F.tid < 256) { const int r = row_off + u.pm * 256 + F.tid; const f32x4* p = (const f32x4*)(part + (size_t)r * 16); const f32x4 a0 = p[0], a1 = p[1], a2 = p[2], a3 = p[3];
            const float Sm = ((a0[0] + a0[2]) + (a1[0] + a1[2])) + ((a2[0] + a2[2]) + (a3[0] + a3[2])), Q = ((a0[1] + a0[3]) + (a1[1] + a1[3])) + ((a2[1] + a2[3]) + (a3[1] + a3[3]));
            const float mu = Sm * (1.0f / DM); *(f32x2*)(st + 2 * (size_t)r) = (f32x2){mu, 1.0f / sqrtf(Q * (1.0f / DM) - mu * mu + LN_EPS)}; } }
    asm volatile("s_waitcnt vmcnt(0)" ::: "memory"); __syncthreads(); __builtin_amdgcn_fence(__ATOMIC_ACQUIRE, "agent");
}
__device__ __forceinline__ void cvt_fold(const Frame& F, float* fx) { for (int i = blockIdx.x * 512 + F.tid; i < 16384; i += F.G * 512) fx[i] = (float)((const int*)fx)[i] * 5.9604644775390625e-08f; }
__device__ __forceinline__ void phase_ln_final(const Frame& F, const bf16_t* vb, float* out, const float* gam, const float* bet) {
    u32x4 wn[4];
#pragma unroll
    for (int q = 0; q < 4; ++q) wn[q] = ((const u32x4*)(vb + (size_t)(F.gw < MTOK ? F.gw : 0) * DM) + F.lane)[64 * q];
    for (int m = F.gw; m < MTOK; m += F.NGW) {
        u32x4 wc[4];
#pragma unroll
        for (int q = 0; q < 4; ++q) wc[q] = wn[q];
        { const int mn = m + F.NGW < MTOK ? m + F.NGW : m; const u32x4* vr = (const u32x4*)(vb + (size_t)mn * DM) + F.lane;
#pragma unroll
          for (int q = 0; q < 4; ++q) wn[q] = vr[64 * q]; }
        float v[4][8]; float s = 0.f;
#pragma unroll
        for (int q = 0; q < 4; ++q) { const u32x4 w = wc[q]; v[q][0] = bflo(w.x); v[q][1] = bfhi(w.x); v[q][2] = bflo(w.y); v[q][3] = bfhi(w.y); v[q][4] = bflo(w.z); v[q][5] = bfhi(w.z); v[q][6] = bflo(w.w); v[q][7] = bfhi(w.w);
#pragma unroll
            for (int e = 0; e < 8; ++e) s += v[q][e]; }
        const float mean = wave_sum(s) * (1.f / DM); float s2 = 0.f;
#pragma unroll
        for (int q = 0; q < 4; ++q)
#pragma unroll
            for (int e = 0; e < 8; ++e) { v[q][e] -= mean; s2 += v[q][e] * v[q][e]; }
        const float rstd = 1.f / sqrtf(wave_sum(s2) * (1.f / DM) + LN_EPS);
#pragma unroll
        for (int q = 0; q < 4; ++q) { const int c = (F.lane + 64 * q) * 8; float* o = out + (size_t)m * DM + c;
#pragma unroll
            for (int h = 0; h < 2; ++h) { const f32x4 gv = *(const f32x4*)(gam + c + 4 * h), bv = *(const f32x4*)(bet + c + 4 * h);
                *(f32x4*)(o + 4 * h) = (f32x4){v[q][4 * h] * rstd, v[q][4 * h + 1] * rstd, v[q][4 * h + 2] * rstd, v[q][4 * h + 3] * rstd} * gv + bv; } }
    }
}
namespace att {
typedef short s16x4 __attribute__((ext_vector_type(4)));
typedef float f32x16 __attribute__((ext_vector_type(16)));
constexpr float SCALE = 0.088388347648318440f;
constexpr int KVB = 64;
constexpr int SHM_K = KVB * HD * 2, SHM_V = KVB * HD * 2;
constexpr int OFF_V = 0, OFF_K = 2 * SHM_V, OFF_WS = 2 * SHM_V + 2 * SHM_K, OFF_OST = 0;
#define KSWZ(row, colB) ((row) * 256 + ((colB) ^ (((row) & 7) << 4)))
#define SBAR() __builtin_amdgcn_sched_barrier(0)
__device__ __forceinline__ int crow(int r, int hi) { return (r & 3) + 8 * (r >> 2) + 4 * hi; }
__device__ __forceinline__ unsigned cvtpk(float lo, float hi) { unsigned r; asm volatile("v_cvt_pk_bf16_f32 %0, %1, %2" : "=v"(r) : "v"(lo), "v"(hi)); return r; }
__device__ __forceinline__ void partialSM(f32x16& p0, f32x16& p1, float& m_reg, float& mn, float& alpha) {
  constexpr float C = SCALE * 1.4426950408889634f;
  float pmax = p0[0];
#pragma unroll
  for (int r = 1; r < 16; ++r) pmax = fmaxf(pmax, p0[r]);
#pragma unroll
  for (int r = 0; r < 16; ++r) pmax = fmaxf(pmax, p1[r]);
  { auto rr = __builtin_amdgcn_permlane32_swap(__float_as_uint(pmax), __float_as_uint(pmax), false, false);
    pmax = fmaxf(__uint_as_float(rr[0]), __uint_as_float(rr[1])); }
  if (__all(pmax <= m_reg)) { mn = m_reg; alpha = 1.f; }
  else { mn = fmaxf(m_reg, pmax); alpha = __builtin_amdgcn_exp2f((m_reg - mn) * C); m_reg = mn; }
  const float mnC = -mn * C;
#pragma unroll
  for (int r = 0; r < 16; ++r) p0[r] = __builtin_amdgcn_exp2f(fmaf(p0[r], C, mnC));
#pragma unroll
  for (int r = 0; r < 16; ++r) p1[r] = __builtin_amdgcn_exp2f(fmaf(p1[r], C, mnC));
}
__device__ __forceinline__ void finishSM(f32x16& p0, f32x16& p1, float alpha, float& l_reg, bf16x8& pa0, bf16x8& pa1, bf16x8& pa2, bf16x8& pa3) {
  float ps = 0;
#pragma unroll
  for (int r = 0; r < 16; ++r) ps += p0[r];
#pragma unroll
  for (int r = 0; r < 16; ++r) ps += p1[r];
  { auto rr = __builtin_amdgcn_permlane32_swap(__float_as_uint(ps), __float_as_uint(ps), false, false);
    ps = __uint_as_float(rr[0]) + __uint_as_float(rr[1]); }
  l_reg = l_reg * alpha + ps;
#define PK4(P, BASE, OUT) do { unsigned a0 = cvtpk(P[BASE + 0], P[BASE + 1]), a1 = cvtpk(P[BASE + 2], P[BASE + 3]);   \
    unsigned b0 = cvtpk(P[BASE + 4], P[BASE + 5]), b1 = cvtpk(P[BASE + 6], P[BASE + 7]);                              \
    auto r0 = __builtin_amdgcn_permlane32_swap(a0, b0, false, false); auto r1 = __builtin_amdgcn_permlane32_swap(a1, b1, false, false); \
    u32x4 w = {r0[0], r1[0], r0[1], r1[1]}; OUT = *reinterpret_cast<bf16x8*>(&w); } while (0)
  PK4(p0, 0, pa0); PK4(p0, 8, pa1); PK4(p1, 0, pa2); PK4(p1, 8, pa3);
#undef PK4
}
__device__ __forceinline__ void qkt(f32x16& p0, f32x16& p1, const LAS char* Ks, const bf16x8* qr, int r32, int hi) {
  p0 = f32x16{}; p1 = f32x16{};
#pragma unroll
  for (int d0 = 0; d0 < 8; ++d0) { const int cb = (d0 * 16 + hi * 8) * 2;
    const bf16x8 b0 = *reinterpret_cast<const LAS bf16x8*>(Ks + KSWZ(r32, cb));
    const bf16x8 b1 = *reinterpret_cast<const LAS bf16x8*>(Ks + KSWZ(32 + r32, cb));
    p0 = __builtin_amdgcn_mfma_f32_32x32x16_bf16(b0, qr[d0], p0, 0, 0, 0);
    p1 = __builtin_amdgcn_mfma_f32_32x32x16_bf16(b1, qr[d0], p1, 0, 0, 0); }
}
__device__ __forceinline__ int v_st(int k, int c) { const int kk = (k & ~0xC) | ((k & 4) << 1) | ((k & 8) >> 1); return ((kk >> 3) * 4 + (c >> 5)) * 512 + ((kk & 7) * 32 + (c & 31)) * 2; }
__device__ __forceinline__ int v_rd_base(int lane) { return ((lane & 3) << 3) | (((lane >> 2) & 3) << 6) | (((lane >> 4) & 1) << 5) | (((lane >> 5) & 1) << 8); }
constexpr int v_rd_off(int d0, int ks, int half) { return d0 * 512 + ks * 4096 + half * 2048; }
template <int OFF> __device__ __forceinline__ s16x4 tr_read(int vb) { s16x4 r; asm volatile("ds_read_b64_tr_b16 %0, %1 offset:%2" : "=&v"(r) : "v"(vb), "i"(OFF) : "memory"); return r; }
template <int D0> __device__ __forceinline__ void pv_one(f32x16& od, int vb, bf16x8 pa0, bf16x8 pa1, bf16x8 pa2, bf16x8 pa3) {
  const s16x4 l0 = tr_read<v_rd_off(D0, 0, 0)>(vb), h0 = tr_read<v_rd_off(D0, 0, 1)>(vb), l1 = tr_read<v_rd_off(D0, 1, 0)>(vb), h1 = tr_read<v_rd_off(D0, 1, 1)>(vb);
  const s16x4 l2 = tr_read<v_rd_off(D0, 2, 0)>(vb), h2 = tr_read<v_rd_off(D0, 2, 1)>(vb), l3 = tr_read<v_rd_off(D0, 3, 0)>(vb), h3 = tr_read<v_rd_off(D0, 3, 1)>(vb);
  asm volatile("s_waitcnt lgkmcnt(0)" ::: "memory"); SBAR();
#define PKV(L, H) (bf16x8){L[0], L[1], L[2], L[3], H[0], H[1], H[2], H[3]}
  od = __builtin_amdgcn_mfma_f32_32x32x16_bf16(pa0, PKV(l0, h0), od, 0, 0, 0);
  od = __builtin_amdgcn_mfma_f32_32x32x16_bf16(pa1, PKV(l1, h1), od, 0, 0, 0);
  od = __builtin_amdgcn_mfma_f32_32x32x16_bf16(pa2, PKV(l2, h2), od, 0, 0, 0);
  od = __builtin_amdgcn_mfma_f32_32x32x16_bf16(pa3, PKV(l3, h3), od, 0, 0, 0);
#undef PKV
}
__device__ __forceinline__ void mask_tile(f32x16& p0, f32x16& p1, int dq) {
  const float NEG = -__builtin_inff();
#pragma unroll
  for (int r = 0; r < 16; ++r) { const int c = (r & 3) + 8 * (r >> 2);
    if ((unsigned)(dq - c) >= 257u) p0[r] = NEG;
    if ((unsigned)(dq - c - 32) >= 257u) p1[r] = NEG; }
}
__device__ __forceinline__ void partialSM2(f32x16& p0, f32x16& p1, float& m_reg, float& mn, float& alpha) {
  float pmax = p0[0];
#pragma unroll
  for (int r = 1; r < 16; ++r) pmax = fmaxf(pmax, p0[r]);
#pragma unroll
  for (int r = 0; r < 16; ++r) pmax = fmaxf(pmax, p1[r]);
  { auto rr = __builtin_amdgcn_permlane32_swap(__float_as_uint(pmax), __float_as_uint(pmax), false, false);
    pmax = fmaxf(__uint_as_float(rr[0]), __uint_as_float(rr[1])); }
  constexpr float C2 = 1.4426950408889634f * SCALE;
  if (__builtin_expect(__all(pmax <= m_reg), 1)) { mn = m_reg; alpha = 1.f; }
  else { mn = fmaxf(m_reg, pmax); alpha = __builtin_amdgcn_exp2f((m_reg - mn) * C2); m_reg = mn; }
  const float mnL = -mn * C2;
#pragma unroll
  for (int r = 0; r < 16; ++r) p0[r] = fmaf(p0[r], C2, mnL);
#pragma unroll
  for (int r = 0; r < 16; ++r) p1[r] = fmaf(p1[r], C2, mnL);
#pragma unroll
  for (int r = 0; r < 16; ++r) p0[r] = __builtin_amdgcn_exp2f(p0[r]);
}
__device__ __forceinline__ void finishSM2(f32x16& p0, f32x16& p1, float alpha, float& l_reg, bf16x8& pa0, bf16x8& pa1, bf16x8& pa2, bf16x8& pa3) {
#pragma unroll
  for (int r = 0; r < 16; ++r) p1[r] = __builtin_amdgcn_exp2f(p1[r]);
  float ps = 0;
#pragma unroll
  for (int r = 0; r < 16; ++r) ps += p0[r];
#pragma unroll
  for (int r = 0; r < 16; ++r) ps += p1[r];
  { auto rr = __builtin_amdgcn_permlane32_swap(__float_as_uint(ps), __float_as_uint(ps), false, false);
    ps = __uint_as_float(rr[0]) + __uint_as_float(rr[1]); }
  l_reg = l_reg * alpha + ps;
#define PK4(P, B_, OUT) do { unsigned a0 = cvtpk(P[B_+0], P[B_+1]), a1 = cvtpk(P[B_+2], P[B_+3]);                          \
      unsigned b0 = cvtpk(P[B_+4], P[B_+5]), b1 = cvtpk(P[B_+6], P[B_+7]);                                             \
      auto r0 = __builtin_amdgcn_permlane32_swap(a0, b0, false, false); auto r1 = __builtin_amdgcn_permlane32_swap(a1, b1, false, false); \
      u32x4 w = {r0[0], r1[0], r0[1], r1[1]}; OUT = *reinterpret_cast<bf16x8*>(&w); } while (0)
  PK4(p0, 0, pa0); PK4(p0, 8, pa1); PK4(p1, 0, pa2); PK4(p1, 8, pa3);
#undef PK4
}
template <int KB, bool SK>
__device__ __forceinline__ void qkt2(f32x16& p0, f32x16& p1, const LAS char* K_lds, int r32, int hi, const bf16x8* qr, bool act) {
  if (SK && !act) { const float NEG = -__builtin_inff();
#pragma unroll
    for (int r = 0; r < 16; ++r) { p0[r] = NEG; p1[r] = NEG; } return; }
  p0 = f32x16{}; p1 = f32x16{};
  const LAS char* kb[4];
#pragma unroll
  for (int dd = 0; dd < 4; ++dd) kb[dd] = K_lds + KB * SHM_K + KSWZ(r32, (dd * 16 + hi * 8) * 2);
#pragma unroll
  for (int d0 = 0; d0 < 8; ++d0) { const LAS char* a = kb[d0 & 3] + (d0 >> 2) * 128;
    const bf16x8 b0 = *reinterpret_cast<const LAS bf16x8*>(a);
    const bf16x8 b1 = *reinterpret_cast<const LAS bf16x8*>(a + 32 * 256);
    p0 = __builtin_amdgcn_mfma_f32_32x32x16_bf16(b0, qr[d0], p0, 0, 0, 0);
    p1 = __builtin_amdgcn_mfma_f32_32x32x16_bf16(b1, qr[d0], p1, 0, 0, 0); }
}
template <int VB, bool SK>
__device__ __forceinline__ void pv_tile2(f32x16* o, int vb0, bf16x8 pa0, bf16x8 pa1, bf16x8 pa2, bf16x8 pa3, bool act) {
  if (SK && !act) return;
#define TRRD(dst, off) asm volatile("ds_read_b64_tr_b16 %0, %1 offset:%2" : "=&v"(dst) : "v"(vb0), "i"(off) : "memory")
#define PV_D0(d0) do { s16x4 l0, l1, l2, l3, h0, h1, h2, h3; constexpr int b_ = VB * SHM_V + v_rd_off(d0, 0, 0); \
      TRRD(l0, b_); TRRD(h0, b_ + 2048); TRRD(l1, b_ + 4096); TRRD(h1, b_ + 6144); TRRD(l2, b_ + 8192); TRRD(h2, b_ + 10240); TRRD(l3, b_ + 12288); TRRD(h3, b_ + 14336); \
      asm volatile("s_waitcnt lgkmcnt(0)" ::: "memory"); SBAR(); \
      o[d0] = __builtin_amdgcn_mfma_f32_32x32x16_bf16(pa0, (bf16x8){l0[0], l0[1], l0[2], l0[3], h0[0], h0[1], h0[2], h0[3]}, o[d0], 0, 0, 0);   \
      o[d0] = __builtin_amdgcn_mfma_f32_32x32x16_bf16(pa1, (bf16x8){l1[0], l1[1], l1[2], l1[3], h1[0], h1[1], h1[2], h1[3]}, o[d0], 0, 0, 0);   \
      o[d0] = __builtin_amdgcn_mfma_f32_32x32x16_bf16(pa2, (bf16x8){l2[0], l2[1], l2[2], l2[3], h2[0], h2[1], h2[2], h2[3]}, o[d0], 0, 0, 0);   \
      o[d0] = __builtin_amdgcn_mfma_f32_32x32x16_bf16(pa3, (bf16x8){l3[0], l3[1], l3[2], l3[3], h3[0], h3[1], h3[2], h3[3]}, o[d0], 0, 0, 0); } while (0)
  PV_D0(0); PV_D0(1); PV_D0(2); PV_D0(3);
#undef PV_D0
#undef TRRD
}
struct Seam { bf16x8 qr[8]; bf16x8 st_v0, st_v1, st_k0, st_k1; };
constexpr int OFF2_V = 0, OFF2_K = 2 * SHM_V, OFF2_WS = 2 * SHM_V + 2 * SHM_K, OFF2_OST = OFF2_WS + 8 * 256;
template <bool WIN, int LDQ, int LDK, int LDO, class Gen>
__device__ __forceinline__ void attn_units(LAS char* lds, int wid, int lane, const Gen& G, int u0, int ustride, int ucount) {
  if (u0 >= ucount) return;
  constexpr bool SK = WIN;
  const int tid = wid * 64 + lane, r32 = lane & 31, hi = lane >> 5;
  LAS char* V_lds = lds + OFF2_V; LAS char* K_lds = lds + OFF2_K;
  LAS float* wsf = (LAS float*)(lds + OFF2_WS) + wid * 64; LAS float* li_l = wsf; LAS float* al_l = wsf + 32;
  LAS char* ost = lds + OFF2_OST + wid * 4096;
  const int sr = tid >> 4, sc = (tid & 15) * 8, vst0 = v_st(sr, sc), vst1 = v_st(32 + sr, sc), kws = KSWZ(sr, sc * 2);
  const int vb0 = (int)(unsigned)(size_t)V_lds + v_rd_base(lane);
  const unsigned kvo0 = (unsigned)((sr * LDK + sc) * 2), kvo1 = (unsigned)(((32 + sr) * LDK + sc) * 2), qo = (unsigned)((((wid * 32 + r32) * LDQ) + hi * 8) * 2);
  Seam S;
#define VMW() asm volatile("s_waitcnt vmcnt(0)" ::: "memory")
#define VMWN(n) asm volatile("s_waitcnt vmcnt(%0)" :: "i"(n) : "memory")
#define SLOAD_H(Kp, Vp, k0) do { const char* kb_ = (const char*)((Kp) + (size_t)(k0) * LDK); const char* vb_ = (const char*)((Vp) + (size_t)(k0) * LDK);     \
                                 S.st_v0 = *(const bf16x8*)(vb_ + kvo0); S.st_v1 = *(const bf16x8*)(vb_ + kvo1); S.st_k0 = *(const bf16x8*)(kb_ + kvo0); S.st_k1 = *(const bf16x8*)(kb_ + kvo1); } while (0)
#define SWRITE_HK(bf) do { *(LAS bf16x8*)(K_lds + (bf) * SHM_K + kws) = S.st_k0; *(LAS bf16x8*)(K_lds + (bf) * SHM_K + kws + 32 * 256) = S.st_k1; } while (0)
#define SWRITE_HV(bf) do { *(LAS bf16x8*)(V_lds + (bf) * SHM_V + vst0) = S.st_v0; *(LAS bf16x8*)(V_lds + (bf) * SHM_V + vst1) = S.st_v1; } while (0)
#define SWRITE_H(bf) do { SWRITE_HV(bf); SWRITE_HK(bf); } while (0)
#define LOADQ(P) do { const char* qb_ = (const char*)G.qb(P); _Pragma("unroll") for (int d0 = 0; d0 < 8; ++d0) S.qr[d0] = *(const bf16x8*)(qb_ + qo + d0 * 32); } while (0)
#define UMAP(uu) ((ucount % 8 == 0 && ustride % 8 == 0) ? (((uu) % ustride) & 7) * (ucount / 8) + ((uu) / ustride) * (ustride / 8) + (((uu) % ustride) >> 3) : (uu))
  int c = __builtin_amdgcn_readfirstlane(UMAP(u0));
  { LOADQ(c); const int kb0 = G.t_lo(c) * KVB; SLOAD_H(G.kh(c), G.vh(c), kb0); VMW(); SWRITE_HK(0); }
  __syncthreads();
  for (int u = u0; u < ucount; u += ustride) {
    const bool has_next = u + ustride < ucount; const int n = __builtin_amdgcn_readfirstlane(has_next ? UMAP(u + ustride) : c);
    const int j_lo = G.t_lo(c), NT = G.t_hi(c) - j_lo;
    const int kbn = G.t_lo(n) * KVB;
    const int qlo = G.qpos0(c) + wid * 32, qm = qlo + r32 - 4 * hi + 128;
    float m_reg = G.m_init(c), l_reg = G.l_init(); f32x16 o[4] = {};
    const bf16_t* Kh = G.kh(c); const bf16_t* Vh = G.vh(c);
#define RESC(a) do { if (__any((a) < 1.f)) { if (hi == 0) al_l[r32] = (a); asm volatile("s_waitcnt lgkmcnt(0)" ::: "memory");              \
                     _Pragma("unroll") for (int d_ = 0; d_ < 4; ++d_) _Pragma("unroll") for (int r = 0; r < 16; ++r) o[d_][r] *= al_l[crow(r, hi)]; } } while (0)
#define KBASE(t) ((j_lo + (t)) * KVB)
#define ACT(t) (!WIN || (KBASE(t) <= qlo + 31 + 128 && KBASE(t) + KVB - 1 >= qlo - 128))
#define MASKT(P0_, P1_, t) do { if (WIN) { const int kb_ = KBASE(t); if (ACT(t) && !(kb_ >= qlo - 97 && kb_ <= qlo + 65)) mask_tile(P0_, P1_, qm - kb_); } } while (0)
#define SEAM_K0() do { VMWN(8); SWRITE_HK(0); SBAR(); } while (0)
    f32x16 pA0, pA1, pB0, pB1; float mnA, mnB, alA, alB; bf16x8 pa0, pa1, pa2, pa3;
    SWRITE_HV(0); SBAR();
    if (NT > 1) SLOAD_H(Kh, Vh, KBASE(1));
    SBAR(); qkt2<0, SK>(pA0, pA1, K_lds, r32, hi, S.qr, ACT(0));
    MASKT(pA0, pA1, 0); partialSM2(pA0, pA1, m_reg, mnA, alA);
    if (NT > 1) { VMW(); SWRITE_H(1); }
    __syncthreads();
#define HALF_STEP(PX0, PX1, mnX, alX, PY0, PY1, alY, t, KB, VB, SB) do {                                                      \
        SBAR(); qkt2<KB, SK>(PX0, PX1, K_lds, r32, hi, S.qr, ACT(t));                                                         \
        finishSM2(PY0, PY1, alY, l_reg, pa0, pa1, pa2, pa3); SBAR();                                                          \
        if ((t) + 1 < NT) { SLOAD_H(Kh, Vh, KBASE((t) + 1)); SBAR(); }                                                        \
        pv_tile2<VB, SK>(o, vb0, pa0, pa1, pa2, pa3, ACT((t) - 1)); MASKT(PX0, PX1, (t)); partialSM2(PX0, PX1, m_reg, mnX, alX); \
        __syncthreads();                                                                                                      \
        if ((t) + 1 < NT) { VMW(); SWRITE_H(SB); }                                                                            \
        RESC(alX); __syncthreads(); } while (0)
    for (int t = 1; t + 1 < NT; t += 2) {
      HALF_STEP(pB0, pB1, mnB, alB, pA0, pA1, alA, t, 1, 0, 0);
      HALF_STEP(pA0, pA1, mnA, alA, pB0, pB1, alB, t + 1, 0, 1, 1);
    }
    const bool even = (NT & 1) == 0;
    if (even) { SBAR(); qkt2<1, SK>(pB0, pB1, K_lds, r32, hi, S.qr, ACT(NT - 1)); SBAR(); }
    SLOAD_H(G.kh(n), G.vh(n), kbn); SBAR();
    LOADQ(n);
    SBAR();
    finishSM2(pA0, pA1, alA, l_reg, pa0, pa1, pa2, pa3); SBAR();
    pv_tile2<0, SK>(o, vb0, pa0, pa1, pa2, pa3, ACT(even ? NT - 2 : NT - 1));
    if (even) { MASKT(pB0, pB1, NT - 1); partialSM2(pB0, pB1, m_reg, mnB, alB); __syncthreads(); RESC(alB);
      finishSM2(pB0, pB1, alB, l_reg, pa0, pa1, pa2, pa3); SBAR(); pv_tile2<1, SK>(o, vb0, pa0, pa1, pa2, pa3, ACT(NT - 1)); }
    SBAR(); SEAM_K0();
    if (hi == 0) li_l[r32] = l_reg; asm volatile("s_waitcnt lgkmcnt(0)" ::: "memory");
    char* obase = (char*)(G.ob(c) + (size_t)(wid * 32) * LDO); const unsigned loff = (unsigned)(((lane >> 4) * LDO + (lane & 15) * 8) * 2);
#pragma unroll
    for (int hf = 0; hf < 2; ++hf) {
#pragma unroll
      for (int rr = 0; rr < 8; ++rr) { const int r = hf * 8 + rr; const int orow = crow(r, hi); const float rl = __builtin_amdgcn_rcpf(li_l[orow]);
#pragma unroll
        for (int d0 = 0; d0 < 4; ++d0) *(LAS unsigned short*)(ost + (orow & 15) * 256 + (d0 * 32 + r32) * 2) = (unsigned short)f2bf(o[d0][r] * rl); }
      asm volatile("s_waitcnt lgkmcnt(0)" ::: "memory");
#pragma unroll
      for (int i = 0; i < 4; ++i) { const int ch = i * 64 + lane, row = ch >> 4, c16 = ch & 15;
        const u32x4 v = *(const LAS u32x4*)(ost + row * 256 + c16 * 16); *(u32x4*)(obase + (size_t)((hf * 16 + i * 4) * LDO * 2) + loff) = v; }
      asm volatile("s_waitcnt lgkmcnt(0)" ::: "memory");
    }
    __syncthreads();
    c = n;
#undef RESC
#undef KBASE
#undef ACT
#undef MASKT
#undef SEAM_K0
#undef HALF_STEP
  }
#undef VMW
#undef VMWN
#undef SLOAD_H
#undef SWRITE_HK
#undef SWRITE_HV
#undef SWRITE_H
#undef LOADQ
#undef UMAP
}
#undef KSWZ
#undef SBAR
}
struct GenWin {
    const bf16_t* Q; const bf16_t* Kb; const bf16_t* Vb; bf16_t* O; const float* sink;
    __device__ __forceinline__ int qblk(int u) const { return (u / 3) & 15; }
    __device__ __forceinline__ int head(int u) const { return ((u / 48) & 3) * 3 + u % 3; }
    __device__ __forceinline__ size_t row0(int u) const { return (size_t)(u / 192) * SEQ + 256 * qblk(u); }
    __device__ __forceinline__ const bf16_t* qb(int u) const { return Q + row0(u) * MIXW + head(u) * HD; }
    __device__ __forceinline__ const bf16_t* kh(int u) const { return Kb + (size_t)(u / 192) * SEQ * KVW + ((u / 48) & 3) * HD; }
    __device__ __forceinline__ const bf16_t* vh(int u) const { return Vb + (size_t)(u / 192) * SEQ * KVW + ((u / 48) & 3) * HD; }
    __device__ __forceinline__ bf16_t* ob(int u) const { return O + row0(u) * DM + head(u) * HD; }
    __device__ __forceinline__ int t_lo(int u) const { const int q = qblk(u); return 4 * q - 2 < 0 ? 0 : 4 * q - 2; }
    __device__ __forceinline__ int t_hi(int u) const { const int q = qblk(u); return 4 * q + 6 > 64 ? 64 : 4 * q + 6; }
    __device__ __forceinline__ int qpos0(int u) const { return 256 * qblk(u); }
    __device__ __forceinline__ float m_init(int u) const { return sink[head(u)] * (1.0f / att::SCALE); }
    __device__ __forceinline__ float l_init() const { return 1.0f; }
};
__device__ __forceinline__ void phase_attn_mfma(const Frame& F, CAP a, int jl) {
    unsigned char* ws = a->ws;
    const GenWin G{(const bf16_t*)(ws + WS_R1 + R1_Q), (const bf16_t*)(ws + WS_R1 + R1_K), (const bf16_t*)(ws + WS_R1 + R1_V), (bf16_t*)(ws + WS_R1 + R1_CONCAT), a->in[15] + (size_t)jl * NQH};
    att::attn_units<true, MIXW, KVW, DM>((LAS char*)F.lds, F.wave, F.lane, G, (int)blockIdx.x, F.G, NBATCH * NQH * 16);
}
struct GenMem {
    const bf16_t* QM; const bf16_t* KV; bf16_t* O; int layer;
    __device__ __forceinline__ size_t row0(int u) const { return (size_t)(u >> 6) * SEQ + 256 * (u & 15); }
    __device__ __forceinline__ const bf16_t* qb(int u) const { return QM + row0(u) * MEMW + ((u >> 4) & 3) * HD; }
    __device__ __forceinline__ const bf16_t* kh(int u) const { return KV + (size_t)(u >> 6) * NMEM * 4096 + layer * 1024 + ((u >> 4) & 3) * HD; }
    __device__ __forceinline__ const bf16_t* vh(int u) const { return kh(u) + 512; }
    __device__ __forceinline__ bf16_t* ob(int u) const { return O + row0(u) * DM + MIXW + ((u >> 4) & 3) * HD; }
    __device__ __forceinline__ int t_lo(int) const { return 0; }
    __device__ __forceinline__ int t_hi(int) const { return 4; }
    __device__ __forceinline__ int qpos0(int) const { return 0; }
    __device__ __forceinline__ float m_init(int) const { return -1e30f; }
    __device__ __forceinline__ float l_init() const { return 0.f; }
};
__device__ __forceinline__ void phase_memattn_mfma(const Frame& F, CAP a, int layer, bf16_t* O) {
    unsigned char* ws = a->ws;
    const GenMem G{(const bf16_t*)(ws + WS_R1 + R1_QM), (const bf16_t*)(ws + WS_MEMKV), O, layer};
    att::attn_units<false, MEMW, 4096, DM>((LAS char*)F.lds, F.wave, F.lane, G, (int)blockIdx.x, F.G, NBATCH * 4 * 16);
}

__device__ __forceinline__ CAP get_args() { CAP p = (CAP)__builtin_amdgcn_kernarg_segment_ptr(); asm volatile("" : "+s"(p)); return p; }
__device__ __forceinline__ bool run_ok(int id) { CAP a = get_args(); return a->lin_lo <= id && id < a->lin_hi; }
__device__ __forceinline__ Frame make_frame(unsigned char* lds_raw, int wave_s) {
    Frame F; const int l_ = lane_id_opaque();
    F.lds = (LAS unsigned char*)lds_raw; F.lane = l_; F.wave = wave_s; F.tid = wave_s * 64 + l_;
    F.G = gridDim.x; F.gw = blockIdx.x * NWAVES + F.wave; F.NGW = F.G * NWAVES; return F;
}
__global__ void __launch_bounds__(NWAVES * 64, 2) mk_fwd(Args args_unused) {
    extern __shared__ __attribute__((aligned(16))) unsigned char lds_raw[];
    int wave_s = __builtin_amdgcn_readfirstlane((int)threadIdx.x >> 6); asm volatile("" : "+s"(wave_s));
    { const int t = wave_s * 64 + lane_id_opaque(); for (int u = t; u < (LDS_BYTES - LDSCTL_OFF) / 4; u += NWAVES * 64) ((LAS unsigned*)((LAS unsigned char*)lds_raw + LDSCTL_OFF))[u] = 0u; }
    __syncthreads();
#if !MK_MULTI
    { CAP a = get_args(); if (wave_s == 0 && lane_id_opaque() == 0 && xb_xcc_id() != (blockIdx.x & 7u)) (void)xb_add((unsigned*)(a->ws + WS_CTL) + CW_BAR + GB_FLAG, 1u); }
    { CAP a = get_args(); (void)xcd_barrier_post((unsigned*)(a->ws + WS_CTL) + CW_BAR, (volatile LAS unsigned*)((LAS unsigned char*)lds_raw + MISC_OFF) + 8, wave_s == 0 && lane_id_opaque() == 0); }
#define SEAM() do { CAP a_ = get_args(); XcdBarrier bar_; bar_.bar = (unsigned*)(a_->ws + WS_CTL) + CW_BAR; bar_.x = xb_xcc_id(); bar_.st = (volatile LAS unsigned*)((LAS unsigned char*)lds_raw + MISC_OFF) + 8; xcd_barrier(bar_, wave_s == 0 && lane_id_opaque() == 0); } while (0)
#define GSEAM() do { CAP a_ = get_args(); unsigned* gb_ = (unsigned*)(a_->ws + WS_CTL) + CW_BAR; \
        const bool fast_ = (gridDim.x & 7u) == 0u && (MTOK / NSPLIT / pg8::BM / pg8::WGM) % pg8::NXCD == 0 && __builtin_amdgcn_readfirstlane(xb_ld(&gb_[GB_FLAG])) == 0u; \
        if (fast_) group_barrier(gb_, wave_s == 0 && lane_id_opaque() == 0); else SEAM(); } while (0)
#else
#define SEAM() do {} while (0)
#define GSEAM() do {} while (0)
#endif
#define RUN(id) run_ok(id)
#define PH() CAP a = get_args(); Frame F = make_frame(lds_raw, wave_s); unsigned char* const ws = a->ws; (void)ws; (void)F
#define STATS(which) ((float*)(ws + WS_STATS) + (size_t)(which) * MTOK * 2)
#define PARTP ((float*)(ws + WS_PART))
#define CSBW(l) ((float*)(ws + WS_CSBW) + (size_t)(l) * 32768)

    if (RUN(0)) { PH(); phase_pr0(F, a); } SEAM();
    if (RUN(1)) {
        { PH();
        pg8::GemmPlain g{(const bf16_t*)(ws + WS_R1 + R1_MEMB), (const bf16_t*)(ws + WS_R1 + R1_WMKV), DM, DM};
        pg8::StaticOrder S; S.init(NMEMROWS, 4096, F.G, (int)blockIdx.x);
        pg8::EpiPlainBf16 E{(bf16_t*)(ws + WS_MEMKV), 4096};
        pg8::gemm_phase(F.lds, F.wave, g, S, E); }
        { PH(); phase_kt(F, a); }
    } SEAM();

    { constexpr int layer = 0; constexpr int base = 2 + 32 * layer; constexpr bool attn = layer & 1; constexpr int j = layer >> 1; (void)j;

                if constexpr (layer == 0) { if (RUN(base + 0)) { PH(); phase_wconv(F, a, layer); } SEAM(); }
        if constexpr (!attn) {
                    if (RUN(base + 1)) { PH();
                cvt_fold(F, CSBW(layer) + 16384);
                pg8::GemmPlain g{(const bf16_t*)(ws + WS_XB), (const bf16_t*)(ws + WS_WIN), DM, DM}; pg8::StaticOrder S; S.init(MTOK, 2048, F.G, (int)blockIdx.x);
                pg8::EpiInSsm<(layer > 0)> E{(bf16_t*)(ws + WS_R1 + R1_UH), (bf16_t*)(ws + WS_R1 + R1_QM), pg8::Fold{STATS(1), CSBW(layer), CSBW(layer) + 8192}};
                pg8::gemm_phase(F.lds, F.wave, g, S, E);
            } SEAM();
        if (RUN(base + 2)) {
            { PH();
                pg8::GemmSsm g{(const bf16_t*)(ws + WS_R1 + R1_UH), (const bf16_t*)(ws + WS_SWG), 256, 512}; pg8::SsmOrder S{F.G, (int)blockIdx.x};
                pg8::EpiG1 E{(bf16_t*)(ws + WS_R1 + R1_G)};
                pg8::gemm_phase(F.lds, F.wave, g, S, E); }
            __builtin_amdgcn_fence(__ATOMIC_ACQUIRE, "agent");
            { PH(); phase_scan(F, a, j); }
            asm volatile("s_waitcnt vmcnt(0)" ::: "memory"); __syncthreads(); __builtin_amdgcn_fence(__ATOMIC_ACQUIRE, "agent");
            { PH();
                pg8::GemmSsm g{(const bf16_t*)(ws + WS_R1 + R1_UH), (const bf16_t*)(ws + WS_SWY), 512, 512}; pg8::SsmOrder S{F.G, (int)blockIdx.x};
                pg8::EpiG2 E{(bf16_t*)(ws + WS_R1 + R1_Z)};
                pg8::gemm_phase(F.lds, F.wave, g, S, E); }
        } SEAM();
            constexpr size_t ZOFF = WS_R1 + R1_Z, CCOFF = WS_R1 + R1_CONCAT;
                    if (RUN(base + 5)) {
                { PH();
                pg8::GemmPlain g{(const bf16_t*)(ws + ZOFF), (const bf16_t*)(ws + WS_WGLU), MIXW, MIXW}; pg8::StaticOrder S; S.init(MTOK, 3072, F.G, (int)blockIdx.x);
                pg8::EpiGlu E{(bf16_t*)(ws + CCOFF)};
                pg8::gemm_phase(F.lds, F.wave, g, S, E); }
                { PH(); phase_memattn_mfma(F, a, layer, (bf16_t*)(ws + CCOFF)); }
            } SEAM();
                    if (RUN(base + 6)) { PH();
                pg8::GemmPlain g{(const bf16_t*)(ws + CCOFF), (const bf16_t*)(ws + WS_WOUT), DM, DM}; pg8::StaticOrder S; S.init(MTOK, DM, F.G, (int)blockIdx.x);
                if constexpr (layer == 0) { pg8::EpiResidB<0> E{a->in[0], a->in[1], MROWS_PROMPT, nullptr, nullptr, nullptr, (bf16_t*)(ws + WS_XB), PARTP, 0, F.lds};
                    pg8::gemm_phase(F.lds, F.wave, g, S, E); }
                else { constexpr int lp = layer > 0 ? layer - 1 : 0; pg8::EpiResidB<1> E{nullptr, nullptr, 0, STATS(1), a->in[22] + (size_t)lp * DM, a->in[23] + (size_t)lp * DM, (bf16_t*)(ws + WS_XB), PARTP, 0, F.lds};
                    pg8::gemm_phase(F.lds, F.wave, g, S, E); }
            } SEAM();
        } else {
                    if (RUN(base + 1)) { PH();
                cvt_fold(F, CSBW(layer) + 16384);
                pg8::GemmPlain g{(const bf16_t*)(ws + WS_XB), (const bf16_t*)(ws + WS_WIN), DM, DM}; pg8::StaticOrder S; S.init(MTOK, 3072, F.G, (int)blockIdx.x);
                pg8::EpiInAttn<true> E{ws + WS_R1, (const float*)(ws + WS_ROPE), pg8::Fold{STATS(1), CSBW(layer), CSBW(layer) + 8192}};
                pg8::gemm_phase(F.lds, F.wave, g, S, E);
            } SEAM();
                    if (RUN(base + 2)) { { PH(); phase_attn_mfma(F, a, j); } { PH(); phase_memattn_mfma(F, a, layer, (bf16_t*)(ws + WS_R1 + R1_CONCAT)); } } SEAM();
                    if (RUN(base + 6)) { PH();
                pg8::GemmPlain g{(const bf16_t*)(ws + WS_R1 + R1_CONCAT), (const bf16_t*)(ws + WS_WOUT), DM, DM}; pg8::StaticOrder S; S.init(MTOK, DM, F.G, (int)blockIdx.x);
                constexpr int lp = layer > 0 ? layer - 1 : 0; pg8::EpiResidB<1> E{nullptr, nullptr, 0, STATS(1), a->in[22] + (size_t)lp * DM, a->in[23] + (size_t)lp * DM, (bf16_t*)(ws + WS_XB), PARTP, 0, F.lds};
                pg8::gemm_phase(F.lds, F.wave, g, S, E);
            } SEAM();
        }

        { constexpr int half = 0; constexpr int roff = half * (MTOK / NSPLIT);

                        if (RUN(base + 8 + 2 * half)) { PH();
                pg8::GemmPlain g{(const bf16_t*)(ws + WS_XB) + (size_t)roff * DM, (const bf16_t*)(ws + WS_WFF1), DM, DM}; pg8::StaticOrder S; S.init(MTOK / NSPLIT, DFF, F.G, (int)blockIdx.x);
                local_row_stats(F, S, PARTP, STATS(0), roff);
                pg8::EpiSqRelu E{(bf16_t*)(ws + WS_R1 + R1_H), DFF, pg8::Fold{STATS(0) + 2 * (size_t)roff, CSBW(layer) + 16384, CSBW(layer) + 24576}};
                pg8::gemm_phase(F.lds, F.wave, g, S, E);
            } GSEAM();
                        if (RUN(base + 9 + 2 * half)) { PH();
                pg8::GemmPlain g{(const bf16_t*)(ws + WS_R1 + R1_H), (const bf16_t*)(ws + WS_WFF2), DFF, DFF}; pg8::StaticOrder S; S.init(MTOK / NSPLIT, DM, F.G, (int)blockIdx.x);
                pg8::EpiResidB<1> E{nullptr, nullptr, 0, STATS(0), a->in[18] + (size_t)layer * DM, a->in[19] + (size_t)layer * DM, (bf16_t*)(ws + WS_XB), PARTP, roff, F.lds};
                pg8::gemm_phase(F.lds, F.wave, g, S, E);
            } if constexpr (half + 1 < NSPLIT) GSEAM(); else SEAM();
                }
        { constexpr int half = 1; constexpr int roff = half * (MTOK / NSPLIT);

                        if (RUN(base + 8 + 2 * half)) { PH();
                pg8::GemmPlain g{(const bf16_t*)(ws + WS_XB) + (size_t)roff * DM, (const bf16_t*)(ws + WS_WFF1), DM, DM}; pg8::StaticOrder S; S.init(MTOK / NSPLIT, DFF, F.G, (int)blockIdx.x);
                local_row_stats(F, S, PARTP, STATS(0), roff);
                pg8::EpiSqRelu E{(bf16_t*)(ws + WS_R1 + R1_H), DFF, pg8::Fold{STATS(0) + 2 * (size_t)roff, CSBW(layer) + 16384, CSBW(layer) + 24576}};
                pg8::gemm_phase(F.lds, F.wave, g, S, E);
            } GSEAM();
                        if (RUN(base + 9 + 2 * half)) { PH();
                pg8::GemmPlain g{(const bf16_t*)(ws + WS_R1 + R1_H), (const bf16_t*)(ws + WS_WFF2), DFF, DFF}; pg8::StaticOrder S; S.init(MTOK / NSPLIT, DM, F.G, (int)blockIdx.x);
                pg8::EpiResidB<1> E{nullptr, nullptr, 0, STATS(0), a->in[18] + (size_t)layer * DM, a->in[19] + (size_t)layer * DM, (bf16_t*)(ws + WS_XB), PARTP, roff, F.lds};
                pg8::gemm_phase(F.lds, F.wave, g, S, E);
            } if constexpr (half + 1 < NSPLIT) GSEAM(); else SEAM();
                }
            if constexpr (layer < 3) { if (RUN(base + 24)) { { PH(); phase_finalize(F, PARTP, STATS(1)); } { PH(); phase_wconv(F, a, layer + 1); } } SEAM(); }
                if constexpr (layer == 3) { if (RUN(base + 25)) { PH(); phase_ln_final(F, (const bf16_t*)(ws + WS_XB), a->out, a->in[22] + (size_t)layer * DM, a->in[23] + (size_t)layer * DM); } }
        }
    { constexpr int layer = 1; constexpr int base = 2 + 32 * layer; constexpr bool attn = layer & 1; constexpr int j = layer >> 1; (void)j;

                if constexpr (layer == 0) { if (RUN(base + 0)) { PH(); phase_wconv(F, a, layer); } SEAM(); }
        if constexpr (!attn) {
                    if (RUN(base + 1)) { PH();
                cvt_fold(F, CSBW(layer) + 16384);
                pg8::GemmPlain g{(const bf16_t*)(ws + WS_XB), (const bf16_t*)(ws + WS_WIN), DM, DM}; pg8::StaticOrder S; S.init(MTOK, 2048, F.G, (int)blockIdx.x);
                pg8::EpiInSsm<(layer > 0)> E{(bf16_t*)(ws + WS_R1 + R1_UH), (bf16_t*)(ws + WS_R1 + R1_QM), pg8::Fold{STATS(1), CSBW(layer), CSBW(layer) + 8192}};
                pg8::gemm_phase(F.lds, F.wave, g, S, E);
            } SEAM();
        if (RUN(base + 2)) {
            { PH();
                pg8::GemmSsm g{(const bf16_t*)(ws + WS_R1 + R1_UH), (const bf16_t*)(ws + WS_SWG), 256, 512}; pg8::SsmOrder S{F.G, (int)blockIdx.x};
                pg8::EpiG1 E{(bf16_t*)(ws + WS_R1 + R1_G)};
                pg8::gemm_phase(F.lds, F.wave, g, S, E); }
            __builtin_amdgcn_fence(__ATOMIC_ACQUIRE, "agent");
            { PH(); phase_scan(F, a, j); }
            asm volatile("s_waitcnt vmcnt(0)" ::: "memory"); __syncthreads(); __builtin_amdgcn_fence(__ATOMIC_ACQUIRE, "agent");
            { PH();
                pg8::GemmSsm g{(const bf16_t*)(ws + WS_R1 + R1_UH), (const bf16_t*)(ws + WS_SWY), 512, 512}; pg8::SsmOrder S{F.G, (int)blockIdx.x};
                pg8::EpiG2 E{(bf16_t*)(ws + WS_R1 + R1_Z)};
                pg8::gemm_phase(F.lds, F.wave, g, S, E); }
        } SEAM();
            constexpr size_t ZOFF = WS_R1 + R1_Z, CCOFF = WS_R1 + R1_CONCAT;
                    if (RUN(base + 5)) {
                { PH();
                pg8::GemmPlain g{(const bf16_t*)(ws + ZOFF), (const bf16_t*)(ws + WS_WGLU), MIXW, MIXW}; pg8::StaticOrder S; S.init(MTOK, 3072, F.G, (int)blockIdx.x);
                pg8::EpiGlu E{(bf16_t*)(ws + CCOFF)};
                pg8::gemm_phase(F.lds, F.wave, g, S, E); }
                { PH(); phase_memattn_mfma(F, a, layer, (bf16_t*)(ws + CCOFF)); }
            } SEAM();
                    if (RUN(base + 6)) { PH();
                pg8::GemmPlain g{(const bf16_t*)(ws + CCOFF), (const bf16_t*)(ws + WS_WOUT), DM, DM}; pg8::StaticOrder S; S.init(MTOK, DM, F.G, (int)blockIdx.x);
                if constexpr (layer == 0) { pg8::EpiResidB<0> E{a->in[0], a->in[1], MROWS_PROMPT, nullptr, nullptr, nullptr, (bf16_t*)(ws + WS_XB), PARTP, 0, F.lds};
                    pg8::gemm_phase(F.lds, F.wave, g, S, E); }
                else { constexpr int lp = layer > 0 ? layer - 1 : 0; pg8::EpiResidB<1> E{nullptr, nullptr, 0, STATS(1), a->in[22] + (size_t)lp * DM, a->in[23] + (size_t)lp * DM, (bf16_t*)(ws + WS_XB), PARTP, 0, F.lds};
                    pg8::gemm_phase(F.lds, F.wave, g, S, E); }
            } SEAM();
        } else {
                    if (RUN(base + 1)) { PH();
                cvt_fold(F, CSBW(layer) + 16384);
                pg8::GemmPlain g{(const bf16_t*)(ws + WS_XB), (const bf16_t*)(ws + WS_WIN), DM, DM}; pg8::StaticOrder S; S.init(MTOK, 3072, F.G, (int)blockIdx.x);
                pg8::EpiInAttn<true> E{ws + WS_R1, (const float*)(ws + WS_ROPE), pg8::Fold{STATS(1), CSBW(layer), CSBW(layer) + 8192}};
                pg8::gemm_phase(F.lds, F.wave, g, S, E);
            } SEAM();
                    if (RUN(base + 2)) { { PH(); phase_attn_mfma(F, a, j); } { PH(); phase_memattn_mfma(F, a, layer, (bf16_t*)(ws + WS_R1 + R1_CONCAT)); } } SEAM();
                    if (RUN(base + 6)) { PH();
                pg8::GemmPlain g{(const bf16_t*)(ws + WS_R1 + R1_CONCAT), (const bf16_t*)(ws + WS_WOUT), DM, DM}; pg8::StaticOrder S; S.init(MTOK, DM, F.G, (int)blockIdx.x);
                constexpr int lp = layer > 0 ? layer - 1 : 0; pg8::EpiResidB<1> E{nullptr, nullptr, 0, STATS(1), a->in[22] + (size_t)lp * DM, a->in[23] + (size_t)lp * DM, (bf16_t*)(ws + WS_XB), PARTP, 0, F.lds};
                pg8::gemm_phase(F.lds, F.wave, g, S, E);
            } SEAM();
        }

        { constexpr int half = 0; constexpr int roff = half * (MTOK / NSPLIT);

                        if (RUN(base + 8 + 2 * half)) { PH();
                pg8::GemmPlain g{(const bf16_t*)(ws + WS_XB) + (size_t)roff * DM, (const bf16_t*)(ws + WS_WFF1), DM, DM}; pg8::StaticOrder S; S.init(MTOK / NSPLIT, DFF, F.G, (int)blockIdx.x);
                local_row_stats(F, S, PARTP, STATS(0), roff);
                pg8::EpiSqRelu E{(bf16_t*)(ws + WS_R1 + R1_H), DFF, pg8::Fold{STATS(0) + 2 * (size_t)roff, CSBW(layer) + 16384, CSBW(layer) + 24576}};
                pg8::gemm_phase(F.lds, F.wave, g, S, E);
            } GSEAM();
                        if (RUN(base + 9 + 2 * half)) { PH();
                pg8::GemmPlain g{(const bf16_t*)(ws + WS_R1 + R1_H), (const bf16_t*)(ws + WS_WFF2), DFF, DFF}; pg8::StaticOrder S; S.init(MTOK / NSPLIT, DM, F.G, (int)blockIdx.x);
                pg8::EpiResidB<1> E{nullptr, nullptr, 0, STATS(0), a->in[18] + (size_t)layer * DM, a->in[19] + (size_t)layer * DM, (bf16_t*)(ws + WS_XB), PARTP, roff, F.lds};
                pg8::gemm_phase(F.lds, F.wave, g, S, E);
            } if constexpr (half + 1 < NSPLIT) GSEAM(); else SEAM();
                }
        { constexpr int half = 1; constexpr int roff = half * (MTOK / NSPLIT);

                        if (RUN(base + 8 + 2 * half)) { PH();
                pg8::GemmPlain g{(const bf16_t*)(ws + WS_XB) + (size_t)roff * DM, (const bf16_t*)(ws + WS_WFF1), DM, DM}; pg8::StaticOrder S; S.init(MTOK / NSPLIT, DFF, F.G, (int)blockIdx.x);
                local_row_stats(F, S, PARTP, STATS(0), roff);
                pg8::EpiSqRelu E{(bf16_t*)(ws + WS_R1 + R1_H), DFF, pg8::Fold{STATS(0) + 2 * (size_t)roff, CSBW(layer) + 16384, CSBW(layer) + 24576}};
                pg8::gemm_phase(F.lds, F.wave, g, S, E);
            } GSEAM();
                        if (RUN(base + 9 + 2 * half)) { PH();
                pg8::GemmPlain g{(const bf16_t*)(ws + WS_R1 + R1_H), (const bf16_t*)(ws + WS_WFF2), DFF, DFF}; pg8::StaticOrder S; S.init(MTOK / NSPLIT, DM, F.G, (int)blockIdx.x);
                pg8::EpiResidB<1> E{nullptr, nullptr, 0, STATS(0), a->in[18] + (size_t)layer * DM, a->in[19] + (size_t)layer * DM, (bf16_t*)(ws + WS_XB), PARTP, roff, F.lds};
                pg8::gemm_phase(F.lds, F.wave, g, S, E);
            } if constexpr (half + 1 < NSPLIT) GSEAM(); else SEAM();
                }
            if constexpr (layer < 3) { if (RUN(base + 24)) { { PH(); phase_finalize(F, PARTP, STATS(1)); } { PH(); phase_wconv(F, a, layer + 1); } } SEAM(); }
                if constexpr (layer == 3) { if (RUN(base + 25)) { PH(); phase_ln_final(F, (const bf16_t*)(ws + WS_XB), a->out, a->in[22] + (size_t)layer * DM, a->in[23] + (size_t)layer * DM); } }
        }
    { constexpr int layer = 2; constexpr int base = 2 + 32 * layer; constexpr bool attn = layer & 1; constexpr int j = layer >> 1; (void)j;

                if constexpr (layer == 0) { if (RUN(base + 0)) { PH(); phase_wconv(F, a, layer); } SEAM(); }
        if constexpr (!attn) {
                    if (RUN(base + 1)) { PH();
                cvt_fold(F, CSBW(layer) + 16384);
                pg8::GemmPlain g{(const bf16_t*)(ws + WS_XB), (const bf16_t*)(ws + WS_WIN), DM, DM}; pg8::StaticOrder S; S.init(MTOK, 2048, F.G, (int)blockIdx.x);
                pg8::EpiInSsm<(layer > 0)> E{(bf16_t*)(ws + WS_R1 + R1_UH), (bf16_t*)(ws + WS_R1 + R1_QM), pg8::Fold{STATS(1), CSBW(layer), CSBW(layer) + 8192}};
                pg8::gemm_phase(F.lds, F.wave, g, S, E);
            } SEAM();
        if (RUN(base + 2)) {
            { PH();
                pg8::GemmSsm g{(const bf16_t*)(ws + WS_R1 + R1_UH), (const bf16_t*)(ws + WS_SWG), 256, 512}; pg8::SsmOrder S{F.G, (int)blockIdx.x};
                pg8::EpiG1 E{(bf16_t*)(ws + WS_R1 + R1_G)};
                pg8::gemm_phase(F.lds, F.wave, g, S, E); }
            __builtin_amdgcn_fence(__ATOMIC_ACQUIRE, "agent");
            { PH(); phase_scan(F, a, j); }
            asm volatile("s_waitcnt vmcnt(0)" ::: "memory"); __syncthreads(); __builtin_amdgcn_fence(__ATOMIC_ACQUIRE, "agent");
            { PH();
                pg8::GemmSsm g{(const bf16_t*)(ws + WS_R1 + R1_UH), (const bf16_t*)(ws + WS_SWY), 512, 512}; pg8::SsmOrder S{F.G, (int)blockIdx.x};
                pg8::EpiG2 E{(bf16_t*)(ws + WS_R1 + R1_Z)};
                pg8::gemm_phase(F.lds, F.wave, g, S, E); }
        } SEAM();
            constexpr size_t ZOFF = WS_R1 + R1_Z, CCOFF = WS_R1 + R1_CONCAT;
                    if (RUN(base + 5)) {
                { PH();
                pg8::GemmPlain g{(const bf16_t*)(ws + ZOFF), (const bf16_t*)(ws + WS_WGLU), MIXW, MIXW}; pg8::StaticOrder S; S.init(MTOK, 3072, F.G, (int)blockIdx.x);
                pg8::EpiGlu E{(bf16_t*)(ws + CCOFF)};
                pg8::gemm_phase(F.lds, F.wave, g, S, E); }
                { PH(); phase_memattn_mfma(F, a, layer, (bf16_t*)(ws + CCOFF)); }
            } SEAM();
                    if (RUN(base + 6)) { PH();
                pg8::GemmPlain g{(const bf16_t*)(ws + CCOFF), (const bf16_t*)(ws + WS_WOUT), DM, DM}; pg8::StaticOrder S; S.init(MTOK, DM, F.G, (int)blockIdx.x);
                if constexpr (layer == 0) { pg8::EpiResidB<0> E{a->in[0], a->in[1], MROWS_PROMPT, nullptr, nullptr, nullptr, (bf16_t*)(ws + WS_XB), PARTP, 0, F.lds};
                    pg8::gemm_phase(F.lds, F.wave, g, S, E); }
                else { constexpr int lp = layer > 0 ? layer - 1 : 0; pg8::EpiResidB<1> E{nullptr, nullptr, 0, STATS(1), a->in[22] + (size_t)lp * DM, a->in[23] + (size_t)lp * DM, (bf16_t*)(ws + WS_XB), PARTP, 0, F.lds};
                    pg8::gemm_phase(F.lds, F.wave, g, S, E); }
            } SEAM();
        } else {
                    if (RUN(base + 1)) { PH();
                cvt_fold(F, CSBW(layer) + 16384);
                pg8::GemmPlain g{(const bf16_t*)(ws + WS_XB), (const bf16_t*)(ws + WS_WIN), DM, DM}; pg8::StaticOrder S; S.init(MTOK, 3072, F.G, (int)blockIdx.x);
                pg8::EpiInAttn<true> E{ws + WS_R1, (const float*)(ws + WS_ROPE), pg8::Fold{STATS(1), CSBW(layer), CSBW(layer) + 8192}};
                pg8::gemm_phase(F.lds, F.wave, g, S, E);
            } SEAM();
                    if (RUN(base + 2)) { { PH(); phase_attn_mfma(F, a, j); } { PH(); phase_memattn_mfma(F, a, layer, (bf16_t*)(ws + WS_R1 + R1_CONCAT)); } } SEAM();
                    if (RUN(base + 6)) { PH();
                pg8::GemmPlain g{(const bf16_t*)(ws + WS_R1 + R1_CONCAT), (const bf16_t*)(ws + WS_WOUT), DM, DM}; pg8::StaticOrder S; S.init(MTOK, DM, F.G, (int)blockIdx.x);
                constexpr int lp = layer > 0 ? layer - 1 : 0; pg8::EpiResidB<1> E{nullptr, nullptr, 0, STATS(1), a->in[22] + (size_t)lp * DM, a->in[23] + (size_t)lp * DM, (bf16_t*)(ws + WS_XB), PARTP, 0, F.lds};
                pg8::gemm_phase(F.lds, F.wave, g, S, E);
            } SEAM();
        }

        { constexpr int half = 0; constexpr int roff = half * (MTOK / NSPLIT);

                        if (RUN(base + 8 + 2 * half)) { PH();
                pg8::GemmPlain g{(const bf16_t*)(ws + WS_XB) + (size_t)roff * DM, (const bf16_t*)(ws + WS_WFF1), DM, DM}; pg8::StaticOrder S; S.init(MTOK / NSPLIT, DFF, F.G, (int)blockIdx.x);
                local_row_stats(F, S, PARTP, STATS(0), roff);
                pg8::EpiSqRelu E{(bf16_t*)(ws + WS_R1 + R1_H), DFF, pg8::Fold{STATS(0) + 2 * (size_t)roff, CSBW(layer) + 16384, CSBW(layer) + 24576}};
                pg8::gemm_phase(F.lds, F.wave, g, S, E);
            } GSEAM();
                        if (RUN(base + 9 + 2 * half)) { PH();
                pg8::GemmPlain g{(const bf16_t*)(ws + WS_R1 + R1_H), (const bf16_t*)(ws + WS_WFF2), DFF, DFF}; pg8::StaticOrder S; S.init(MTOK / NSPLIT, DM, F.G, (int)blockIdx.x);
                pg8::EpiResidB<1> E{nullptr, nullptr, 0, STATS(0), a->in[18] + (size_t)layer * DM, a->in[19] + (size_t)layer * DM, (bf16_t*)(ws + WS_XB), PARTP, roff, F.lds};
                pg8::gemm_phase(F.lds, F.wave, g, S, E);
            } if constexpr (half + 1 < NSPLIT) GSEAM(); else SEAM();
                }
        { constexpr int half = 1; constexpr int roff = half * (MTOK / NSPLIT);

                        if (RUN(base + 8 + 2 * half)) { PH();
                pg8::GemmPlain g{(const bf16_t*)(ws + WS_XB) + (size_t)roff * DM, (const bf16_t*)(ws + WS_WFF1), DM, DM}; pg8::StaticOrder S; S.init(MTOK / NSPLIT, DFF, F.G, (int)blockIdx.x);
                local_row_stats(F, S, PARTP, STATS(0), roff);
                pg8::EpiSqRelu E{(bf16_t*)(ws + WS_R1 + R1_H), DFF, pg8::Fold{STATS(0) + 2 * (size_t)roff, CSBW(layer) + 16384, CSBW(layer) + 24576}};
                pg8::gemm_phase(F.lds, F.wave, g, S, E);
            } GSEAM();
                        if (RUN(base + 9 + 2 * half)) { PH();
                pg8::GemmPlain g{(const bf16_t*)(ws + WS_R1 + R1_H), (const bf16_t*)(ws + WS_WFF2), DFF, DFF}; pg8::StaticOrder S; S.init(MTOK / NSPLIT, DM, F.G, (int)blockIdx.x);
                pg8::EpiResidB<1> E{nullptr, nullptr, 0, STATS(0), a->in[18] + (size_t)layer * DM, a->in[19] + (size_t)layer * DM, (bf16_t*)(ws + WS_XB), PARTP, roff, F.lds};
                pg8::gemm_phase(F.lds, F.wave, g, S, E);
            } if constexpr (half + 1 < NSPLIT) GSEAM(); else SEAM();
                }
            if constexpr (layer < 3) { if (RUN(base + 24)) { { PH(); phase_finalize(F, PARTP, STATS(1)); } { PH(); phase_wconv(F, a, layer + 1); } } SEAM(); }
                if constexpr (layer == 3) { if (RUN(base + 25)) { PH(); phase_ln_final(F, (const bf16_t*)(ws + WS_XB), a->out, a->in[22] + (size_t)layer * DM, a->in[23] + (size_t)layer * DM); } }
        }
    { constexpr int layer = 3; constexpr int base = 2 + 32 * layer; constexpr bool attn = layer & 1; constexpr int j = layer >> 1; (void)j;

                if constexpr (layer == 0) { if (RUN(base + 0)) { PH(); phase_wconv(F, a, layer); } SEAM(); }
        if constexpr (!attn) {
                    if (RUN(base + 1)) { PH();
                cvt_fold(F, CSBW(layer) + 16384);
                pg8::GemmPlain g{(const bf16_t*)(ws + WS_XB), (const bf16_t*)(ws + WS_WIN), DM, DM}; pg8::StaticOrder S; S.init(MTOK, 2048, F.G, (int)blockIdx.x);
                pg8::EpiInSsm<(layer > 0)> E{(bf16_t*)(ws + WS_R1 + R1_UH), (bf16_t*)(ws + WS_R1 + R1_QM), pg8::Fold{STATS(1), CSBW(layer), CSBW(layer) + 8192}};
                pg8::gemm_phase(F.lds, F.wave, g, S, E);
            } SEAM();
        if (RUN(base + 2)) {
            { PH();
                pg8::GemmSsm g{(const bf16_t*)(ws + WS_R1 + R1_UH), (const bf16_t*)(ws + WS_SWG), 256, 512}; pg8::SsmOrder S{F.G, (int)blockIdx.x};
                pg8::EpiG1 E{(bf16_t*)(ws + WS_R1 + R1_G)};
                pg8::gemm_phase(F.lds, F.wave, g, S, E); }
            __builtin_amdgcn_fence(__ATOMIC_ACQUIRE, "agent");
            { PH(); phase_scan(F, a, j); }
            asm volatile("s_waitcnt vmcnt(0)" ::: "memory"); __syncthreads(); __builtin_amdgcn_fence(__ATOMIC_ACQUIRE, "agent");
            { PH();
                pg8::GemmSsm g{(const bf16_t*)(ws + WS_R1 + R1_UH), (const bf16_t*)(ws + WS_SWY), 512, 512}; pg8::SsmOrder S{F.G, (int)blockIdx.x};
                pg8::EpiG2 E{(bf16_t*)(ws + WS_R1 + R1_Z)};
                pg8::gemm_phase(F.lds, F.wave, g, S, E); }
        } SEAM();
            constexpr size_t ZOFF = WS_R1 + R1_Z, CCOFF = WS_R1 + R1_CONCAT;
                    if (RUN(base + 5)) {
                { PH();
                pg8::GemmPlain g{(const bf16_t*)(ws + ZOFF), (const bf16_t*)(ws + WS_WGLU), MIXW, MIXW}; pg8::StaticOrder S; S.init(MTOK, 3072, F.G, (int)blockIdx.x);
                pg8::EpiGlu E{(bf16_t*)(ws + CCOFF)};
                pg8::gemm_phase(F.lds, F.wave, g, S, E); }
                { PH(); phase_memattn_mfma(F, a, layer, (bf16_t*)(ws + CCOFF)); }
            } SEAM();
                    if (RUN(base + 6)) { PH();
                pg8::GemmPlain g{(const bf16_t*)(ws + CCOFF), (const bf16_t*)(ws + WS_WOUT), DM, DM}; pg8::StaticOrder S; S.init(MTOK, DM, F.G, (int)blockIdx.x);
                if constexpr (layer == 0) { pg8::EpiResidB<0> E{a->in[0], a->in[1], MROWS_PROMPT, nullptr, nullptr, nullptr, (bf16_t*)(ws + WS_XB), PARTP, 0, F.lds};
                    pg8::gemm_phase(F.lds, F.wave, g, S, E); }
                else { constexpr int lp = layer > 0 ? layer - 1 : 0; pg8::EpiResidB<1> E{nullptr, nullptr, 0, STATS(1), a->in[22] + (size_t)lp * DM, a->in[23] + (size_t)lp * DM, (bf16_t*)(ws + WS_XB), PARTP, 0, F.lds};
                    pg8::gemm_phase(F.lds, F.wave, g, S, E); }
            } SEAM();
        } else {
                    if (RUN(base + 1)) { PH();
                cvt_fold(F, CSBW(layer) + 16384);
                pg8::GemmPlain g{(const bf16_t*)(ws + WS_XB), (const bf16_t*)(ws + WS_WIN), DM, DM}; pg8::StaticOrder S; S.init(MTOK, 3072, F.G, (int)blockIdx.x);
                pg8::EpiInAttn<true> E{ws + WS_R1, (const float*)(ws + WS_ROPE), pg8::Fold{STATS(1), CSBW(layer), CSBW(layer) + 8192}};
                pg8::gemm_phase(F.lds, F.wave, g, S, E);
            } SEAM();
                    if (RUN(base + 2)) { { PH(); phase_attn_mfma(F, a, j); } { PH(); phase_memattn_mfma(F, a, layer, (bf16_t*)(ws + WS_R1 + R1_CONCAT)); } } SEAM();
                    if (RUN(base + 6)) { PH();
                pg8::GemmPlain g{(const bf16_t*)(ws + WS_R1 + R1_CONCAT), (const bf16_t*)(ws + WS_WOUT), DM, DM}; pg8::StaticOrder S; S.init(MTOK, DM, F.G, (int)blockIdx.x);
                constexpr int lp = layer > 0 ? layer - 1 : 0; pg8::EpiResidB<1> E{nullptr, nullptr, 0, STATS(1), a->in[22] + (size_t)lp * DM, a->in[23] + (size_t)lp * DM, (bf16_t*)(ws + WS_XB), PARTP, 0, F.lds};
                pg8::gemm_phase(F.lds, F.wave, g, S, E);
            } SEAM();
        }

        { constexpr int half = 0; constexpr int roff = half * (MTOK / NSPLIT);

                        if (RUN(base + 8 + 2 * half)) { PH();
                pg8::GemmPlain g{(const bf16_t*)(ws + WS_XB) + (size_t)roff * DM, (const bf16_t*)(ws + WS_WFF1), DM, DM}; pg8::StaticOrder S; S.init(MTOK / NSPLIT, DFF, F.G, (int)blockIdx.x);
                local_row_stats(F, S, PARTP, STATS(0), roff);
                pg8::EpiSqRelu E{(bf16_t*)(ws + WS_R1 + R1_H), DFF, pg8::Fold{STATS(0) + 2 * (size_t)roff, CSBW(layer) + 16384, CSBW(layer) + 24576}};
                pg8::gemm_phase(F.lds, F.wave, g, S, E);
            } GSEAM();
                        if (RUN(base + 9 + 2 * half)) { PH();
                pg8::GemmPlain g{(const bf16_t*)(ws + WS_R1 + R1_H), (const bf16_t*)(ws + WS_WFF2), DFF, DFF}; pg8::StaticOrder S; S.init(MTOK / NSPLIT, DM, F.G, (int)blockIdx.x);
                pg8::EpiResidB<1> E{nullptr, nullptr, 0, STATS(0), a->in[18] + (size_t)layer * DM, a->in[19] + (size_t)layer * DM, (bf16_t*)(ws + WS_XB), PARTP, roff, F.lds};
                pg8::gemm_phase(F.lds, F.wave, g, S, E);
            } if constexpr (half + 1 < NSPLIT) GSEAM(); else SEAM();
                }
        { constexpr int half = 1; constexpr int roff = half * (MTOK / NSPLIT);

                        if (RUN(base + 8 + 2 * half)) { PH();
                pg8::GemmPlain g{(const bf16_t*)(ws + WS_XB) + (size_t)roff * DM, (const bf16_t*)(ws + WS_WFF1), DM, DM}; pg8::StaticOrder S; S.init(MTOK / NSPLIT, DFF, F.G, (int)blockIdx.x);
                local_row_stats(F, S, PARTP, STATS(0), roff);
                pg8::EpiSqRelu E{(bf16_t*)(ws + WS_R1 + R1_H), DFF, pg8::Fold{STATS(0) + 2 * (size_t)roff, CSBW(layer) + 16384, CSBW(layer) + 24576}};
                pg8::gemm_phase(F.lds, F.wave, g, S, E);
            } GSEAM();
                        if (RUN(base + 9 + 2 * half)) { PH();
                pg8::GemmPlain g{(const bf16_t*)(ws + WS_R1 + R1_H), (const bf16_t*)(ws + WS_WFF2), DFF, DFF}; pg8::StaticOrder S; S.init(MTOK / NSPLIT, DM, F.G, (int)blockIdx.x);
                pg8::EpiResidB<1> E{nullptr, nullptr, 0, STATS(0), a->in[18] + (size_t)layer * DM, a->in[19] + (size_t)layer * DM, (bf16_t*)(ws + WS_XB), PARTP, roff, F.lds};
                pg8::gemm_phase(F.lds, F.wave, g, S, E);
            } if constexpr (half + 1 < NSPLIT) GSEAM(); else SEAM();
                }
            if constexpr (layer < 3) { if (RUN(base + 24)) { { PH(); phase_finalize(F, PARTP, STATS(1)); } { PH(); phase_wconv(F, a, layer + 1); } } SEAM(); }
                if constexpr (layer == 3) { if (RUN(base + 25)) { PH(); phase_ln_final(F, (const bf16_t*)(ws + WS_XB), a->out, a->in[22] + (size_t)layer * DM, a->in[23] + (size_t)layer * DM); } }
        }
#undef RUN
#undef SEAM
#undef PH
}

extern "C" void kernel_launch(void* const* d_in, const int* in_sizes, int n_in, void* d_out, int out_size, void* d_ws, size_t ws_size, hipStream_t stream) {
    static int grid = 0;
    if (grid == 0) {
        if (n_in != 24 || out_size != MTOK * DM || ws_size < WS_END) { fprintf(stderr, "kernel_launch: unexpected shapes: n_in %d out %d ws %zu (need %zu)\n", n_in, out_size, ws_size, (size_t)WS_END); grid = -1; return; }
        int dev = 0, cus = 0;
        if (hipGetDevice(&dev) != hipSuccess || hipDeviceGetAttribute(&cus, hipDeviceAttributeMultiprocessorCount, dev) != hipSuccess) { grid = -1; return; }
        if (hipFuncSetAttribute((const void*)mk_fwd, hipFuncAttributeMaxDynamicSharedMemorySize, LDS_BYTES) != hipSuccess) { fprintf(stderr, "kernel_launch: hipFuncSetAttribute failed\n"); grid = -1; return; }
        int per_cu = 0;
        if (hipOccupancyMaxActiveBlocksPerMultiprocessor(&per_cu, (const void*)mk_fwd, NWAVES * 64, LDS_BYTES) != hipSuccess || per_cu < 1) fprintf(stderr, "kernel_launch: occupancy query says %d\n", per_cu);
        (void)hipGetLastError();
        grid = cus;
    }
    if (grid < 0) return;
    (void)hipMemsetAsync((char*)d_ws + WS_CTL, 0, CTL_ZERO_BYTES, stream);
    Args a{};
    for (int i = 0; i < 24; ++i) a.in[i] = (const float*)d_in[i];
    a.out = (float*)d_out; a.ws = (unsigned char*)d_ws;
#if MK_MULTI
    for (int id = 0; id < 2 + 32 * 4; ++id) { a.lin_lo = id; a.lin_hi = id + 1; hipLaunchKernelGGL(mk_fwd, dim3(grid), dim3(NWAVES * 64), LDS_BYTES, stream, a); }
#else
    a.lin_lo = 0; a.lin_hi = 1 << 20;
    hipLaunchKernelGGL(mk_fwd, dim3(grid), dim3(NWAVES * 64), LDS_BYTES, stream, a);
#endif
    const hipError_t le = hipPeekAtLastError();
    if (le != hipSuccess) fprintf(stderr, "kernel_launch: launch failed: %s\n", hipGetErrorName(le));
}
```

```cpp
#include <hip/hip_runtime.h>
#include <cstdio>
#include <cstdint>

#ifndef MK_MULTI
#define MK_MULTI 0
#endif

#define GAS __attribute__((address_space(1)))
#define LAS __attribute__((address_space(3)))
typedef unsigned short bf16_t;
typedef short bf16x8 __attribute__((ext_vector_type(8)));
typedef float f32x4 __attribute__((ext_vector_type(4)));
typedef float f32x2 __attribute__((ext_vector_type(2)));
typedef unsigned u32x4 __attribute__((ext_vector_type(4)));
typedef unsigned u32x2 __attribute__((ext_vector_type(2)));
typedef int i32x4 __attribute__((ext_vector_type(4)));

constexpr int DM = 2048, NBATCH = 12, SEQ = 4096, MTOK = NBATCH * SEQ;
constexpr int MROWS_PROMPT = 8 * SEQ;
constexpr int MIXW = 1536, MEMW = 512, HD = 128, NQH = 12, NKVH = 4, KVW = 512, NMEM = 256;
constexpr int SSG = 96, SSP = 64, SSC = 16, DFF = 8192;
constexpr int NMEMROWS = NBATCH * NMEM;
constexpr float ALPHA = 1.6817928305074290f;
constexpr float LN_EPS = 1e-5f;
constexpr int NWAVES = 8;

constexpr size_t MiB = 1u << 20;
constexpr size_t WS_CTL = 0, CTL_ZERO_BYTES = 3 * MiB;
constexpr size_t WS_STATS = 1 * MiB;
constexpr size_t WS_PART = 3 * MiB;
constexpr size_t WS_CSBW = 2 * MiB;
constexpr size_t WS_ROPE = 6 * MiB;
constexpr size_t WS_POW = 8 * MiB;
constexpr size_t WS_BBAR = 12 * MiB;
constexpr size_t WS_KT = 16 * MiB;
constexpr size_t WS_MEMKV = 24 * MiB;
constexpr size_t WS_WIN = 48 * MiB;
constexpr size_t WS_WGLU = 60 * MiB;
constexpr size_t WS_WOUT = 69 * MiB;
constexpr size_t WS_WFF1 = 77 * MiB;
constexpr size_t WS_WFF2 = 109 * MiB;
constexpr size_t WS_SWG = 141 * MiB;
constexpr size_t WS_SWY = 153 * MiB;
constexpr size_t WS_XB = 177 * MiB;
constexpr size_t WS_R1 = 369 * MiB;
constexpr size_t WS_END = 993 * MiB;
constexpr size_t R1_UH = 0;
constexpr size_t R1_G = 288 * MiB;
constexpr size_t R1_Z = 432 * MiB;
constexpr size_t R1_QM = 576 * MiB;
constexpr size_t R1_CONCAT = 0;
constexpr size_t R1_Q = 192 * MiB;
constexpr size_t R1_K = 336 * MiB;
constexpr size_t R1_V = 384 * MiB;
#ifndef NSPLIT
#define NSPLIT 2
#endif
constexpr size_t R1_H = 0;
constexpr size_t R1_MEMB = 0;
constexpr size_t R1_WMKV = 16 * MiB;
constexpr int CW_BAR = 4096;

constexpr int RING_BYTES = 131072;
constexpr int LDSCTL_OFF = RING_BYTES, MISC_OFF = LDSCTL_OFF + 320;
constexpr int LDS_BYTES = 163840;
constexpr int FOLD_SLOT_OFF = LDSCTL_OFF + 9216;

#define LDS_WAIT() asm volatile("s_waitcnt lgkmcnt(0)" ::: "memory")
#define VM_WAIT() asm volatile("s_waitcnt vmcnt(0)" ::: "memory")
__device__ __forceinline__ unsigned f2bf(float f) { unsigned u = __builtin_bit_cast(unsigned, f); return (u + 0x7fffu + ((u >> 16) & 1u)) >> 16; }
__device__ __forceinline__ unsigned pk2(float lo, float hi) { return f2bf(lo) | (f2bf(hi) << 16); }
__device__ __forceinline__ float bf2f(unsigned short b) { return __builtin_bit_cast(float, ((unsigned)b) << 16); }
__device__ __forceinline__ float bflo(unsigned w) { return __builtin_bit_cast(float, w << 16); }
__device__ __forceinline__ float bfhi(unsigned w) { return __builtin_bit_cast(float, w & 0xffff0000u); }

namespace pg8 {
constexpr int BM = 256, BK = 64, HALF = 128, HTB = HALF * BK * 2, NXCD = 8, WGM = 4;
__host__ __device__ __forceinline__ int lds_byte(int r, int c) { const int st = (r >> 4) * 2 + (c >> 5), rr = r & 15, cc = c & 31, ob = rr * 64 + cc * 2; return st * 1024 + (ob ^ (((ob >> 9) & 1) << 5)); }
__host__ __device__ __forceinline__ void stage_rc(int b, int& R, int& C) { const int st = b / 1024, sb = b % 1024, swz = sb ^ (((sb >> 9) & 1) << 5); R = (st >> 1) * 16 + swz / 64; C = (st & 1) * 32 + (swz % 64) / 2; }
__host__ __device__ __forceinline__ int perm32(int rho) { const int n = rho >> 4, i = rho & 15; return 8 * (i >> 2) + 4 * n + (i & 3); }

struct Unit { int pm, pn; };
struct GemmPlain {
    const bf16_t* A; const bf16_t* Bt; int K, lda;
    __device__ __forceinline__ const char* a_tile(const Unit& u) const { return (const char*)(A + (size_t)u.pm * BM * lda); }
    __device__ __forceinline__ const char* b_tile(const Unit& u) const { return (const char*)(Bt + (size_t)u.pn * BM * K); }
};
struct GemmSsm {
    const bf16_t* A; const bf16_t* Bt; int K, lda;
    __device__ __forceinline__ const char* a_tile(const Unit& u) const { return (const char*)(A + (size_t)(u.pm * SSG + u.pn) * 256 * 512); }
    __device__ __forceinline__ const char* b_tile(const Unit& u) const { return (const char*)(Bt + (size_t)u.pn * 256 * K); }
};
struct StaticOrder {
    int nM, nN, nwg, G, c;
    __device__ void init(int M, int N, int G_, int c_) { nM = M / BM; nN = N / BM; nwg = nM * nN; G = G_; c = c_; }
    __device__ bool next(int i, Unit& u) const {
        const long L = (long)i * G + c; if (L >= nwg) return false;
        int wgid = (int)L; { const int q = nwg / NXCD, r = nwg % NXCD, xcd = wgid % NXCD, off = wgid / NXCD; wgid = (xcd < r ? xcd * (q + 1) : r * (q + 1) + (xcd - r) * q) + off; }
        const int nig = WGM * nN, gid = wgid / nig, fm = gid * WGM, gsz = (nM - fm) < WGM ? (nM - fm) : WGM;
        u.pm = fm + ((wgid % nig) % gsz); u.pn = (wgid % nig) / gsz; return true;
    }
    __device__ __forceinline__ void a_ready(const Unit&) const {}
    __device__ __forceinline__ void done(const Unit&) const {}
};
struct SsmOrder {
    int G, c;
    __device__ bool next(int i, Unit& u) const { const int L = i * G + c; if (L >= NBATCH * SSG) return false; u.pm = L % NBATCH; u.pn = L / NBATCH; return true; }
    __device__ __forceinline__ void a_ready(const Unit&) const {}
    __device__ __forceinline__ void done(const Unit&) const {}
};
typedef __bf16 bf16x2_t __attribute__((ext_vector_type(2)));
__device__ __forceinline__ unsigned cvt_pk_bf16(float lo, float hi) { const f32x2 v = {lo, hi}; return __builtin_bit_cast(unsigned, __builtin_convertvector(v, bf16x2_t)); }

#ifndef RELAX
#define RELAX 0
#endif
template <class E, class = void> struct EpiPre { static constexpr bool v = false; };
template <class E> struct EpiPre<E, decltype((void)E::PRE)> { static constexpr bool v = E::PRE; };
#ifndef STAGGER
#define STAGGER 0
#endif
#ifndef SPLITST
#define SPLITST 0
#endif
template <class Epi, class GM, class Sched, int PROBE = 0>
__device__ __forceinline__ void gemm_phase(LAS unsigned char* lds, int wave, const GM g, const Sched& S, const Epi& E) {
    int lane_; asm volatile("v_mbcnt_lo_u32_b32 %0, -1, 0\n\tv_mbcnt_hi_u32_b32 %0, -1, %0" : "=v"(lane_));
    const int wid = wave, lane = lane_, tid = wid * 64 + lane, wr = wid >> 2, wc = wid & 3, fr = lane & 15, fq = lane >> 4;
    const int K = g.K, nt = K / BK;
    unsigned voffA[2], voffB[2];
#pragma unroll
    for (int i = 0; i < 2; ++i) { int R, C; stage_rc(tid * 16 + i * 8192, R, C); const int Rb = Epi::PERM ? ((R & ~31) + perm32(R & 31)) : R;
        voffA[i] = (unsigned)(R * g.lda + C) * 2u; voffB[i] = (unsigned)(Rb * K + C) * 2u; }
    const size_t kstep = (size_t)(BK * 2);
    const size_t hstepA = (size_t)HALF * g.lda * 2, hstepB = (size_t)HALF * K * 2;
    const unsigned ldsw = (unsigned)wid * 1024u;
    const int aoff = lds_byte(wr * 64 + fr, fq * 8), boff = lds_byte(wc * 32 + fr, fq * 8);
#define PG8_SA(b, h) (((b) * 2 + (h)) * HTB)
#define PG8_SB(b, h) ((4 + (b) * 2 + (h)) * HTB)
#define PG8_STAGE(bufoff, gbase, voff) do { if (PROBE < 2 || (PROBE == 4 && (bufoff) >= 4 * HTB) || (PROBE == 5 && (bufoff) < 4 * HTB)) _Pragma("unroll") for (int _i = 0; _i < 2; ++_i) \
        __builtin_amdgcn_global_load_lds((const unsigned*)((const char*)(gbase) + (voff)[_i]), (LAS unsigned*)(lds + (bufoff) + ldsw + _i * 8192), 16, 0, 0); } while (0)
#define PG8_LDA(dst, b, h) do { _Pragma("unroll") for (int m = 0; m < 4; ++m) _Pragma("unroll") for (int k = 0; k < 2; ++k) dst[m][k] = *(const LAS bf16x8*)(lds + PG8_SA(b, h) + aoff + m * 2048 + k * 1024); } while (0)
#define PG8_LDB(dst, b, h) do { _Pragma("unroll") for (int n = 0; n < 2; ++n) _Pragma("unroll") for (int k = 0; k < 2; ++k) dst[n][k] = *(const LAS bf16x8*)(lds + PG8_SB(b, h) + boff + n * 2048 + k * 1024); } while (0)
#define PG8_MMA(ai, bj, At, Bt) do { __builtin_amdgcn_s_setprio(1); _Pragma("unroll") for (int m = 0; m < 4; ++m) _Pragma("unroll") for (int n = 0; n < 2; ++n) _Pragma("unroll") for (int k = 0; k < 2; ++k) \
        acc[ai][bj][m][n] = __builtin_amdgcn_mfma_f32_16x16x32_bf16(Bt[n][k], At[m][k], acc[ai][bj][m][n], 0, 0, 0); __builtin_amdgcn_s_setprio(0); } while (0)
#define PG8_WAIT_V(n) asm volatile("s_waitcnt vmcnt(" #n ")" ::: "memory")
#define PG8_WAIT_L(n) asm volatile("s_waitcnt lgkmcnt(" #n ")" ::: "memory")
#define PG8_BAR __builtin_amdgcn_s_barrier()
#define PG8_SCHED __builtin_amdgcn_sched_barrier(0)
    Unit cur, nxt; int ui = 0;
    if (!S.next(0, cur)) return;
    f32x4 acc[2][2][4][2];
#pragma unroll
    for (int a = 0; a < 2; ++a)
#pragma unroll
        for (int b = 0; b < 2; ++b)
#pragma unroll
            for (int m = 0; m < 4; ++m)
#pragma unroll
                for (int n = 0; n < 2; ++n) acc[a][b][m][n] = (f32x4){0.f, 0.f, 0.f, 0.f};
    bf16x8 At[4][2], B0[2][2], B1[2][2];
    const char* cA = g.a_tile(cur); const char* cB = g.b_tile(cur);
    S.a_ready(cur);
    if (STAGGER > 0) { const int grp = (blockIdx.x >> 3) & 7; for (int i = 0; i < grp; ++i) __builtin_amdgcn_s_sleep(STAGGER); }
    PG8_STAGE(PG8_SB(0, 0), cB, voffB); PG8_STAGE(PG8_SB(0, 1), cB + hstepB, voffB); PG8_STAGE(PG8_SA(0, 0), cA, voffA); PG8_STAGE(PG8_SA(0, 1), cA + hstepA, voffA);
    PG8_STAGE(PG8_SB(1, 0), cB + kstep, voffB); PG8_STAGE(PG8_SA(1, 0), cA + kstep, voffA); PG8_STAGE(PG8_SB(1, 1), cB + hstepB + kstep, voffB);
    if (wr == 1) PG8_BAR;
    PG8_WAIT_V(6); PG8_BAR;
    PG8_BAR;
    for (;;) {
        const bool has_next = S.next(ui + 1, nxt);
        const char* nA = has_next ? g.a_tile(nxt) : cA; const char* nB = has_next ? g.b_tile(nxt) : cB;
        if constexpr (EpiPre<Epi>::v) E.prefetch(lds, cur, ui & 1, wid, lane);
#define PG8_TRIP(W12) do { \
            const bool last = (t == nt - 2); \
            const char* a1 = cA + (size_t)(t + 1) * kstep; \
            const char* a2 = last ? nA : cA + (size_t)(t + 2) * kstep; const char* b2 = last ? nB : cB + (size_t)(t + 2) * kstep; \
            const char* a3 = a2 + kstep; const char* b3 = b2 + kstep; \
            if (last && has_next) S.a_ready(nxt); \
            PG8_LDB(B0, 0, 0); PG8_LDB(B1, 0, 1); PG8_SCHED; PG8_LDA(At, 0, 0); PG8_STAGE(PG8_SA(1, 1), a1 + hstepA, voffA); \
            W12; PG8_WAIT_L(0); PG8_BAR; PG8_MMA(0, 0, At, B0); PG8_MMA(0, 1, At, B1); PG8_BAR; PG8_SCHED; \
            PG8_LDA(At, 0, 1); PG8_STAGE(PG8_SB(0, 0), b2, voffB); PG8_STAGE(PG8_SB(0, 1), b2 + hstepB, voffB); if (!SPLITST) PG8_STAGE(PG8_SA(0, 0), a2, voffA); \
            if (SPLITST) PG8_WAIT_V(6); else { W12; } PG8_WAIT_L(0); PG8_BAR; if (SPLITST) { PG8_STAGE(PG8_SA(0, 0), a2, voffA); PG8_SCHED; } PG8_MMA(1, 0, At, B0); PG8_MMA(1, 1, At, B1); PG8_BAR; PG8_SCHED; \
            PG8_LDB(B0, 1, 0); PG8_LDB(B1, 1, 1); PG8_SCHED; PG8_LDA(At, 1, 0); PG8_STAGE(PG8_SA(0, 1), a2 + hstepA, voffA); \
            PG8_WAIT_V(8); PG8_WAIT_L(0); PG8_BAR; PG8_MMA(0, 0, At, B0); PG8_MMA(0, 1, At, B1); PG8_BAR; PG8_SCHED; \
            PG8_LDA(At, 1, 1); PG8_STAGE(PG8_SB(1, 0), b3, voffB); PG8_STAGE(PG8_SB(1, 1), b3 + hstepB, voffB); if (!SPLITST) PG8_STAGE(PG8_SA(1, 0), a3, voffA); \
            if (SPLITST) PG8_WAIT_V(6); else PG8_WAIT_V(8); PG8_WAIT_L(0); PG8_BAR; if (SPLITST) { PG8_STAGE(PG8_SA(1, 0), a3, voffA); PG8_SCHED; } PG8_MMA(1, 0, At, B0); PG8_MMA(1, 1, At, B1); PG8_BAR; PG8_SCHED; \
        } while (0)
#define PG8_W12_16 asm volatile("s_waitcnt vmcnt(24)\n\ts_cmp_lg_u32 %0, 0\n\ts_cbranch_scc1 1f\n\ts_waitcnt vmcnt(8)\n1:" :: "s"(relax) : "scc", "memory")
#define PG8_W12_32 asm volatile("s_waitcnt vmcnt(40)\n\ts_cmp_lg_u32 %0, 0\n\ts_cbranch_scc1 1f\n\ts_waitcnt vmcnt(8)\n1:" :: "s"(relax) : "scc", "memory")
        for (int t = 0; t < nt; t += 2) {
            const int relax = __builtin_amdgcn_readfirstlane((RELAX && Epi::NST > 0 && ui > 0 && t == 0) ? 1 : 0);
            if constexpr (!RELAX || Epi::NST < 16) { PG8_TRIP(PG8_WAIT_V(8)); } else if constexpr (Epi::NST >= 32) { PG8_TRIP(PG8_W12_32); } else { PG8_TRIP(PG8_W12_16); }
        }
#undef PG8_TRIP
#undef PG8_W12_16
#undef PG8_W12_32
        if (wr == 0) PG8_BAR;
        if (PROBE >= 1) {
#pragma unroll
            for (int a = 0; a < 2; ++a)
#pragma unroll
                for (int b = 0; b < 2; ++b)
#pragma unroll
                    for (int m = 0; m < 4; ++m)
#pragma unroll
                        for (int n = 0; n < 2; ++n) asm volatile("" :: "v"(acc[a][b][m][n]));
        } else
        { int fr_ = fr, fq_ = fq; asm volatile("" : "+v"(fr_), "+v"(fq_)); if constexpr (EpiPre<Epi>::v) E.run(acc, cur, wr, wc, fr_, fq_, lds + FOLD_SLOT_OFF + (ui & 1) * 4096); else E(acc, cur, wr, wc, fr_, fq_); }
        S.done(cur);
        if (!has_next) break;
#pragma unroll
        for (int a = 0; a < 2; ++a)
#pragma unroll
            for (int b = 0; b < 2; ++b)
#pragma unroll
                for (int m = 0; m < 4; ++m)
#pragma unroll
                    for (int n = 0; n < 2; ++n) acc[a][b][m][n] = (f32x4){0.f, 0.f, 0.f, 0.f};
        cur = nxt; cA = nA; cB = nB; ++ui;
        if (wr == 1) PG8_BAR;
    }
    PG8_WAIT_V(0);
    PG8_BAR;
#undef PG8_SA
#undef PG8_SB
#undef PG8_STAGE
#undef PG8_LDA
#undef PG8_LDB
#undef PG8_MMA
#undef PG8_WAIT_V
#undef PG8_WAIT_L
#undef PG8_BAR
#undef PG8_SCHED
}

typedef const f32x4 (&AccRef)[2][2][4][2];
#define EPI_ROWS_BEGIN _Pragma("unroll") for (int ai = 0; ai < 2; ++ai) _Pragma("unroll") for (int m = 0; m < 4; ++m) { const int r = u.pm * BM + ai * HALF + wr * 64 + m * 16 + fr;
#define EPI_ROWS_END }
__device__ __forceinline__ u32x4 pack8(f32x4 v0, f32x4 v1) { u32x4 w; w.x = cvt_pk_bf16(v0[0], v0[1]); w.y = cvt_pk_bf16(v0[2], v0[3]); w.z = cvt_pk_bf16(v1[0], v1[1]); w.w = cvt_pk_bf16(v1[2], v1[3]); return w; }

struct Fold { const float* st; const float* cs; const float* bw; };
__device__ __forceinline__ void row_stats(const float* st, int r, float& mu, float& rs) { const f32x2 sq = *(const f32x2*)(st + 2 * (size_t)r); mu = sq.x; rs = sq.y; }
struct EpiPlainBf16 {
    static constexpr bool PERM = true; static constexpr int NST = 16;
    bf16_t* O; int ldc;
    __device__ __forceinline__ void operator()(AccRef acc, const Unit& u, int wr, int wc, int fr, int fq) const {
        const int c0 = u.pn * BM + wc * 32 + 8 * fq;
        EPI_ROWS_BEGIN  bf16_t* rowp = O + (size_t)r * ldc + c0;
#pragma unroll
            for (int bj = 0; bj < 2; ++bj) *(u32x4*)(rowp + bj * HALF) = pack8(acc[ai][bj][m][0], acc[ai][bj][m][1]);  EPI_ROWS_END
    }
};
#define FOLD_COLS() f32x4 csv[2][2], bwv[2][2]; if (FOLD) { _Pragma("unroll") for (int bj = 0; bj < 2; ++bj) _Pragma("unroll") for (int n = 0; n < 2; ++n) { \
        const i32x4 ci_ = *(const i32x4*)(fo.cs + cfull + bj * HALF + 4 * n), bi_ = *(const i32x4*)(fo.bw + cfull + bj * HALF + 4 * n); \
        csv[bj][n] = __builtin_convertvector(ci_, f32x4) * 5.9604644775390625e-08f; bwv[bj][n] = __builtin_convertvector(bi_, f32x4) * 5.9604644775390625e-08f; } } \
    f32x2 stv[2][4]; if (FOLD) { _Pragma("unroll") for (int ai = 0; ai < 2; ++ai) _Pragma("unroll") for (int m = 0; m < 4; ++m) stv[ai][m] = *(const f32x2*)(fo.st + 2 * (size_t)(u.pm * BM + ai * HALF + wr * 64 + m * 16 + fr)); }
#define FOLD_ROW() const float mu = FOLD ? stv[ai][m].x : 0.f, rs = FOLD ? stv[ai][m].y : 1.f;
#define FOLD_COLS_LDS() f32x4 csv[2][2], bwv[2][2]; f32x2 stv[2][4]; if (FOLD) { _Pragma("unroll") for (int bj = 0; bj < 2; ++bj) _Pragma("unroll") for (int n = 0; n < 2; ++n) { \
        const i32x4 ci_ = *(const LAS i32x4*)(slot + (cl + bj * HALF + 4 * n) * 4), bi_ = *(const LAS i32x4*)(slot + 1024 + (cl + bj * HALF + 4 * n) * 4); \
        csv[bj][n] = __builtin_convertvector(ci_, f32x4) * 5.9604644775390625e-08f; bwv[bj][n] = __builtin_convertvector(bi_, f32x4) * 5.9604644775390625e-08f; } \
        _Pragma("unroll") for (int ai = 0; ai < 2; ++ai) _Pragma("unroll") for (int m = 0; m < 4; ++m) stv[ai][m] = *(const LAS f32x2*)(slot + 2048 + (ai * HALF + wr * 64 + m * 16 + fr) * 8); }
#define FOLD_COLS_LDS_F() f32x4 csv[2][2], bwv[2][2]; f32x2 stv[2][4]; if (FOLD) { _Pragma("unroll") for (int bj = 0; bj < 2; ++bj) _Pragma("unroll") for (int n = 0; n < 2; ++n) { \
        csv[bj][n] = *(const LAS f32x4*)(slot + (cl + bj * HALF + 4 * n) * 4); bwv[bj][n] = *(const LAS f32x4*)(slot + 1024 + (cl + bj * HALF + 4 * n) * 4); } \
        _Pragma("unroll") for (int ai = 0; ai < 2; ++ai) _Pragma("unroll") for (int m = 0; m < 4; ++m) stv[ai][m] = *(const LAS f32x2*)(slot + 2048 + (ai * HALF + wr * 64 + m * 16 + fr) * 8); }
#define FOLD_PREFETCH() static constexpr bool PRE = FOLD; \
    __device__ __forceinline__ void prefetch(LAS unsigned char* lds, const Unit& u, int par, int wid, int lane) const { \
        if (wid < 4) { const char* src = wid == 0 ? (const char*)(fo.cs + u.pn * BM) : wid == 1 ? (const char*)(fo.bw + u.pn * BM) : (const char*)(fo.st + 2 * (size_t)(u.pm * BM + (wid - 2) * HALF)); \
            __builtin_amdgcn_global_load_lds((const unsigned*)(src + lane * 16), (LAS unsigned*)(lds + FOLD_SLOT_OFF + par * 4096 + wid * 1024), 16, 0, 0); } }
#define FOLDV(bj, n) (FOLD ? (acc[ai][bj][m][n] - csv[bj][n] * mu) * rs + bwv[bj][n] : acc[ai][bj][m][n])
template <bool FOLD> struct EpiInSsm {
    static constexpr bool PERM = true; static constexpr int NST = 16;
    bf16_t* UH; bf16_t* QM; Fold fo;
    FOLD_PREFETCH()
    __device__ __forceinline__ void operator()(AccRef acc, const Unit& u, int wr, int wc, int fr, int fq) const { run(acc, u, wr, wc, fr, fq, nullptr); }
    __device__ __forceinline__ void run(AccRef acc, const Unit& u, int wr, int wc, int fr, int fq, const LAS unsigned char* slot) const {
        const int cl = wc * 32 + 8 * fq; const bool isu = u.pn < 6;
        FOLD_COLS_LDS()
        const int ou = ((((u.pm >> 4) * SSG + u.pn * 16 + wc * 2 + (fq >> 1)) * 256 + (u.pm & 15) * 16 + wr * 4) * 512 + fr * 16 + 8 * (fq & 1));
        const int oq = (u.pm * BM + wr * 64 + fr) * MEMW + (u.pn * BM + wc * 32 + 8 * fq - MIXW);
        char* const obase = isu ? (char*)UH : (char*)QM; const unsigned bo = 2u * (unsigned)(isu ? ou : oq);
        const unsigned sm = isu ? 1024u : 16384u, sai = isu ? 8192u : 131072u, sbj = isu ? 2097152u : 256u;
        EPI_ROWS_BEGIN  (void)r; FOLD_ROW()
#pragma unroll
            for (int bj = 0; bj < 2; ++bj) *(u32x4*)(obase + (bo + ai * sai + m * sm + bj * sbj)) = pack8(FOLDV(bj, 0), FOLDV(bj, 1));  EPI_ROWS_END
    }
};
template <bool FOLD> struct EpiInAttn {
    static constexpr bool PERM = true; static constexpr int NST = 16;
    unsigned char* r1; const float* rope; Fold fo;
    FOLD_PREFETCH()
    __device__ __forceinline__ void operator()(AccRef acc, const Unit& u, int wr, int wc, int fr, int fq) const { run(acc, u, wr, wc, fr, fq, nullptr); }
    __device__ __forceinline__ void run(AccRef acc, const Unit& u, int wr, int wc, int fr, int fq, const LAS unsigned char* slot) const {
        const int ct = u.pn * BM + wc * 32 + 8 * fq, cl = wc * 32 + 8 * fq; const bool ro = u.pn < 8;
        const size_t boff = R1_Q + (size_t)(u.pn >= 6) * (R1_K - R1_Q) + (size_t)(u.pn >= 8) * (R1_V - R1_K) + (size_t)(u.pn >= 10) * (R1_QM - R1_V);
        bf16_t* base = (bf16_t*)(r1 + boff); const int ld = u.pn < 6 ? MIXW : KVW;
        const int c0 = ct - (u.pn >= 6) * MIXW - (u.pn >= 8) * KVW - (u.pn >= 10) * KVW;
        const int i0 = 16 * wc + 4 * fq;
        FOLD_COLS_LDS()
#ifndef RP_DIST
#define RP_DIST 2
#endif
        f32x4 rc0[8], rc1[8];
#define RP_LOAD(s) do { const int pos_ = (u.pm * BM + ((s) >> 2) * HALF + wr * 64 + ((s) & 3) * 16 + fr) & 4095; rc0[s] = *(const f32x4*)(rope + (size_t)(pos_ * 64 + i0) * 2); rc1[s] = *(const f32x4*)(rope + (size_t)(pos_ * 64 + i0) * 2 + 4); } while (0)
#pragma unroll
        for (int s = 0; s < RP_DIST; ++s) RP_LOAD(s);
        EPI_ROWS_BEGIN  if (ai * 4 + m + RP_DIST < 8) RP_LOAD(ai * 4 + m + RP_DIST);
            f32x4 cs0 = rc0[ai * 4 + m], cs1 = rc1[ai * 4 + m];
            if (!ro) { cs0 = (f32x4){1.f, 0.f, 1.f, 0.f}; cs1 = cs0; }
            bf16_t* rowp = base + (size_t)r * ld + c0; FOLD_ROW()
#pragma unroll
            for (int bj = 0; bj < 2; ++bj) { const f32x4 v0 = FOLDV(bj, 0), v1 = FOLDV(bj, 1); f32x4 o0, o1;
                o0[0] = v0[0] * cs0[0] - v0[1] * cs0[1]; o0[1] = v0[1] * cs0[0] + v0[0] * cs0[1]; o0[2] = v0[2] * cs0[2] - v0[3] * cs0[3]; o0[3] = v0[3] * cs0[2] + v0[2] * cs0[3];
                o1[0] = v1[0] * cs1[0] - v1[1] * cs1[1]; o1[1] = v1[1] * cs1[0] + v1[0] * cs1[1]; o1[2] = v1[2] * cs1[2] - v1[3] * cs1[3]; o1[3] = v1[3] * cs1[2] + v1[2] * cs1[3];
                *(u32x4*)(rowp + bj * HALF) = pack8(o0, o1); }  EPI_ROWS_END
#undef RP_LOAD
    }
};
struct EpiG1 {
    static constexpr bool PERM = true; static constexpr int NST = 16;
    bf16_t* G;
    __device__ __forceinline__ void operator()(AccRef acc, const Unit& u, int wr, int wc, int fr, int fq) const {
        char* base = (char*)(G + (size_t)(u.pm * SSG + u.pn) * 65536); const unsigned bo = 2u * (unsigned)((wr * 64 + fr) * 256 + wc * 32 + 8 * fq);
#pragma unroll
        for (int ai = 0; ai < 2; ++ai)
#pragma unroll
            for (int m = 0; m < 4; ++m)
#pragma unroll
                for (int bj = 0; bj < 2; ++bj) *(u32x4*)(base + (bo + 2u * (unsigned)((ai * HALF + m * 16) * 256 + bj * HALF))) = pack8(acc[ai][bj][m][0], acc[ai][bj][m][1]);
    }
};
__device__ __forceinline__ f32x4 gelu_tanh4(f32x4 x) {
    const f32x4 t = x * (x * x * (-2.885390081777927f * 0.7978845608028654f * 0.044715f) + (-2.885390081777927f * 0.7978845608028654f));
    f32x4 r;
#pragma unroll
    for (int j = 0; j < 4; ++j) r[j] = __builtin_amdgcn_rcpf(1.0f + __builtin_amdgcn_exp2f(t[j]));
    return x * r;
}
struct EpiG2 {
    static constexpr bool PERM = true; static constexpr int NST = 16;
    bf16_t* Z;
    __device__ __forceinline__ void operator()(AccRef acc, const Unit& u, int wr, int wc, int fr, int fq) const {
        const int c0 = wc * 32 + 8 * fq;
#pragma unroll
        for (int ai = 0; ai < 2; ++ai)
#pragma unroll
            for (int m = 0; m < 4; ++m) { const int kk = ai * HALF + wr * 64 + m * 16 + fr;
#pragma unroll
                for (int bj = 0; bj < 2; ++bj) { const int c = c0 + bj * HALF; f32x4 v0 = acc[ai][bj][m][0], v1 = acc[ai][bj][m][1];
                    v0 = gelu_tanh4(v0); v1 = gelu_tanh4(v1);
                    bf16_t* p = Z + (size_t)(u.pm * SEQ + kk * 16 + (c >> 4)) * MIXW + u.pn * 16 + (c & 15);
                    *(u32x4*)p = pack8(v0, v1); } }
    }
};
struct EpiGlu {
    static constexpr bool PERM = true; static constexpr int NST = 16;
    bf16_t* O;
    __device__ __forceinline__ void operator()(AccRef acc, const Unit& u, int wr, int wc, int fr, int fq) const {
        const int c0 = u.pn * BM + wc * 32 + 8 * fq;
        EPI_ROWS_BEGIN  bf16_t* rowp = O + (size_t)r * DM;
#pragma unroll
            for (int bj = 0; bj < 2; ++bj) { const int q4 = (c0 + bj * HALF) >> 1; const f32x4 a = acc[ai][bj][m][0], gt = acc[ai][bj][m][1]; float o[4];
#pragma unroll
                for (int j = 0; j < 4; ++j) o[j] = a[j] * __builtin_amdgcn_rcpf(1.0f + __builtin_amdgcn_exp2f(-1.4426950408889634f * gt[j]));
                u32x2 w; w.x = cvt_pk_bf16(o[0], o[1]); w.y = cvt_pk_bf16(o[2], o[3]); *(u32x2*)(rowp + q4) = w; }  EPI_ROWS_END
    }
};
template <int MODE> struct EpiResidB {
    static constexpr bool PERM = true; static constexpr int NST = 16;
    const float* xa; const float* xb2; int split; const float* stp; const float* gam; const float* bet;
    bf16_t* vb; float* part; int row_off; LAS unsigned char* lds;
    static constexpr bool PRE = MODE == 1;
    __device__ __forceinline__ void prefetch(LAS unsigned char* lds_, const Unit& u, int par, int wid, int lane) const {
        if (wid < 4) { const char* src = wid == 0 ? (const char*)(gam + u.pn * BM) : wid == 1 ? (const char*)(bet + u.pn * BM) : (const char*)(stp + 2 * (size_t)(u.pm * BM + row_off + (wid - 2) * HALF));
            __builtin_amdgcn_global_load_lds((const unsigned*)(src + lane * 16), (LAS unsigned*)(lds_ + FOLD_SLOT_OFF + par * 4096 + wid * 1024), 16, 0, 0); } }
    __device__ __forceinline__ void operator()(AccRef acc, const Unit& u, int wr, int wc, int fr, int fq) const { run(acc, u, wr, wc, fr, fq, nullptr); }
    __device__ __forceinline__ void run(AccRef acc, const Unit& u, int wr, int wc, int fr, int fq, const LAS unsigned char* slot) const {
        const int c0 = u.pn * BM + wc * 32 + 8 * fq, cl = wc * 32 + 8 * fq;
        LAS f32x2* P = (LAS f32x2*)(lds + LDSCTL_OFF + 1024);
        f32x4 gv[2][2], bv[2][2];
        if (MODE == 1) {
#pragma unroll
            for (int bj = 0; bj < 2; ++bj)
#pragma unroll
                for (int n = 0; n < 2; ++n) { gv[bj][n] = *(const LAS f32x4*)(slot + (cl + bj * HALF + 4 * n) * 4); bv[bj][n] = *(const LAS f32x4*)(slot + 1024 + (cl + bj * HALF + 4 * n) * 4); } }
#ifndef RB_DIST
#define RB_DIST 8
#endif
        constexpr int DIST = MODE == 1 ? RB_DIST : 4;
        const int row0 = u.pm * BM + row_off;
        const char* xbase = MODE == 1 ? (const char*)vb : (row0 < split ? (const char*)xa : (const char*)(xb2 - (size_t)split * DM));
        const unsigned eo = (unsigned)((row0 + wr * 64 + fr) * DM + c0);
#define RB_EO(s) (eo + (unsigned)((((s) >> 3) * HALF + (((s) >> 1) & 3) * 16) * DM + ((s) & 1) * HALF))
#define RB_LOAD(s) do { if (MODE == 1) wq[s] = *(const u32x4*)(xbase + 2 * RB_EO(s)); else { xq0[s] = *(const f32x4*)(xbase + 4 * RB_EO(s)); xq1[s] = *(const f32x4*)(xbase + 4 * RB_EO(s) + 16); } } while (0)
        u32x4 wq[16]; f32x4 xq0[16], xq1[16];
#pragma unroll
        for (int s = 0; s < DIST; ++s) RB_LOAD(s);
        float s1 = 0.f, s2 = 0.f;
#pragma unroll
        for (int s = 0; s < 16; ++s) { const int ai = s >> 3, m = (s >> 1) & 3, bj = s & 1;
            if (s + DIST < 16) RB_LOAD(s + DIST);
            f32x2 st_ = {0.f, 1.f}; if (MODE == 1) st_ = *(const LAS f32x2*)(slot + 2048 + (ai * HALF + wr * 64 + m * 16 + fr) * 8);
            const float rs = st_.y, nmr = -st_.x * rs;
            f32x4 x0, x1;
            if (MODE == 1) { const u32x4 w = wq[s];
                x0 = (f32x4){bflo(w.x), bfhi(w.x), bflo(w.y), bfhi(w.y)}; x1 = (f32x4){bflo(w.z), bfhi(w.z), bflo(w.w), bfhi(w.w)};
                x0 = (x0 * rs + nmr) * gv[bj][0] + bv[bj][0]; x1 = (x1 * rs + nmr) * gv[bj][1] + bv[bj][1]; }
            else { x0 = xq0[s]; x1 = xq1[s]; }
            const f32x4 v0 = x0 * ALPHA + acc[ai][bj][m][0], v1 = x1 * ALPHA + acc[ai][bj][m][1];
            *(u32x4*)((char*)vb + 2 * RB_EO(s)) = pack8(v0, v1);
            { const f32x4 q = v0 + v1, q2 = v0 * v0 + v1 * v1; s1 += (q[0] + q[1]) + (q[2] + q[3]); s2 += (q2[0] + q2[1]) + (q2[2] + q2[3]); }
            if (bj == 1) { s1 += __shfl_xor(s1, 16); s1 += __shfl_xor(s1, 32); s2 += __shfl_xor(s2, 16); s2 += __shfl_xor(s2, 32);
                if (fq == 0) P[(ai * HALF + wr * 64 + m * 16 + fr) * 4 + wc] = (f32x2){s1, s2};
                s1 = 0.f; s2 = 0.f; } }
#undef RB_EO
#undef RB_LOAD
        asm volatile("s_waitcnt lgkmcnt(0)" ::: "memory"); __builtin_amdgcn_s_barrier(); asm volatile("" ::: "memory");
        if (wr == 0) { const int rl = wc * 64 + fq * 16 + fr; const f32x4 p01 = *(const LAS f32x4*)(P + rl * 4), p23 = *(const LAS f32x4*)(P + rl * 4 + 2);
            *(f32x2*)(part + ((size_t)(u.pm * BM + row_off + rl) * 8 + u.pn) * 2) = (f32x2){(p01[0] + p01[2]) + (p23[0] + p23[2]), (p01[1] + p01[3]) + (p23[1] + p23[3])}; }
    }
};
template <bool FOLD> struct EpiSqReluT {
    static constexpr bool PERM = true; static constexpr int NST = 16;
    bf16_t* O; int ldc; Fold fo;
    FOLD_PREFETCH()
    __device__ __forceinline__ void operator()(AccRef acc, const Unit& u, int wr, int wc, int fr, int fq) const { run(acc, u, wr, wc, fr, fq, nullptr); }
    __device__ __forceinline__ void run(AccRef acc, const Unit& u, int wr, int wc, int fr, int fq, const LAS unsigned char* slot) const {
        const int c0 = u.pn * BM + wc * 32 + 8 * fq, cl = wc * 32 + 8 * fq;
        FOLD_COLS_LDS_F()
        const unsigned bo = 2u * (unsigned)((u.pm * BM + wr * 64 + fr) * ldc + c0);
        EPI_ROWS_BEGIN  (void)r; FOLD_ROW()
#pragma unroll
            for (int bj = 0; bj < 2; ++bj) { f32x4 v0 = FOLDV(bj, 0), v1 = FOLDV(bj, 1);
#pragma unroll
                for (int j = 0; j < 4; ++j) { const float a = fmaxf(v0[j], 0.f), b = fmaxf(v1[j], 0.f); v0[j] = a * a; v1[j] = b * b; }
                *(u32x4*)((char*)O + (bo + 2u * (unsigned)((ai * HALF + m * 16) * ldc + bj * HALF))) = pack8(v0, v1); }  EPI_ROWS_END
    }
};
typedef EpiSqReluT<true> EpiSqRelu;
}

#define XB_TMO      128
#define XB_XCNT(j)  (256  + 64 * (j))
#define XB_XSUB(j)  (1280 + 64 * (j))
#define XB_XGEN(j)  (2304 + 64 * (j))
#define XB_TOP      3328
#define XB_TOPGEN   3392
#define XCD_BAR_WORDS 3456
#define XB_SPIN_CAP (1u << 22)
__device__ __forceinline__ unsigned xb_ld(unsigned* p)              { return __hip_atomic_load(p, __ATOMIC_RELAXED, __HIP_MEMORY_SCOPE_AGENT); }
__device__ __forceinline__ unsigned xb_add(unsigned* p, unsigned v) { return __hip_atomic_fetch_add(p, v, __ATOMIC_RELAXED, __HIP_MEMORY_SCOPE_AGENT); }
__device__ __forceinline__ unsigned xb_xcc_id() { return (unsigned)__builtin_amdgcn_s_getreg((3 << 11) | 20) & 0xFu; }
#define XB_SPIN(cond, bar) do { unsigned _sp = 0; while (cond) { __builtin_amdgcn_s_sleep(1); \
    if ((++_sp & 255u) == 0u) { if (xb_ld(&(bar)[XB_TMO])) break; if (_sp > XB_SPIN_CAP) { atomicAdd(&(bar)[XB_TMO], 1u); break; } } } } while (0)
struct XcdBarrier { unsigned* bar; unsigned x; volatile LAS unsigned* st; };
__device__ __forceinline__ XcdBarrier xcd_barrier_post(unsigned* bar, volatile LAS unsigned* st, bool leader) {
    XcdBarrier b; b.bar = bar; b.x = xb_xcc_id(); b.st = st;
    if (leader) (void)xb_add(&bar[XB_XCNT(b.x)], 1u);
    return b;
}
__device__ __forceinline__ void xcd_barrier_complete(unsigned* bar, unsigned x, unsigned& nloc, unsigned& nx) {
    const unsigned G = gridDim.x * gridDim.y * gridDim.z;
    unsigned sum, cnt, mine, sp = 0u;
    for (;;) {
        sum = 0u; cnt = 0u; mine = 0u;
#pragma unroll
        for (unsigned j = 0; j < 16; ++j) { const unsigned c = xb_ld(&bar[XB_XCNT(j)]); sum += c; cnt += (c > 0u) ? 1u : 0u; mine = (j == x) ? c : mine; }
        if (sum == G) break;
        __builtin_amdgcn_s_sleep(1);
        if ((++sp & 255u) == 0u) { if (xb_ld(&bar[XB_TMO])) break; if (sp > XB_SPIN_CAP) { atomicAdd(&bar[XB_TMO], 1u); break; } }
    }
    nloc = mine > 0u ? mine : 1u; nx = cnt > 0u ? cnt : 1u;
}
__device__ __forceinline__ void xcd_barrier(const XcdBarrier& b, bool leader) {
    asm volatile("s_waitcnt vmcnt(0)" ::: "memory");
    __syncthreads();
    if (leader) {
        unsigned* bar = b.bar;
        __builtin_amdgcn_s_waitcnt(0);
        unsigned nloc = b.st[0], nx = b.st[1];
        if (nloc == 0u) { xcd_barrier_complete(bar, b.x, nloc, nx); b.st[0] = nloc; b.st[1] = nx; }
        const unsigned old = xb_add(&bar[XB_XSUB(b.x)], 1u);
        const unsigned gen = old / nloc;
        if (nloc > 1u && old == gen * nloc) { __builtin_amdgcn_fence(__ATOMIC_RELEASE, "agent"); asm volatile("s_waitcnt vmcnt(0)" ::: "memory"); }
        if (old + 1u == (gen + 1u) * nloc) {
            __builtin_amdgcn_fence(__ATOMIC_RELEASE, "agent");
            asm volatile("s_waitcnt vmcnt(0)" ::: "memory");
            const unsigned og = xb_add(&bar[XB_TOP], 1u);
            const unsigned tg = og / nx;
            if (og + 1u == (tg + 1u) * nx) xb_add(&bar[XB_TOPGEN], 1u);
            else XB_SPIN(xb_ld(&bar[XB_TOPGEN]) == tg, bar);
            __builtin_amdgcn_fence(__ATOMIC_ACQUIRE, "agent");
            xb_add(&bar[XB_XGEN(b.x)], 1u);
            asm volatile("s_waitcnt vmcnt(0)" ::: "memory");
        } else {
            XB_SPIN(xb_ld(&bar[XB_XGEN(b.x)]) == gen, bar);
            __builtin_amdgcn_fence(__ATOMIC_ACQUIRE, "agent");
            asm volatile("s_waitcnt vmcnt(0)" ::: "memory");
        }
    }
    __syncthreads();
}

#define GB_CNT(g) (4096 + 64 * (g))
#define GB_GEN(g) (4608 + 64 * (g))
#define GB_FLAG   5120
__device__ __forceinline__ void group_barrier(unsigned* bar, bool leader) {
    asm volatile("s_waitcnt vmcnt(0)" ::: "memory");
    __syncthreads();
    if (leader) {
        const unsigned g = blockIdx.x & 7u, n = (gridDim.x + 7u - g) / 8u;
        const unsigned old = xb_add(&bar[GB_CNT(g)], 1u);
        const unsigned gen = old / n;
        if (old + 1u == (gen + 1u) * n) xb_add(&bar[GB_GEN(g)], 1u);
        else XB_SPIN(xb_ld(&bar[GB_GEN(g)]) == gen, bar);
        __builtin_amdgcn_fence(__ATOMIC_ACQUIRE, "agent");
        asm volatile("s_waitcnt vmcnt(0)" ::: "memory");
    }
    __syncthreads();
}

struct Args { const float* in[24]; float* out; unsigned char* ws; int lin_lo, lin_hi; };
typedef const __attribute__((address_space(4))) Args* CAP;
struct Frame {
    LAS unsigned char* lds; int tid, lane, wave, G, gw, NGW;
};
__device__ __forceinline__ int lane_id_opaque() { int l; asm volatile("v_mbcnt_lo_u32_b32 %0, -1, 0\n\tv_mbcnt_hi_u32_b32 %0, -1, %0" : "=v"(l)); return l; }
__device__ __forceinline__ float wave_sum(float v) {
#pragma unroll
    for (int o = 1; o < 64; o <<= 1) v += __shfl_xor(v, o);
    return v;
}
__device__ __forceinline__ void sincos_d(double x, double& s, double& c) {
    const double TWO_PI = 6.283185307179586476925286766559;
    const double n = __builtin_rint(x * (1.0 / TWO_PI)); const double r = x - n * TWO_PI, r2 = r * r;
    double ts = 1.0, tc = 1.0, ss = 1.0, cc = 1.0;
#pragma unroll 1
    for (int k = 1; k <= 14; ++k) { tc *= -r2 / (double)((2 * k - 1) * (2 * k)); ts *= -r2 / (double)((2 * k) * (2 * k + 1)); cc += tc; ss += ts; }
    s = ss * r; c = cc;
}

template <class RowMap>
__device__ __forceinline__ void transpose_item(const float* W, int K, int N, bf16_t* WT, const RowMap& rm, LAS float* scr, int item, int lane,
                                               const float* gam = nullptr, const float* bet = nullptr, float* cs = nullptr, float* bw = nullptr) {
    const int nblk = N / 32, kb = item / nblk, nb = item % nblk, k0 = 64 * kb, n0 = 32 * nb;
    const int r = lane >> 3, c4 = 4 * (lane & 7);
    f32x4 w[8];
#pragma unroll
    for (int i = 0; i < 8; ++i) w[i] = *(const f32x4*)(W + (size_t)(k0 + 8 * i + r) * N + n0 + c4);
    if (gam) {
        float gk[8], bk[8];
#pragma unroll
        for (int i = 0; i < 8; ++i) { gk[i] = gam[k0 + 8 * i + r]; bk[i] = bet[k0 + 8 * i + r]; }
        f32x4 acs = {0.f, 0.f, 0.f, 0.f}, abw = {0.f, 0.f, 0.f, 0.f};
#pragma unroll
        for (int i = 0; i < 8; ++i) { const int kk = 8 * i + r;
#pragma unroll
            for (int e = 0; e < 4; ++e) { const float gw = bf2f((unsigned short)f2bf(gk[i] * w[i][e])); scr[kk * 33 + c4 + e] = gw; acs[e] += gw; abw[e] += bk[i] * w[i][e]; } }
#pragma unroll
        for (int e = 0; e < 4; ++e) {
#pragma unroll
            for (int o = 8; o < 64; o <<= 1) { acs[e] += __shfl_xor(acs[e], o); abw[e] += __shfl_xor(abw[e], o); } }
        if (lane < 8) {
#pragma unroll
            for (int e = 0; e < 4; ++e) { const int rn = rm(n0 + c4 + e);
                __hip_atomic_fetch_add((int*)cs + rn, (int)rintf(acs[e] * 16777216.f), __ATOMIC_RELAXED, __HIP_MEMORY_SCOPE_AGENT); __hip_atomic_fetch_add((int*)bw + rn, (int)rintf(abw[e] * 16777216.f), __ATOMIC_RELAXED, __HIP_MEMORY_SCOPE_AGENT); } }
    } else {
#pragma unroll
        for (int i = 0; i < 8; ++i)
#pragma unroll
            for (int e = 0; e < 4; ++e) scr[(8 * i + r) * 33 + c4 + e] = w[i][e];
    }
    LDS_WAIT(); asm volatile("" ::: "memory");
    const int c = lane & 7;
#pragma unroll
    for (int j = 0; j < 4; ++j) { const int n = (lane >> 3) + 8 * j; const LAS float* s = scr + (8 * c) * 33 + n;
        u32x4 o; o.x = pk2(s[0 * 33], s[1 * 33]); o.y = pk2(s[2 * 33], s[3 * 33]); o.z = pk2(s[4 * 33], s[5 * 33]); o.w = pk2(s[6 * 33], s[7 * 33]);
        *(u32x4*)(WT + (size_t)rm(n0 + n) * K + k0 + 8 * c) = o; }
    LDS_WAIT(); asm volatile("" ::: "memory");
}
struct RowIdent { int off; __device__ __forceinline__ int operator()(int n) const { return n + off; } };
struct RowRope { __device__ __forceinline__ int operator()(int n) const { if (n >= MIXW + KVW) return n; const int d = n & 127, base = n - d; return base + (d < 64 ? 2 * d : 2 * (d - 64) + 1); } };
struct RowGlu { __device__ __forceinline__ int operator()(int n) const { const int e = n >= MIXW ? 1 : 0, cc = n - e * MIXW; return 8 * (cc >> 2) + 4 * e + (cc & 3); } };

__device__ __forceinline__ void cvt_rows(const Frame& F, const float* src, bf16_t* dst, size_t n8) {
    const size_t st = (size_t)F.G * 512;
    for (size_t i = (size_t)blockIdx.x * 512 + F.tid; i < n8; i += 4 * st) {
        f32x4 a[4], b[4];
#pragma unroll
        for (int u = 0; u < 4; ++u) { const size_t k = i + u * st < n8 ? i + u * st : i; a[u] = *(const f32x4*)(src + k * 8); b[u] = *(const f32x4*)(src + k * 8 + 4); }
#pragma unroll
        for (int u = 0; u < 4; ++u) if (i + u * st < n8) { u32x4 o; o.x = pk2(a[u][0], a[u][1]); o.y = pk2(a[u][2], a[u][3]); o.z = pk2(b[u][0], b[u][1]); o.w = pk2(b[u][2], b[u][3]);
            *(u32x4*)(dst + (i + u * st) * 8) = o; }
    }
}

__device__ __forceinline__ void phase_pr0(const Frame& F, CAP a) {
    unsigned char* ws = a->ws;
    bf16_t* XB = (bf16_t*)(ws + WS_XB);
    cvt_rows(F, a->in[0], XB, (size_t)MROWS_PROMPT * DM / 8);
    cvt_rows(F, a->in[1], XB + (size_t)MROWS_PROMPT * DM, (size_t)(MTOK - MROWS_PROMPT) * DM / 8);
    bf16_t* MEMB = (bf16_t*)(ws + WS_R1 + R1_MEMB);
    cvt_rows(F, a->in[2], MEMB, (size_t)8 * NMEM * DM / 8);
    cvt_rows(F, a->in[3], MEMB + (size_t)8 * NMEM * DM, (size_t)4 * NMEM * DM / 8);
    LAS float* scr = (LAS float*)(F.lds + F.wave * 16384);
    constexpr int I_MKV = (DM / 64) * (1024 / 32);
    for (int it = F.gw; it < 4 * I_MKV; it += F.NGW) { const int l = it / I_MKV, r = it % I_MKV;
        transpose_item(a->in[16] + (size_t)l * DM * 1024, DM, 1024, (bf16_t*)(ws + WS_R1 + R1_WMKV), RowIdent{l * 1024}, scr, r, F.lane); }
    float* rope = (float*)(ws + WS_ROPE);
    for (int i = blockIdx.x * 512 + F.tid; i < SEQ * 64; i += F.G * 512) { const int pos = i >> 6, f = i & 63;
        double inv = 1.0; const double rr = 0.86596432336006535;
        for (int k = 0; k < f; ++k) inv *= rr;
        double s, c; sincos_d((double)pos * inv, s, c); rope[2 * i] = (float)c; rope[2 * i + 1] = (float)s; }
    f32x2* POW = (f32x2*)(ws + WS_POW); f32x2* BBAR = (f32x2*)(ws + WS_BBAR);
    for (int i = blockIdx.x * 512 + F.tid; i < 2 * 2 * SSG * SSP; i += F.G * 512) {
        const int p = i & 63, gdj = i >> 6;
        const double lr = (double)a->in[5][i], li = (double)a->in[6][i];
        const double dt = (double)__expf(a->in[7][gdj]) ;
        double er; { const double x = lr * dt; double t = 1.0; er = 1.0;
#pragma unroll 1
            for (int k = 1; k <= 12; ++k) { t *= x / (double)k; er += t; } }
        double s1, c1; sincos_d(li * dt, s1, c1);
        const double br = er * c1, bi = er * s1;
        double pr = 1.0, pi_ = 0.0;
        for (int e = 0; e <= 16; ++e) { POW[(size_t)i * 17 + e] = (f32x2){(float)pr, (float)pi_}; const double nr = pr * br - pi_ * bi, ni = pr * bi + pi_ * br; pr = nr; pi_ = ni; }
        const double nr_ = br - 1.0, ni_ = bi, den = lr * lr + li * li; const double cr = (nr_ * lr + ni_ * li) / den, ci = (ni_ * lr - nr_ * li) / den;
        f32x4 brv[4], biv[4];
#pragma unroll
        for (int q = 0; q < 4; ++q) { brv[q] = *(const f32x4*)(a->in[8] + (size_t)i * 16 + 4 * q); biv[q] = *(const f32x4*)(a->in[9] + (size_t)i * 16 + 4 * q); }
#pragma unroll
        for (int c = 0; c < SSC; ++c) { const double b_r = (double)brv[c >> 2][c & 3], b_i = (double)biv[c >> 2][c & 3];
            BBAR[(size_t)i * 16 + c] = (f32x2){(float)(cr * b_r - ci * b_i), (float)(cr * b_i + ci * b_r)}; }
    }
}
__device__ __forceinline__ void phase_kt(const Frame& F, CAP a) {
    const f32x2* POW = (const f32x2*)(a->ws + WS_POW); const f32x2* BBAR = (const f32x2*)(a->ws + WS_BBAR); float* KT = (float*)(a->ws + WS_KT);
    for (int i = blockIdx.x * 512 + F.tid; i < 2 * 2 * SSG * 16 * 256; i += F.G * 512) {
        const int cp = i & 15, c = (i >> 4) & 15, tau = (i >> 8) & 15, gdj = i >> 12;
        const float* cre = a->in[10] + ((size_t)gdj * 16 + c) * 64; const float* cim = a->in[11] + ((size_t)gdj * 16 + c) * 64;
        float s = 0.f;
        for (int p = 0; p < SSP; ++p) { const f32x2 pw = POW[((size_t)gdj * 64 + p) * 17 + tau], bb = BBAR[((size_t)gdj * 64 + p) * 16 + cp];
            const float wr_ = pw.x * bb.x - pw.y * bb.y, wi_ = pw.x * bb.y + pw.y * bb.x;
            s += cre[p] * wr_ - cim[p] * wi_; }
        KT[i] = s;
    }
}
__device__ __forceinline__ void phase_wconv(const Frame& F, CAP a, int layer) {
    unsigned char* ws = a->ws; const int j = layer >> 1; const bool attn = layer & 1;
    LAS float* scr = (LAS float*)(F.lds + F.wave * 16384);
    float* csbw = (float*)(ws + WS_CSBW) + (size_t)layer * 32768;
    const int NIN = attn ? 3072 : 2048;
    const int I_IN = (DM / 64) * (NIN / 32), I_GLU = attn ? 0 : (MIXW / 64) * (3072 / 32), I_OUT = (DM / 64) * (DM / 32), I_F1 = (DM / 64) * (DFF / 32), I_F2 = (DFF / 64) * (DM / 32);
    const int NIT = I_IN + I_GLU + I_OUT + I_F1 + I_F2;
    for (int it = F.gw; it < NIT; it += F.NGW) {
        int r = it;
        if (r < I_IN) { const float* gp = layer > 0 ? a->in[22] + (size_t)(layer - 1) * DM : nullptr; const float* bp = layer > 0 ? a->in[23] + (size_t)(layer - 1) * DM : nullptr;
                        if (attn) transpose_item(a->in[14] + (size_t)j * DM * 3072, DM, 3072, (bf16_t*)(ws + WS_WIN), RowRope{}, scr, r, F.lane, gp, bp, csbw + 0, csbw + 8192);
                        else transpose_item(a->in[4] + (size_t)j * DM * DM, DM, DM, (bf16_t*)(ws + WS_WIN), RowIdent{0}, scr, r, F.lane, gp, bp, csbw + 0, csbw + 8192); continue; } r -= I_IN;
        if (r < I_GLU) { transpose_item(a->in[13] + (size_t)j * MIXW * 3072, MIXW, 3072, (bf16_t*)(ws + WS_WGLU), RowGlu{}, scr, r, F.lane); continue; } r -= I_GLU;
        if (r < I_OUT) { transpose_item(a->in[17] + (size_t)layer * DM * DM, DM, DM, (bf16_t*)(ws + WS_WOUT), RowIdent{0}, scr, r, F.lane); continue; } r -= I_OUT;
        if (r < I_F1) { transpose_item(a->in[20] + (size_t)layer * DM * DFF, DM, DFF, (bf16_t*)(ws + WS_WFF1), RowIdent{0}, scr, r, F.lane, a->in[18] + (size_t)layer * DM, a->in[19] + (size_t)layer * DM, csbw + 16384, csbw + 24576); continue; } r -= I_F1;
        transpose_item(a->in[21] + (size_t)layer * DFF * DM, DFF, DM, (bf16_t*)(ws + WS_WFF2), RowIdent{0}, scr, r, F.lane);
    }
    if (!attn) {
        const f32x2* POW = (const f32x2*)(ws + WS_POW) + (size_t)j * 2 * SSG * SSP * 17; const f32x2* BBAR = (const f32x2*)(ws + WS_BBAR) + (size_t)j * 2 * SSG * SSP * 16;
        const float* KT = (const float*)(ws + WS_KT) + (size_t)j * 2 * SSG * 4096;
        const float* CRE = a->in[10] + (size_t)j * 2 * SSG * 1024; const float* CIM = a->in[11] + (size_t)j * 2 * SSG * 1024; const float* DSK = a->in[12] + (size_t)j * MIXW;
        bf16_t* WG = (bf16_t*)(ws + WS_SWG); bf16_t* WY = (bf16_t*)(ws + WS_SWY);
        const int st = F.G * 512;
        for (int i0 = blockIdx.x * 512 + F.tid; i0 < SSG * 256 * 128; i0 += 4 * st) {
            unsigned o[4];
#pragma unroll
            for (int u = 0; u < 4; ++u) { const int i = i0 + u * st < SSG * 256 * 128 ? i0 + u * st : i0;
                const int k2 = (i & 127) * 2, n = (i >> 7) & 255, g = i >> 15; const int dir = n >> 7, comp = n & 1, p = (n & 127) >> 1, s = k2 >> 4, cp = k2 & 15;
                const int e = dir == 0 ? 15 - s : s; const size_t gd = (size_t)(dir * SSG + g) * 64 + p; const f32x2 pw = POW[gd * 17 + e];
                float v[2];
#pragma unroll
                for (int q = 0; q < 2; ++q) { const f32x2 bb = BBAR[gd * 16 + cp + q]; v[q] = comp == 0 ? pw.x * bb.x - pw.y * bb.y : pw.x * bb.y + pw.y * bb.x; }
                o[u] = pk2(v[0], v[1]); }
#pragma unroll
            for (int u = 0; u < 4; ++u) if (i0 + u * st < SSG * 256 * 128) *(unsigned*)(WG + (size_t)(i0 + u * st) * 2) = o[u];
        }
        for (int i0 = blockIdx.x * 512 + F.tid; i0 < SSG * 256 * 256; i0 += 4 * st) {
            unsigned o[4]; const int k2 = (i0 & 255) * 2;
            if (k2 < 256) { const int s = k2 >> 4, cp = k2 & 15;
#pragma unroll
                for (int u = 0; u < 4; ++u) { const int i = i0 + u * st < SSG * 256 * 256 ? i0 + u * st : i0; const int n = (i >> 8) & 255, g = i >> 16, t = n >> 4, c = n & 15;
                    const int df = t - s > 0 ? t - s : 0, db = s - t > 0 ? s - t : 0;
                    const f32x2 kf = *(const f32x2*)(KT + ((size_t)(0 * SSG + g) * 16 + df) * 256 + c * 16 + cp), kb = *(const f32x2*)(KT + ((size_t)(1 * SSG + g) * 16 + db) * 256 + c * 16 + cp);
                    const float dsk = DSK[g * 16 + c];
                    float v0 = 0.f, v1 = 0.f;
                    if (s <= t) { v0 += kf.x; v1 += kf.y; }
                    if (s >= t) { v0 += kb.x; v1 += kb.y; }
                    if (s == t && cp == c) v0 += dsk;
                    if (s == t && cp + 1 == c) v1 += dsk;
                    o[u] = pk2(v0, v1); }
            } else { const int dir = (k2 - 256) >> 7, p = ((k2 - 256) & 127) >> 1;
#pragma unroll
                for (int u = 0; u < 4; ++u) { const int i = i0 + u * st < SSG * 256 * 256 ? i0 + u * st : i0; const int n = (i >> 8) & 255, g = i >> 16, t = n >> 4, c = n & 15;
                    const int e = dir == 0 ? t + 1 : 16 - t;
                    const f32x2 pw = POW[((size_t)(dir * SSG + g) * 64 + p) * 17 + e]; const size_t ci = ((size_t)(dir * SSG + g) * 16 + c) * 64 + p; const float cr = CRE[ci], cim = CIM[ci];
                    o[u] = pk2(cr * pw.x - cim * pw.y, -(cr * pw.y + cim * pw.x)); }
            }
#pragma unroll
            for (int u = 0; u < 4; ++u) if (i0 + u * st < SSG * 256 * 256) *(unsigned*)(WY + (size_t)(i0 + u * st) * 2) = o[u];
        }
    }
}
__device__ __forceinline__ void phase_scan(const Frame& F, CAP a, int j) {
    unsigned char* ws = a->ws; const char* G = (const char*)(ws + WS_R1 + R1_G); char* UH = (char*)(ws + WS_R1 + R1_UH);
    const f32x2* POW = (const f32x2*)(ws + WS_POW) + (size_t)j * 2 * SSG * SSP * 17;
    for (int it = F.wave; ; it += NWAVES) { const int L = it * F.G + (int)blockIdx.x; if (L >= NBATCH * SSG) break;
        const int bg = (L % NBATCH) * SSG + L / NBATCH;
        const int g = bg % SSG, dir = F.lane >> 5, p0 = 2 * (F.lane & 31);
        const f32x2 la = POW[((size_t)(dir * SSG + g) * 64 + p0) * 17 + 16], lb = POW[((size_t)(dir * SSG + g) * 64 + p0 + 1) * 17 + 16];
        const char* gb = G + (size_t)bg * 131072; char* hb = UH + (size_t)bg * 262144 + 512;
        const int sg = dir == 0 ? 512 : -512, g0 = (dir == 0 ? 0 : 255 * 512) + 8 * F.lane, h0 = (dir == 0 ? 0 : 255 * 1024) + 8 * F.lane;
        float ar = 0.f, ai = 0.f, br = 0.f, bi = 0.f;
        u32x2 wa[16], wb[16];
#define SCAN_LOAD(w, kb) _Pragma("unroll") for (int i = 0; i < 16; ++i) w[i] = *(const u32x2*)(gb + (unsigned)(g0 + ((kb) + i) * sg));
#define SCAN_STEPS(w, kb) _Pragma("unroll") for (int i = 0; i < 16; ++i) { u32x2 o; o.x = pg8::cvt_pk_bf16(ar, ai); o.y = pg8::cvt_pk_bf16(br, bi); *(u32x2*)(hb + (unsigned)(h0 + ((kb) + i) * 2 * sg)) = o; \
            const float nar = la.x * ar - la.y * ai + bflo(w[i].x), nai = la.x * ai + la.y * ar + bfhi(w[i].x), nbr = lb.x * br - lb.y * bi + bflo(w[i].y), nbi = lb.x * bi + lb.y * br + bfhi(w[i].y); \
            ar = nar; ai = nai; br = nbr; bi = nbi; }
        SCAN_LOAD(wa, 0)
#pragma unroll 1
        for (int kb = 0; kb < 256; kb += 32) {
            SCAN_LOAD(wb, kb + 16)
            SCAN_STEPS(wa, kb)
            const int kn = kb + 32 < 256 ? kb + 32 : 240;
            SCAN_LOAD(wa, kn)
            SCAN_STEPS(wb, kb + 16)
        }
#undef SCAN_LOAD
#undef SCAN_STEPS
    }
}
__device__ __forceinline__ void phase_finalize(const Frame& F, const float* part, float* st, float* fx = nullptr) {
    if (fx) for (int i = blockIdx.x * 512 + F.tid; i < 16384; i += F.G * 512) fx[i] = (float)((const int*)fx)[i] * 5.9604644775390625e-08f;
    for (int r = blockIdx.x * 512 + F.tid; r < MTOK; r += F.G * 512) { const f32x4* p = (const f32x4*)(part + (size_t)r * 16); const f32x4 a0 = p[0], a1 = p[1], a2 = p[2], a3 = p[3];
        const float S = ((a0[0] + a0[2]) + (a1[0] + a1[2])) + ((a2[0] + a2[2]) + (a3[0] + a3[2])), Q = ((a0[1] + a0[3]) + (a1[1] + a1[3])) + ((a2[1] + a2[3]) + (a3[1] + a3[3]));
        const float mu = S * (1.0f / DM); *(f32x2*)(st + 2 * (size_t)r) = (f32x2){mu, 1.0f / sqrtf(Q * (1.0f / DM) - mu * mu + LN_EPS)}; }
}
__device__ __forceinline__ void phase_ln_final(const Frame& F, const bf16_t* vb, float* out, const float* gam, const float* bet) {
    u32x4 wn[4];
#pragma unroll
    for (int q = 0; q < 4; ++q) wn[q] = ((const u32x4*)(vb + (size_t)(F.gw < MTOK ? F.gw : 0) * DM) + F.lane)[64 * q];
    for (int m = F.gw; m < MTOK; m += F.NGW) {
        u32x4 wc[4];
#pragma unroll
        for (int q = 0; q < 4; ++q) wc[q] = wn[q];
        { const int mn = m + F.NGW < MTOK ? m + F.NGW : m; const u32x4* vr = (const u32x4*)(vb + (size_t)mn * DM) + F.lane;
#pragma unroll
          for (int q = 0; q < 4; ++q) wn[q] = vr[64 * q]; }
        float v[4][8]; float s = 0.f;
#pragma unroll
        for (int q = 0; q < 4; ++q) { const u32x4 w = wc[q]; v[q][0] = bflo(w.x); v[q][1] = bfhi(w.x); v[q][2] = bflo(w.y); v[q][3] = bfhi(w.y); v[q][4] = bflo(w.z); v[q][5] = bfhi(w.z); v[q][6] = bflo(w.w); v[q][7] = bfhi(w.w);
#pragma unroll
            for (int e = 0; e < 8; ++e) s += v[q][e]; }
        const float mean = wave_sum(s) * (1.f / DM); float s2 = 0.f;
#pragma unroll
        for (int q = 0; q < 4; ++q)
#pragma unroll
            for (int e = 0; e < 8; ++e) { v[q][e] -= mean; s2 += v[q][e] * v[q][e]; }
        const float rstd = 1.f / sqrtf(wave_sum(s2) * (1.f / DM) + LN_EPS);
#pragma unroll
        for (int q = 0; q < 4; ++q) { const int c = (F.lane + 64 * q) * 8; float* o = out + (size_t)m * DM + c;
#pragma unroll
            for (int h = 0; h < 2; ++h) { const f32x4 gv = *(const f32x4*)(gam + c + 4 * h), bv = *(const f32x4*)(bet + c + 4 * h);
                *(f32x4*)(o + 4 * h) = (f32x4){v[q][4 * h] * rstd, v[q][4 * h + 1] * rstd, v[q][4 * h + 2] * rstd, v[q][4 * h + 3] * rstd} * gv + bv; } }
    }
}
namespace att {
typedef short s16x4 __attribute__((ext_vector_type(4)));
typedef float f32x16 __attribute__((ext_vector_type(16)));
constexpr float SCALE = 0.088388347648318440f;
constexpr int KVB = 64;
constexpr int SHM_K = KVB * HD * 2, SHM_V = KVB * HD * 2;
constexpr int OFF_V = 0, OFF_K = 2 * SHM_V, OFF_WS = 2 * SHM_V + 2 * SHM_K, OFF_OST = 0;
#define KSWZ(row, colB) ((row) * 256 + ((colB) ^ (((row) & 7) << 4)))
#define SBAR() __builtin_amdgcn_sched_barrier(0)
__device__ __forceinline__ int crow(int r, int hi) { return (r & 3) + 8 * (r >> 2) + 4 * hi; }
__device__ __forceinline__ unsigned cvtpk(float lo, float hi) { unsigned r; asm volatile("v_cvt_pk_bf16_f32 %0, %1, %2" : "=v"(r) : "v"(lo), "v"(hi)); return r; }
__device__ __forceinline__ void partialSM(f32x16& p0, f32x16& p1, float& m_reg, float& mn, float& alpha) {
  constexpr float C = SCALE * 1.4426950408889634f;
  float pmax = p0[0];
#pragma unroll
  for (int r = 1; r < 16; ++r) pmax = fmaxf(pmax, p0[r]);
#pragma unroll
  for (int r = 0; r < 16; ++r) pmax = fmaxf(pmax, p1[r]);
  { auto rr = __builtin_amdgcn_permlane32_swap(__float_as_uint(pmax), __float_as_uint(pmax), false, false);
    pmax = fmaxf(__uint_as_float(rr[0]), __uint_as_float(rr[1])); }
  if (__all(pmax <= m_reg)) { mn = m_reg; alpha = 1.f; }
  else { mn = fmaxf(m_reg, pmax); alpha = __builtin_amdgcn_exp2f((m_reg - mn) * C); m_reg = mn; }
  const float mnC = -mn * C;
#pragma unroll
  for (int r = 0; r < 16; ++r) p0[r] = __builtin_amdgcn_exp2f(fmaf(p0[r], C, mnC));
#pragma unroll
  for (int r = 0; r < 16; ++r) p1[r] = __builtin_amdgcn_exp2f(fmaf(p1[r], C, mnC));
}
__device__ __forceinline__ void finishSM(f32x16& p0, f32x16& p1, float alpha, float& l_reg, bf16x8& pa0, bf16x8& pa1, bf16x8& pa2, bf16x8& pa3) {
  float ps = 0;
#pragma unroll
  for (int r = 0; r < 16; ++r) ps += p0[r];
#pragma unroll
  for (int r = 0; r < 16; ++r) ps += p1[r];
  { auto rr = __builtin_amdgcn_permlane32_swap(__float_as_uint(ps), __float_as_uint(ps), false, false);
    ps = __uint_as_float(rr[0]) + __uint_as_float(rr[1]); }
  l_reg = l_reg * alpha + ps;
#define PK4(P, BASE, OUT) do { unsigned a0 = cvtpk(P[BASE + 0], P[BASE + 1]), a1 = cvtpk(P[BASE + 2], P[BASE + 3]);   \
    unsigned b0 = cvtpk(P[BASE + 4], P[BASE + 5]), b1 = cvtpk(P[BASE + 6], P[BASE + 7]);                              \
    auto r0 = __builtin_amdgcn_permlane32_swap(a0, b0, false, false); auto r1 = __builtin_amdgcn_permlane32_swap(a1, b1, false, false); \
    u32x4 w = {r0[0], r1[0], r0[1], r1[1]}; OUT = *reinterpret_cast<bf16x8*>(&w); } while (0)
  PK4(p0, 0, pa0); PK4(p0, 8, pa1); PK4(p1, 0, pa2); PK4(p1, 8, pa3);
#undef PK4
}
__device__ __forceinline__ void qkt(f32x16& p0, f32x16& p1, const LAS char* Ks, const bf16x8* qr, int r32, int hi) {
  p0 = f32x16{}; p1 = f32x16{};
#pragma unroll
  for (int d0 = 0; d0 < 8; ++d0) { const int cb = (d0 * 16 + hi * 8) * 2;
    const bf16x8 b0 = *reinterpret_cast<const LAS bf16x8*>(Ks + KSWZ(r32, cb));
    const bf16x8 b1 = *reinterpret_cast<const LAS bf16x8*>(Ks + KSWZ(32 + r32, cb));
    p0 = __builtin_amdgcn_mfma_f32_32x32x16_bf16(b0, qr[d0], p0, 0, 0, 0);
    p1 = __builtin_amdgcn_mfma_f32_32x32x16_bf16(b1, qr[d0], p1, 0, 0, 0); }
}
__device__ __forceinline__ int v_st(int k, int c) { const int kk = (k & ~0xC) | ((k & 4) << 1) | ((k & 8) >> 1); return ((kk >> 3) * 4 + (c >> 5)) * 512 + ((kk & 7) * 32 + (c & 31)) * 2; }
__device__ __forceinline__ int v_rd_base(int lane) { return ((lane & 3) << 3) | (((lane >> 2) & 3) << 6) | (((lane >> 4) & 1) << 5) | (((lane >> 5) & 1) << 8); }
constexpr int v_rd_off(int d0, int ks, int half) { return d0 * 512 + ks * 4096 + half * 2048; }
template <int OFF> __device__ __forceinline__ s16x4 tr_read(int vb) { s16x4 r; asm volatile("ds_read_b64_tr_b16 %0, %1 offset:%2" : "=&v"(r) : "v"(vb), "i"(OFF) : "memory"); return r; }
template <int D0> __device__ __forceinline__ void pv_one(f32x16& od, int vb, bf16x8 pa0, bf16x8 pa1, bf16x8 pa2, bf16x8 pa3) {
  const s16x4 l0 = tr_read<v_rd_off(D0, 0, 0)>(vb), h0 = tr_read<v_rd_off(D0, 0, 1)>(vb), l1 = tr_read<v_rd_off(D0, 1, 0)>(vb), h1 = tr_read<v_rd_off(D0, 1, 1)>(vb);
  const s16x4 l2 = tr_read<v_rd_off(D0, 2, 0)>(vb), h2 = tr_read<v_rd_off(D0, 2, 1)>(vb), l3 = tr_read<v_rd_off(D0, 3, 0)>(vb), h3 = tr_read<v_rd_off(D0, 3, 1)>(vb);
  asm volatile("s_waitcnt lgkmcnt(0)" ::: "memory"); SBAR();
#define PKV(L, H) (bf16x8){L[0], L[1], L[2], L[3], H[0], H[1], H[2], H[3]}
  od = __builtin_amdgcn_mfma_f32_32x32x16_bf16(pa0, PKV(l0, h0), od, 0, 0, 0);
  od = __builtin_amdgcn_mfma_f32_32x32x16_bf16(pa1, PKV(l1, h1), od, 0, 0, 0);
  od = __builtin_amdgcn_mfma_f32_32x32x16_bf16(pa2, PKV(l2, h2), od, 0, 0, 0);
  od = __builtin_amdgcn_mfma_f32_32x32x16_bf16(pa3, PKV(l3, h3), od, 0, 0, 0);
#undef PKV
}
__device__ __forceinline__ void mask_tile(f32x16& p0, f32x16& p1, int dq) {
  const float NEG = -__builtin_inff();
#pragma unroll
  for (int r = 0; r < 16; ++r) { const int c = (r & 3) + 8 * (r >> 2);
    if ((unsigned)(dq - c) >= 257u) p0[r] = NEG;
    if ((unsigned)(dq - c - 32) >= 257u) p1[r] = NEG; }
}
__device__ __forceinline__ void partialSM2(f32x16& p0, f32x16& p1, float& m_reg, float& mn, float& alpha) {
  float pmax = p0[0];
#pragma unroll
  for (int r = 1; r < 16; ++r) pmax = fmaxf(pmax, p0[r]);
#pragma unroll
  for (int r = 0; r < 16; ++r) pmax = fmaxf(pmax, p1[r]);
  { auto rr = __builtin_amdgcn_permlane32_swap(__float_as_uint(pmax), __float_as_uint(pmax), false, false);
    pmax = fmaxf(__uint_as_float(rr[0]), __uint_as_float(rr[1])); }
  constexpr float C2 = 1.4426950408889634f * SCALE;
  if (__builtin_expect(__all(pmax <= m_reg), 1)) { mn = m_reg; alpha = 1.f; }
  else { mn = fmaxf(m_reg, pmax); alpha = __builtin_amdgcn_exp2f((m_reg - mn) * C2); m_reg = mn; }
  const float mnL = -mn * C2;
#pragma unroll
  for (int r = 0; r < 16; ++r) p0[r] = fmaf(p0[r], C2, mnL);
#pragma unroll
  for (int r = 0; r < 16; ++r) p1[r] = fmaf(p1[r], C2, mnL);
#pragma unroll
  for (int r = 0; r < 16; ++r) p0[r] = __builtin_amdgcn_exp2f(p0[r]);
}
__device__ __forceinline__ void finishSM2(f32x16& p0, f32x16& p1, float alpha, float& l_reg, bf16x8& pa0, bf16x8& pa1, bf16x8& pa2, bf16x8& pa3) {
#pragma unroll
  for (int r = 0; r < 16; ++r) p1[r] = __builtin_amdgcn_exp2f(p1[r]);
  float ps = 0;
#pragma unroll
  for (int r = 0; r < 16; ++r) ps += p0[r];
#pragma unroll
  for (int r = 0; r < 16; ++r) ps += p1[r];
  { auto rr = __builtin_amdgcn_permlane32_swap(__float_as_uint(ps), __float_as_uint(ps), false, false);
    ps = __uint_as_float(rr[0]) + __uint_as_float(rr[1]); }
  l_reg = l_reg * alpha + ps;
#define PK4(P, B_, OUT) do { unsigned a0 = cvtpk(P[B_+0], P[B_+1]), a1 = cvtpk(P[B_+2], P[B_+3]);                          \
      unsigned b0 = cvtpk(P[B_+4], P[B_+5]), b1 = cvtpk(P[B_+6], P[B_+7]);                                             \
      auto r0 = __builtin_amdgcn_permlane32_swap(a0, b0, false, false); auto r1 = __builtin_amdgcn_permlane32_swap(a1, b1, false, false); \
      u32x4 w = {r0[0], r1[0], r0[1], r1[1]}; OUT = *reinterpret_cast<bf16x8*>(&w); } while (0)
  PK4(p0, 0, pa0); PK4(p0, 8, pa1); PK4(p1, 0, pa2); PK4(p1, 8, pa3);
#undef PK4
}
template <int KB, bool SK>
__device__ __forceinline__ void qkt2(f32x16& p0, f32x16& p1, const LAS char* K_lds, int r32, int hi, const bf16x8* qr, bool act) {
  if (SK && !act) { const float NEG = -__builtin_inff();
#pragma unroll
    for (int r = 0; r < 16; ++r) { p0[r] = NEG; p1[r] = NEG; } return; }
  p0 = f32x16{}; p1 = f32x16{};
  const LAS char* kb[4];
#pragma unroll
  for (int dd = 0; dd < 4; ++dd) kb[dd] = K_lds + KB * SHM_K + KSWZ(r32, (dd * 16 + hi * 8) * 2);
#pragma unroll
  for (int d0 = 0; d0 < 8; ++d0) { const LAS char* a = kb[d0 & 3] + (d0 >> 2) * 128;
    const bf16x8 b0 = *reinterpret_cast<const LAS bf16x8*>(a);
    const bf16x8 b1 = *reinterpret_cast<const LAS bf16x8*>(a + 32 * 256);
    p0 = __builtin_amdgcn_mfma_f32_32x32x16_bf16(b0, qr[d0], p0, 0, 0, 0);
    p1 = __builtin_amdgcn_mfma_f32_32x32x16_bf16(b1, qr[d0], p1, 0, 0, 0); }
}
template <int VB, bool SK>
__device__ __forceinline__ void pv_tile2(f32x16* o, int vb0, bf16x8 pa0, bf16x8 pa1, bf16x8 pa2, bf16x8 pa3, bool act) {
  if (SK && !act) return;
#define TRRD(dst, off) asm volatile("ds_read_b64_tr_b16 %0, %1 offset:%2" : "=&v"(dst) : "v"(vb0), "i"(off) : "memory")
#define PV_D0(d0) do { s16x4 l0, l1, l2, l3, h0, h1, h2, h3; constexpr int b_ = VB * SHM_V + v_rd_off(d0, 0, 0); \
      TRRD(l0, b_); TRRD(h0, b_ + 2048); TRRD(l1, b_ + 4096); TRRD(h1, b_ + 6144); TRRD(l2, b_ + 8192); TRRD(h2, b_ + 10240); TRRD(l3, b_ + 12288); TRRD(h3, b_ + 14336); \
      asm volatile("s_waitcnt lgkmcnt(0)" ::: "memory"); SBAR(); \
      o[d0] = __builtin_amdgcn_mfma_f32_32x32x16_bf16(pa0, (bf16x8){l0[0], l0[1], l0[2], l0[3], h0[0], h0[1], h0[2], h0[3]}, o[d0], 0, 0, 0);   \
      o[d0] = __builtin_amdgcn_mfma_f32_32x32x16_bf16(pa1, (bf16x8){l1[0], l1[1], l1[2], l1[3], h1[0], h1[1], h1[2], h1[3]}, o[d0], 0, 0, 0);   \
      o[d0] = __builtin_amdgcn_mfma_f32_32x32x16_bf16(pa2, (bf16x8){l2[0], l2[1], l2[2], l2[3], h2[0], h2[1], h2[2], h2[3]}, o[d0], 0, 0, 0);   \
      o[d0] = __builtin_amdgcn_mfma_f32_32x32x16_bf16(pa3, (bf16x8){l3[0], l3[1], l3[2], l3[3], h3[0], h3[1], h3[2], h3[3]}, o[d0], 0, 0, 0); } while (0)
  PV_D0(0); PV_D0(1); PV_D0(2); PV_D0(3);
#undef PV_D0
#undef TRRD
}
struct Seam { bf16x8 qr[8]; bf16x8 st_v0, st_v1, st_k0, st_k1; };
constexpr int OFF2_V = 0, OFF2_K = 2 * SHM_V, OFF2_WS = 2 * SHM_V + 2 * SHM_K, OFF2_OST = OFF2_WS + 8 * 256;
template <bool WIN, int LDQ, int LDK, int LDO, class Gen>
__device__ __forceinline__ void attn_units(LAS char* lds, int wid, int lane, const Gen& G, int u0, int ustride, int ucount) {
  if (u0 >= ucount) return;
  constexpr bool SK = WIN;
  const int tid = wid * 64 + lane, r32 = lane & 31, hi = lane >> 5;
  LAS char* V_lds = lds + OFF2_V; LAS char* K_lds = lds + OFF2_K;
  LAS float* wsf = (LAS float*)(lds + OFF2_WS) + wid * 64; LAS float* li_l = wsf; LAS float* al_l = wsf + 32;
  LAS char* ost = lds + OFF2_OST + wid * 4096;
  const int sr = tid >> 4, sc = (tid & 15) * 8, vst0 = v_st(sr, sc), vst1 = v_st(32 + sr, sc), kws = KSWZ(sr, sc * 2);
  const int vb0 = (int)(unsigned)(size_t)V_lds + v_rd_base(lane);
  const unsigned kvo0 = (unsigned)((sr * LDK + sc) * 2), kvo1 = (unsigned)(((32 + sr) * LDK + sc) * 2), qo = (unsigned)((((wid * 32 + r32) * LDQ) + hi * 8) * 2);
  Seam S;
#define VMW() asm volatile("s_waitcnt vmcnt(0)" ::: "memory")
#define VMWN(n) asm volatile("s_waitcnt vmcnt(%0)" :: "i"(n) : "memory")
#define SLOAD_H(Kp, Vp, k0) do { const char* kb_ = (const char*)((Kp) + (size_t)(k0) * LDK); const char* vb_ = (const char*)((Vp) + (size_t)(k0) * LDK);     \
                                 S.st_v0 = *(const bf16x8*)(vb_ + kvo0); S.st_v1 = *(const bf16x8*)(vb_ + kvo1); S.st_k0 = *(const bf16x8*)(kb_ + kvo0); S.st_k1 = *(const bf16x8*)(kb_ + kvo1); } while (0)
#define SWRITE_HK(bf) do { *(LAS bf16x8*)(K_lds + (bf) * SHM_K + kws) = S.st_k0; *(LAS bf16x8*)(K_lds + (bf) * SHM_K + kws + 32 * 256) = S.st_k1; } while (0)
#define SWRITE_HV(bf) do { *(LAS bf16x8*)(V_lds + (bf) * SHM_V + vst0) = S.st_v0; *(LAS bf16x8*)(V_lds + (bf) * SHM_V + vst1) = S.st_v1; } while (0)
#define SWRITE_H(bf) do { SWRITE_HV(bf); SWRITE_HK(bf); } while (0)
#define LOADQ(P) do { const char* qb_ = (const char*)G.qb(P); _Pragma("unroll") for (int d0 = 0; d0 < 8; ++d0) S.qr[d0] = *(const bf16x8*)(qb_ + qo + d0 * 32); } while (0)
#define UMAP(uu) ((ucount % 8 == 0 && ustride % 8 == 0) ? (((uu) % ustride) & 7) * (ucount / 8) + ((uu) / ustride) * (ustride / 8) + (((uu) % ustride) >> 3) : (uu))
  int c = __builtin_amdgcn_readfirstlane(UMAP(u0));
  { LOADQ(c); const int kb0 = G.t_lo(c) * KVB; SLOAD_H(G.kh(c), G.vh(c), kb0); VMW(); SWRITE_HK(0); }
  __syncthreads();
  for (int u = u0; u < ucount; u += ustride) {
    const bool has_next = u + ustride < ucount; const int n = __builtin_amdgcn_readfirstlane(has_next ? UMAP(u + ustride) : c);
    const int j_lo = G.t_lo(c), NT = G.t_hi(c) - j_lo;
    const int kbn = G.t_lo(n) * KVB;
    const int qlo = G.qpos0(c) + wid * 32, qm = qlo + r32 - 4 * hi + 128;
    float m_reg = G.m_init(c), l_reg = G.l_init(); f32x16 o[4] = {};
    const bf16_t* Kh = G.kh(c); const bf16_t* Vh = G.vh(c);
#define RESC(a) do { if (__any((a) < 1.f)) { if (hi == 0) al_l[r32] = (a); asm volatile("s_waitcnt lgkmcnt(0)" ::: "memory");              \
                     _Pragma("unroll") for (int d_ = 0; d_ < 4; ++d_) _Pragma("unroll") for (int r = 0; r < 16; ++r) o[d_][r] *= al_l[crow(r, hi)]; } } while (0)
#define KBASE(t) ((j_lo + (t)) * KVB)
#define ACT(t) (!WIN || (KBASE(t) <= qlo + 31 + 128 && KBASE(t) + KVB - 1 >= qlo - 128))
#define MASKT(P0_, P1_, t) do { if (WIN) { const int kb_ = KBASE(t); if (ACT(t) && !(kb_ >= qlo - 97 && kb_ <= qlo + 65)) mask_tile(P0_, P1_, qm - kb_); } } while (0)
#define SEAM_K0() do { VMWN(8); SWRITE_HK(0); SBAR(); } while (0)
    f32x16 pA0, pA1, pB0, pB1; float mnA, mnB, alA, alB; bf16x8 pa0, pa1, pa2, pa3;
    SWRITE_HV(0); SBAR();
    if (NT > 1) SLOAD_H(Kh, Vh, KBASE(1));
    SBAR(); qkt2<0, SK>(pA0, pA1, K_lds, r32, hi, S.qr, ACT(0));
    MASKT(pA0, pA1, 0); partialSM2(pA0, pA1, m_reg, mnA, alA);
    if (NT > 1) { VMW(); SWRITE_H(1); }
    __syncthreads();
#define HALF_STEP(PX0, PX1, mnX, alX, PY0, PY1, alY, t, KB, VB, SB) do {                                                      \
        SBAR(); qkt2<KB, SK>(PX0, PX1, K_lds, r32, hi, S.qr, ACT(t));                                                         \
        finishSM2(PY0, PY1, alY, l_reg, pa0, pa1, pa2, pa3); SBAR();                                                          \
        if ((t) + 1 < NT) { SLOAD_H(Kh, Vh, KBASE((t) + 1)); SBAR(); }                                                        \
        pv_tile2<VB, SK>(o, vb0, pa0, pa1, pa2, pa3, ACT((t) - 1)); MASKT(PX0, PX1, (t)); partialSM2(PX0, PX1, m_reg, mnX, alX); \
        __syncthreads();                                                                                                      \
        if ((t) + 1 < NT) { VMW(); SWRITE_H(SB); }                                                                            \
        RESC(alX); __syncthreads(); } while (0)
    for (int t = 1; t + 1 < NT; t += 2) {
      HALF_STEP(pB0, pB1, mnB, alB, pA0, pA1, alA, t, 1, 0, 0);
      HALF_STEP(pA0, pA1, mnA, alA, pB0, pB1, alB, t + 1, 0, 1, 1);
    }
    const bool even = (NT & 1) == 0;
    if (even) { SBAR(); qkt2<1, SK>(pB0, pB1, K_lds, r32, hi, S.qr, ACT(NT - 1)); SBAR(); }
    SLOAD_H(G.kh(n), G.vh(n), kbn); SBAR();
    LOADQ(n);
    SBAR();
    finishSM2(pA0, pA1, alA, l_reg, pa0, pa1, pa2, pa3); SBAR();
    pv_tile2<0, SK>(o, vb0, pa0, pa1, pa2, pa3, ACT(even ? NT - 2 : NT - 1));
    if (even) { MASKT(pB0, pB1, NT - 1); partialSM2(pB0, pB1, m_reg, mnB, alB); __syncthreads(); RESC(alB);
      finishSM2(pB0, pB1, alB, l_reg, pa0, pa1, pa2, pa3); SBAR(); pv_tile2<1, SK>(o, vb0, pa0, pa1, pa2, pa3, ACT(NT - 1)); }
    SBAR(); SEAM_K0();
    if (hi == 0) li_l[r32] = l_reg; asm volatile("s_waitcnt lgkmcnt(0)" ::: "memory");
    char* obase = (char*)(G.ob(c) + (size_t)(wid * 32) * LDO); const unsigned loff = (unsigned)(((lane >> 4) * LDO + (lane & 15) * 8) * 2);
#pragma unroll
    for (int hf = 0; hf < 2; ++hf) {
#pragma unroll
      for (int rr = 0; rr < 8; ++rr) { const int r = hf * 8 + rr; const int orow = crow(r, hi); const float rl = __builtin_amdgcn_rcpf(li_l[orow]);
#pragma unroll
        for (int d0 = 0; d0 < 4; ++d0) *(LAS unsigned short*)(ost + (orow & 15) * 256 + (d0 * 32 + r32) * 2) = (unsigned short)f2bf(o[d0][r] * rl); }
      asm volatile("s_waitcnt lgkmcnt(0)" ::: "memory");
#pragma unroll
      for (int i = 0; i < 4; ++i) { const int ch = i * 64 + lane, row = ch >> 4, c16 = ch & 15;
        const u32x4 v = *(const LAS u32x4*)(ost + row * 256 + c16 * 16); *(u32x4*)(obase + (size_t)((hf * 16 + i * 4) * LDO * 2) + loff) = v; }
      asm volatile("s_waitcnt lgkmcnt(0)" ::: "memory");
    }
    __syncthreads();
    c = n;
#undef RESC
#undef KBASE
#undef ACT
#undef MASKT
#undef SEAM_K0
#undef HALF_STEP
  }
#undef VMW
#undef VMWN
#undef SLOAD_H
#undef SWRITE_HK
#undef SWRITE_HV
#undef SWRITE_H
#undef LOADQ
#undef UMAP
}
#undef KSWZ
#undef SBAR
}
struct GenWin {
    const bf16_t* Q; const bf16_t* Kb; const bf16_t* Vb; bf16_t* O; const float* sink;
    __device__ __forceinline__ int qblk(int u) const { return (u / 3) & 15; }
    __device__ __forceinline__ int head(int u) const { return ((u / 48) & 3) * 3 + u % 3; }
    __device__ __forceinline__ size_t row0(int u) const { return (size_t)(u / 192) * SEQ + 256 * qblk(u); }
    __device__ __forceinline__ const bf16_t* qb(int u) const { return Q + row0(u) * MIXW + head(u) * HD; }
    __device__ __forceinline__ const bf16_t* kh(int u) const { return Kb + (size_t)(u / 192) * SEQ * KVW + ((u / 48) & 3) * HD; }
    __device__ __forceinline__ const bf16_t* vh(int u) const { return Vb + (size_t)(u / 192) * SEQ * KVW + ((u / 48) & 3) * HD; }
    __device__ __forceinline__ bf16_t* ob(int u) const { return O + row0(u) * DM + head(u) * HD; }
    __device__ __forceinline__ int t_lo(int u) const { const int q = qblk(u); return 4 * q - 2 < 0 ? 0 : 4 * q - 2; }
    __device__ __forceinline__ int t_hi(int u) const { const int q = qblk(u); return 4 * q + 6 > 64 ? 64 : 4 * q + 6; }
    __device__ __forceinline__ int qpos0(int u) const { return 256 * qblk(u); }
    __device__ __forceinline__ float m_init(int u) const { return sink[head(u)] * (1.0f / att::SCALE); }
    __device__ __forceinline__ float l_init() const { return 1.0f; }
};
__device__ __forceinline__ void phase_attn_mfma(const Frame& F, CAP a, int jl) {
    unsigned char* ws = a->ws;
    const GenWin G{(const bf16_t*)(ws + WS_R1 + R1_Q), (const bf16_t*)(ws + WS_R1 + R1_K), (const bf16_t*)(ws + WS_R1 + R1_V), (bf16_t*)(ws + WS_R1 + R1_CONCAT), a->in[15] + (size_t)jl * NQH};
    att::attn_units<true, MIXW, KVW, DM>((LAS char*)F.lds, F.wave, F.lane, G, (int)blockIdx.x, F.G, NBATCH * NQH * 16);
}
struct GenMem {
    const bf16_t* QM; const bf16_t* KV; bf16_t* O; int layer;
    __device__ __forceinline__ size_t row0(int u) const { return (size_t)(u >> 6) * SEQ + 256 * (u & 15); }
    __device__ __forceinline__ const bf16_t* qb(int u) const { return QM + row0(u) * MEMW + ((u >> 4) & 3) * HD; }
    __device__ __forceinline__ const bf16_t* kh(int u) const { return KV + (size_t)(u >> 6) * NMEM * 4096 + layer * 1024 + ((u >> 4) & 3) * HD; }
    __device__ __forceinline__ const bf16_t* vh(int u) const { return kh(u) + 512; }
    __device__ __forceinline__ bf16_t* ob(int u) const { return O + row0(u) * DM + MIXW + ((u >> 4) & 3) * HD; }
    __device__ __forceinline__ int t_lo(int) const { return 0; }
    __device__ __forceinline__ int t_hi(int) const { return 4; }
    __device__ __forceinline__ int qpos0(int) const { return 0; }
    __device__ __forceinline__ float m_init(int) const { return -1e30f; }
    __device__ __forceinline__ float l_init() const { return 0.f; }
};
__device__ __forceinline__ void phase_memattn_mfma(const Frame& F, CAP a, int layer, bf16_t* O) {
    unsigned char* ws = a->ws;
    const GenMem G{(const bf16_t*)(ws + WS_R1 + R1_QM), (const bf16_t*)(ws + WS_MEMKV), O, layer};
    att::attn_units<false, MEMW, 4096, DM>((LAS char*)F.lds, F.wave, F.lane, G, (int)blockIdx.x, F.G, NBATCH * 4 * 16);
}

__device__ __forceinline__ CAP get_args() { CAP p = (CAP)__builtin_amdgcn_kernarg_segment_ptr(); asm volatile("" : "+s"(p)); return p; }
__device__ __forceinline__ bool run_ok(int id) { CAP a = get_args(); return a->lin_lo <= id && id < a->lin_hi; }
__device__ __forceinline__ Frame make_frame(unsigned char* lds_raw, int wave_s) {
    Frame F; const int l_ = lane_id_opaque();
    F.lds = (LAS unsigned char*)lds_raw; F.lane = l_; F.wave = wave_s; F.tid = wave_s * 64 + l_;
    F.G = gridDim.x; F.gw = blockIdx.x * NWAVES + F.wave; F.NGW = F.G * NWAVES; return F;
}
__global__ void __launch_bounds__(NWAVES * 64, 2) mk_fwd(Args args_unused) {
    extern __shared__ __attribute__((aligned(16))) unsigned char lds_raw[];
    int wave_s = __builtin_amdgcn_readfirstlane((int)threadIdx.x >> 6); asm volatile("" : "+s"(wave_s));
    { const int t = wave_s * 64 + lane_id_opaque(); for (int u = t; u < (LDS_BYTES - LDSCTL_OFF) / 4; u += NWAVES * 64) ((LAS unsigned*)((LAS unsigned char*)lds_raw + LDSCTL_OFF))[u] = 0u; }
    __syncthreads();
#if !MK_MULTI
    { CAP a = get_args(); if (wave_s == 0 && lane_id_opaque() == 0 && xb_xcc_id() != (blockIdx.x & 7u)) (void)xb_add((unsigned*)(a->ws + WS_CTL) + CW_BAR + GB_FLAG, 1u); }
    { CAP a = get_args(); (void)xcd_barrier_post((unsigned*)(a->ws + WS_CTL) + CW_BAR, (volatile LAS unsigned*)((LAS unsigned char*)lds_raw + MISC_OFF) + 8, wave_s == 0 && lane_id_opaque() == 0); }
#define SEAM() do { CAP a_ = get_args(); XcdBarrier bar_; bar_.bar = (unsigned*)(a_->ws + WS_CTL) + CW_BAR; bar_.x = xb_xcc_id(); bar_.st = (volatile LAS unsigned*)((LAS unsigned char*)lds_raw + MISC_OFF) + 8; xcd_barrier(bar_, wave_s == 0 && lane_id_opaque() == 0); } while (0)
#define GSEAM() do { CAP a_ = get_args(); unsigned* gb_ = (unsigned*)(a_->ws + WS_CTL) + CW_BAR; \
        const bool fast_ = (gridDim.x & 7u) == 0u && (MTOK / NSPLIT / pg8::BM / pg8::WGM) % pg8::NXCD == 0 && __builtin_amdgcn_readfirstlane(xb_ld(&gb_[GB_FLAG])) == 0u; \
        if (fast_) group_barrier(gb_, wave_s == 0 && lane_id_opaque() == 0); else SEAM(); } while (0)
#else
#define SEAM() do {} while (0)
#define GSEAM() do {} while (0)
#endif
#define RUN(id) run_ok(id)
#define PH() CAP a = get_args(); Frame F = make_frame(lds_raw, wave_s); unsigned char* const ws = a->ws; (void)ws; (void)F
#define STATS(which) ((float*)(ws + WS_STATS) + (size_t)(which) * MTOK * 2)
#define PARTP ((float*)(ws + WS_PART))
#define CSBW(l) ((float*)(ws + WS_CSBW) + (size_t)(l) * 32768)

    if (RUN(0)) { PH(); phase_pr0(F, a); } SEAM();
    if (RUN(1)) {
        { PH();
        pg8::GemmPlain g{(const bf16_t*)(ws + WS_R1 + R1_MEMB), (const bf16_t*)(ws + WS_R1 + R1_WMKV), DM, DM};
        pg8::StaticOrder S; S.init(NMEMROWS, 4096, F.G, (int)blockIdx.x);
        pg8::EpiPlainBf16 E{(bf16_t*)(ws + WS_MEMKV), 4096};
        pg8::gemm_phase(F.lds, F.wave, g, S, E); }
        { PH(); phase_kt(F, a); }
    } SEAM();

    { constexpr int layer = 0; constexpr int base = 2 + 32 * layer; constexpr bool attn = layer & 1; constexpr int j = layer >> 1; (void)j;

                if constexpr (layer == 0) { if (RUN(base + 0)) { PH(); phase_wconv(F, a, layer); } SEAM(); }
        if constexpr (!attn) {
                    if (RUN(base + 1)) { PH();
                pg8::GemmPlain g{(const bf16_t*)(ws + WS_XB), (const bf16_t*)(ws + WS_WIN), DM, DM}; pg8::StaticOrder S; S.init(MTOK, 2048, F.G, (int)blockIdx.x);
                pg8::EpiInSsm<(layer > 0)> E{(bf16_t*)(ws + WS_R1 + R1_UH), (bf16_t*)(ws + WS_R1 + R1_QM), pg8::Fold{STATS(1), CSBW(layer), CSBW(layer) + 8192}};
                pg8::gemm_phase(F.lds, F.wave, g, S, E);
            } SEAM();
        if (RUN(base + 2)) {
            { PH();
                pg8::GemmSsm g{(const bf16_t*)(ws + WS_R1 + R1_UH), (const bf16_t*)(ws + WS_SWG), 256, 512}; pg8::SsmOrder S{F.G, (int)blockIdx.x};
                pg8::EpiG1 E{(bf16_t*)(ws + WS_R1 + R1_G)};
                pg8::gemm_phase(F.lds, F.wave, g, S, E); }
            __builtin_amdgcn_fence(__ATOMIC_ACQUIRE, "agent");
            { PH(); phase_scan(F, a, j); }
            asm volatile("s_waitcnt vmcnt(0)" ::: "memory"); __syncthreads(); __builtin_amdgcn_fence(__ATOMIC_ACQUIRE, "agent");
            { PH();
                pg8::GemmSsm g{(const bf16_t*)(ws + WS_R1 + R1_UH), (const bf16_t*)(ws + WS_SWY), 512, 512}; pg8::SsmOrder S{F.G, (int)blockIdx.x};
                pg8::EpiG2 E{(bf16_t*)(ws + WS_R1 + R1_Z)};
                pg8::gemm_phase(F.lds, F.wave, g, S, E); }
        } SEAM();
            constexpr size_t ZOFF = WS_R1 + R1_Z, CCOFF = WS_R1 + R1_CONCAT;
                    if (RUN(base + 5)) {
                { PH();
                pg8::GemmPlain g{(const bf16_t*)(ws + ZOFF), (const bf16_t*)(ws + WS_WGLU), MIXW, MIXW}; pg8::StaticOrder S; S.init(MTOK, 3072, F.G, (int)blockIdx.x);
                pg8::EpiGlu E{(bf16_t*)(ws + CCOFF)};
                pg8::gemm_phase(F.lds, F.wave, g, S, E); }
                { PH(); phase_memattn_mfma(F, a, layer, (bf16_t*)(ws + CCOFF)); }
            } SEAM();
                    if (RUN(base + 6)) { PH();
                pg8::GemmPlain g{(const bf16_t*)(ws + CCOFF), (const bf16_t*)(ws + WS_WOUT), DM, DM}; pg8::StaticOrder S; S.init(MTOK, DM, F.G, (int)blockIdx.x);
                if constexpr (layer == 0) { pg8::EpiResidB<0> E{a->in[0], a->in[1], MROWS_PROMPT, nullptr, nullptr, nullptr, (bf16_t*)(ws + WS_XB), PARTP, 0, F.lds};
                    pg8::gemm_phase(F.lds, F.wave, g, S, E); }
                else { constexpr int lp = layer > 0 ? layer - 1 : 0; pg8::EpiResidB<1> E{nullptr, nullptr, 0, STATS(1), a->in[22] + (size_t)lp * DM, a->in[23] + (size_t)lp * DM, (bf16_t*)(ws + WS_XB), PARTP, 0, F.lds};
                    pg8::gemm_phase(F.lds, F.wave, g, S, E); }
            } SEAM();
            if (RUN(base + 7)) { PH(); phase_finalize(F, PARTP, STATS(0), CSBW(layer) + 16384); } SEAM();
        } else {
                    if (RUN(base + 1)) { PH();
                pg8::GemmPlain g{(const bf16_t*)(ws + WS_XB), (const bf16_t*)(ws + WS_WIN), DM, DM}; pg8::StaticOrder S; S.init(MTOK, 3072, F.G, (int)blockIdx.x);
                pg8::EpiInAttn<true> E{ws + WS_R1, (const float*)(ws + WS_ROPE), pg8::Fold{STATS(1), CSBW(layer), CSBW(layer) + 8192}};
                pg8::gemm_phase(F.lds, F.wave, g, S, E);
            } SEAM();
                    if (RUN(base + 2)) { { PH(); phase_attn_mfma(F, a, j); } { PH(); phase_memattn_mfma(F, a, layer, (bf16_t*)(ws + WS_R1 + R1_CONCAT)); } } SEAM();
                    if (RUN(base + 6)) { PH();
                pg8::GemmPlain g{(const bf16_t*)(ws + WS_R1 + R1_CONCAT), (const bf16_t*)(ws + WS_WOUT), DM, DM}; pg8::StaticOrder S; S.init(MTOK, DM, F.G, (int)blockIdx.x);
                constexpr int lp = layer > 0 ? layer - 1 : 0; pg8::EpiResidB<1> E{nullptr, nullptr, 0, STATS(1), a->in[22] + (size_t)lp * DM, a->in[23] + (size_t)lp * DM, (bf16_t*)(ws + WS_XB), PARTP, 0, F.lds};
                pg8::gemm_phase(F.lds, F.wave, g, S, E);
            } SEAM();
            if (RUN(base + 7)) { PH(); phase_finalize(F, PARTP, STATS(0), CSBW(layer) + 16384); } SEAM();
        }

        { constexpr int half = 0; constexpr int roff = half * (MTOK / NSPLIT);

                        if (RUN(base + 8 + 2 * half)) { PH();
                pg8::GemmPlain g{(const bf16_t*)(ws + WS_XB) + (size_t)roff * DM, (const bf16_t*)(ws + WS_WFF1), DM, DM}; pg8::StaticOrder S; S.init(MTOK / NSPLIT, DFF, F.G, (int)blockIdx.x);
                pg8::EpiSqRelu E{(bf16_t*)(ws + WS_R1 + R1_H), DFF, pg8::Fold{STATS(0) + 2 * (size_t)roff, CSBW(layer) + 16384, CSBW(layer) + 24576}};
                pg8::gemm_phase(F.lds, F.wave, g, S, E);
            } GSEAM();
                        if (RUN(base + 9 + 2 * half)) { PH();
                pg8::GemmPlain g{(const bf16_t*)(ws + WS_R1 + R1_H), (const bf16_t*)(ws + WS_WFF2), DFF, DFF}; pg8::StaticOrder S; S.init(MTOK / NSPLIT, DM, F.G, (int)blockIdx.x);
                pg8::EpiResidB<1> E{nullptr, nullptr, 0, STATS(0), a->in[18] + (size_t)layer * DM, a->in[19] + (size_t)layer * DM, (bf16_t*)(ws + WS_XB), PARTP, roff, F.lds};
                pg8::gemm_phase(F.lds, F.wave, g, S, E);
            } if constexpr (half + 1 < NSPLIT) GSEAM(); else SEAM();
                }
        { constexpr int half = 1; constexpr int roff = half * (MTOK / NSPLIT);

                        if (RUN(base + 8 + 2 * half)) { PH();
                pg8::GemmPlain g{(const bf16_t*)(ws + WS_XB) + (size_t)roff * DM, (const bf16_t*)(ws + WS_WFF1), DM, DM}; pg8::StaticOrder S; S.init(MTOK / NSPLIT, DFF, F.G, (int)blockIdx.x);
                pg8::EpiSqRelu E{(bf16_t*)(ws + WS_R1 + R1_H), DFF, pg8::Fold{STATS(0) + 2 * (size_t)roff, CSBW(layer) + 16384, CSBW(layer) + 24576}};
                pg8::gemm_phase(F.lds, F.wave, g, S, E);
            } GSEAM();
                        if (RUN(base + 9 + 2 * half)) { PH();
                pg8::GemmPlain g{(const bf16_t*)(ws + WS_R1 + R1_H), (const bf16_t*)(ws + WS_WFF2), DFF, DFF}; pg8::StaticOrder S; S.init(MTOK / NSPLIT, DM, F.G, (int)blockIdx.x);
                pg8::EpiResidB<1> E{nullptr, nullptr, 0, STATS(0), a->in[18] + (size_t)layer * DM, a->in[19] + (size_t)layer * DM, (bf16_t*)(ws + WS_XB), PARTP, roff, F.lds};
                pg8::gemm_phase(F.lds, F.wave, g, S, E);
            } if constexpr (half + 1 < NSPLIT) GSEAM(); else SEAM();
                }
            if constexpr (layer < 3) { if (RUN(base + 24)) { { PH(); phase_finalize(F, PARTP, STATS(1)); } { PH(); phase_wconv(F, a, layer + 1); } } SEAM(); }
                if constexpr (layer == 3) { if (RUN(base + 25)) { PH(); phase_ln_final(F, (const bf16_t*)(ws + WS_XB), a->out, a->in[22] + (size_t)layer * DM, a->in[23] + (size_t)layer * DM); } }
        }
    { constexpr int layer = 1; constexpr int base = 2 + 32 * layer; constexpr bool attn = layer & 1; constexpr int j = layer >> 1; (void)j;

                if constexpr (layer == 0) { if (RUN(base + 0)) { PH(); phase_wconv(F, a, layer); } SEAM(); }
        if constexpr (!attn) {
                    if (RUN(base + 1)) { PH();
                pg8::GemmPlain g{(const bf16_t*)(ws + WS_XB), (const bf16_t*)(ws + WS_WIN), DM, DM}; pg8::StaticOrder S; S.init(MTOK, 2048, F.G, (int)blockIdx.x);
                pg8::EpiInSsm<(layer > 0)> E{(bf16_t*)(ws + WS_R1 + R1_UH), (bf16_t*)(ws + WS_R1 + R1_QM), pg8::Fold{STATS(1), CSBW(layer), CSBW(layer) + 8192}};
                pg8::gemm_phase(F.lds, F.wave, g, S, E);
            } SEAM();
        if (RUN(base + 2)) {
            { PH();
                pg8::GemmSsm g{(const bf16_t*)(ws + WS_R1 + R1_UH), (const bf16_t*)(ws + WS_SWG), 256, 512}; pg8::SsmOrder S{F.G, (int)blockIdx.x};
                pg8::EpiG1 E{(bf16_t*)(ws + WS_R1 + R1_G)};
                pg8::gemm_phase(F.lds, F.wave, g, S, E); }
            __builtin_amdgcn_fence(__ATOMIC_ACQUIRE, "agent");
            { PH(); phase_scan(F, a, j); }
            asm volatile("s_waitcnt vmcnt(0)" ::: "memory"); __syncthreads(); __builtin_amdgcn_fence(__ATOMIC_ACQUIRE, "agent");
            { PH();
                pg8::GemmSsm g{(const bf16_t*)(ws + WS_R1 + R1_UH), (const bf16_t*)(ws + WS_SWY), 512, 512}; pg8::SsmOrder S{F.G, (int)blockIdx.x};
                pg8::EpiG2 E{(bf16_t*)(ws + WS_R1 + R1_Z)};
                pg8::gemm_phase(F.lds, F.wave, g, S, E); }
        } SEAM();
            constexpr size_t ZOFF = WS_R1 + R1_Z, CCOFF = WS_R1 + R1_CONCAT;
                    if (RUN(base + 5)) {
                { PH();
                pg8::GemmPlain g{(const bf16_t*)(ws + ZOFF), (const bf16_t*)(ws + WS_WGLU), MIXW, MIXW}; pg8::StaticOrder S; S.init(MTOK, 3072, F.G, (int)blockIdx.x);
                pg8::EpiGlu E{(bf16_t*)(ws + CCOFF)};
                pg8::gemm_phase(F.lds, F.wave, g, S, E); }
                { PH(); phase_memattn_mfma(F, a, layer, (bf16_t*)(ws + CCOFF)); }
            } SEAM();
                    if (RUN(base + 6)) { PH();
                pg8::GemmPlain g{(const bf16_t*)(ws + CCOFF), (const bf16_t*)(ws + WS_WOUT), DM, DM}; pg8::StaticOrder S; S.init(MTOK, DM, F.G, (int)blockIdx.x);
                if constexpr (layer == 0) { pg8::EpiResidB<0> E{a->in[0], a->in[1], MROWS_PROMPT, nullptr, nullptr, nullptr, (bf16_t*)(ws + WS_XB), PARTP, 0, F.lds};
                    pg8::gemm_phase(F.lds, F.wave, g, S, E); }
                else { constexpr int lp = layer > 0 ? layer - 1 : 0; pg8::EpiResidB<1> E{nullptr, nullptr, 0, STATS(1), a->in[22] + (size_t)lp * DM, a->in[23] + (size_t)lp * DM, (bf16_t*)(ws + WS_XB), PARTP, 0, F.lds};
                    pg8::gemm_phase(F.lds, F.wave, g, S, E); }
            } SEAM();
            if (RUN(base + 7)) { PH(); phase_finalize(F, PARTP, STATS(0), CSBW(layer) + 16384); } SEAM();
        } else {
                    if (RUN(base + 1)) { PH();
                pg8::GemmPlain g{(const bf16_t*)(ws + WS_XB), (const bf16_t*)(ws + WS_WIN), DM, DM}; pg8::StaticOrder S; S.init(MTOK, 3072, F.G, (int)blockIdx.x);
                pg8::EpiInAttn<true> E{ws + WS_R1, (const float*)(ws + WS_ROPE), pg8::Fold{STATS(1), CSBW(layer), CSBW(layer) + 8192}};
                pg8::gemm_phase(F.lds, F.wave, g, S, E);
            } SEAM();
                    if (RUN(base + 2)) { { PH(); phase_attn_mfma(F, a, j); } { PH(); phase_memattn_mfma(F, a, layer, (bf16_t*)(ws + WS_R1 + R1_CONCAT)); } } SEAM();
                    if (RUN(base + 6)) { PH();
                pg8::GemmPlain g{(const bf16_t*)(ws + WS_R1 + R1_CONCAT), (const bf16_t*)(ws + WS_WOUT), DM, DM}; pg8::StaticOrder S; S.init(MTOK, DM, F.G, (int)blockIdx.x);
                constexpr int lp = layer > 0 ? layer - 1 : 0; pg8::EpiResidB<1> E{nullptr, nullptr, 0, STATS(1), a->in[22] + (size_t)lp * DM, a->in[23] + (size_t)lp * DM, (bf16_t*)(ws + WS_XB), PARTP, 0, F.lds};
                pg8::gemm_phase(F.lds, F.wave, g, S, E);
            } SEAM();
            if (RUN(base + 7)) { PH(); phase_finalize(F, PARTP, STATS(0), CSBW(layer) + 16384); } SEAM();
        }

        { constexpr int half = 0; constexpr int roff = half * (MTOK / NSPLIT);

                        if (RUN(base + 8 + 2 * half)) { PH();
                pg8::GemmPlain g{(const bf16_t*)(ws + WS_XB) + (size_t)roff * DM, (const bf16_t*)(ws + WS_WFF1), DM, DM}; pg8::StaticOrder S; S.init(MTOK / NSPLIT, DFF, F.G, (int)blockIdx.x);
                pg8::EpiSqRelu E{(bf16_t*)(ws + WS_R1 + R1_H), DFF, pg8::Fold{STATS(0) + 2 * (size_t)roff, CSBW(layer) + 16384, CSBW(layer) + 24576}};
                pg8::gemm_phase(F.lds, F.wave, g, S, E);
            } GSEAM();
                        if (RUN(base + 9 + 2 * half)) { PH();
                pg8::GemmPlain g{(const bf16_t*)(ws + WS_R1 + R1_H), (const bf16_t*)(ws + WS_WFF2), DFF, DFF}; pg8::StaticOrder S; S.init(MTOK / NSPLIT, DM, F.G, (int)blockIdx.x);
                pg8::EpiResidB<1> E{nullptr, nullptr, 0, STATS(0), a->in[18] + (size_t)layer * DM, a->in[19] + (size_t)layer * DM, (bf16_t*)(ws + WS_XB), PARTP, roff, F.lds};
                pg8::gemm_phase(F.lds, F.wave, g, S, E);
            } if constexpr (half + 1 < NSPLIT) GSEAM(); else SEAM();
                }
        { constexpr int half = 1; constexpr int roff = half * (MTOK / NSPLIT);

                        if (RUN(base + 8 + 2 * half)) { PH();
                pg8::GemmPlain g{(const bf16_t*)(ws + WS_XB) + (size_t)roff * DM, (const bf16_t*)(ws + WS_WFF1), DM, DM}; pg8::StaticOrder S; S.init(MTOK / NSPLIT, DFF, F.G, (int)blockIdx.x);
                pg8::EpiSqRelu E{(bf16_t*)(ws + WS_R1 + R1_H), DFF, pg8::Fold{STATS(0) + 2 * (size_t)roff, CSBW(layer) + 16384, CSBW(layer) + 24576}};
                pg8::gemm_phase(F.lds, F.wave, g, S, E);
            } GSEAM();
                        if (RUN(base + 9 + 2 * half)) { PH();
                pg8::GemmPlain g{(const bf16_t*)(ws + WS_R1 + R1_H), (const bf16_t*)(ws + WS_WFF2), DFF, DFF}; pg8::StaticOrder S; S.init(MTOK / NSPLIT, DM, F.G, (int)blockIdx.x);
                pg8::EpiResidB<1> E{nullptr, nullptr, 0, STATS(0), a->in[18] + (size_t)layer * DM, a->in[19] + (size_t)layer * DM, (bf16_t*)(ws + WS_XB), PARTP, roff, F.lds};
                pg8::gemm_phase(F.lds, F.wave, g, S, E);
            } if constexpr (half + 1 < NSPLIT) GSEAM(); else SEAM();
                }
            if constexpr (layer < 3) { if (RUN(base + 24)) { { PH(); phase_finalize(F, PARTP, STATS(1)); } { PH(); phase_wconv(F, a, layer + 1); } } SEAM(); }
                if constexpr (layer == 3) { if (RUN(base + 25)) { PH(); phase_ln_final(F, (const bf16_t*)(ws + WS_XB), a->out, a->in[22] + (size_t)layer * DM, a->in[23] + (size_t)layer * DM); } }
        }
    { constexpr int layer = 2; constexpr int base = 2 + 32 * layer; constexpr bool attn = layer & 1; constexpr int j = layer >> 1; (void)j;

                if constexpr (layer == 0) { if (RUN(base + 0)) { PH(); phase_wconv(F, a, layer); } SEAM(); }
        if constexpr (!attn) {
                    if (RUN(base + 1)) { PH();
                pg8::GemmPlain g{(const bf16_t*)(ws + WS_XB), (const bf16_t*)(ws + WS_WIN), DM, DM}; pg8::StaticOrder S; S.init(MTOK, 2048, F.G, (int)blockIdx.x);
                pg8::EpiInSsm<(layer > 0)> E{(bf16_t*)(ws + WS_R1 + R1_UH), (bf16_t*)(ws + WS_R1 + R1_QM), pg8::Fold{STATS(1), CSBW(layer), CSBW(layer) + 8192}};
                pg8::gemm_phase(F.lds, F.wave, g, S, E);
            } SEAM();
        if (RUN(base + 2)) {
            { PH();
                pg8::GemmSsm g{(const bf16_t*)(ws + WS_R1 + R1_UH), (const bf16_t*)(ws + WS_SWG), 256, 512}; pg8::SsmOrder S{F.G, (int)blockIdx.x};
                pg8::EpiG1 E{(bf16_t*)(ws + WS_R1 + R1_G)};
                pg8::gemm_phase(F.lds, F.wave, g, S, E); }
            __builtin_amdgcn_fence(__ATOMIC_ACQUIRE, "agent");
            { PH(); phase_scan(F, a, j); }
            asm volatile("s_waitcnt vmcnt(0)" ::: "memory"); __syncthreads(); __builtin_amdgcn_fence(__ATOMIC_ACQUIRE, "agent");
            { PH();
                pg8::GemmSsm g{(const bf16_t*)(ws + WS_R1 + R1_UH), (const bf16_t*)(ws + WS_SWY), 512, 512}; pg8::SsmOrder S{F.G, (int)blockIdx.x};
                pg8::EpiG2 E{(bf16_t*)(ws + WS_R1 + R1_Z)};
                pg8::gemm_phase(F.lds, F.wave, g, S, E); }
        } SEAM();
            constexpr size_t ZOFF = WS_R1 + R1_Z, CCOFF = WS_R1 + R1_CONCAT;
                    if (RUN(base + 5)) {
                { PH();
                pg8::GemmPlain g{(const bf16_t*)(ws + ZOFF), (const bf16_t*)(ws + WS_WGLU), MIXW, MIXW}; pg8::StaticOrder S; S.init(MTOK, 3072, F.G, (int)blockIdx.x);
                pg8::EpiGlu E{(bf16_t*)(ws + CCOFF)};
                pg8::gemm_phase(F.lds, F.wave, g, S, E); }
                { PH(); phase_memattn_mfma(F, a, layer, (bf16_t*)(ws + CCOFF)); }
            } SEAM();
                    if (RUN(base + 6)) { PH();
                pg8::GemmPlain g{(const bf16_t*)(ws + CCOFF), (const bf16_t*)(ws + WS_WOUT), DM, DM}; pg8::StaticOrder S; S.init(MTOK, DM, F.G, (int)blockIdx.x);
                if constexpr (layer == 0) { pg8::EpiResidB<0> E{a->in[0], a->in[1], MROWS_PROMPT, nullptr, nullptr, nullptr, (bf16_t*)(ws + WS_XB), PARTP, 0, F.lds};
                    pg8::gemm_phase(F.lds, F.wave, g, S, E); }
                else { constexpr int lp = layer > 0 ? layer - 1 : 0; pg8::EpiResidB<1> E{nullptr, nullptr, 0, STATS(1), a->in[22] + (size_t)lp * DM, a->in[23] + (size_t)lp * DM, (bf16_t*)(ws + WS_XB), PARTP, 0, F.lds};
                    pg8::gemm_phase(F.lds, F.wave, g, S, E); }
            } SEAM();
            if (RUN(base + 7)) { PH(); phase_finalize(F, PARTP, STATS(0), CSBW(layer) + 16384); } SEAM();
        } else {
                    if (RUN(base + 1)) { PH();
                pg8::GemmPlain g{(const bf16_t*)(ws + WS_XB), (const bf16_t*)(ws + WS_WIN), DM, DM}; pg8::StaticOrder S; S.init(MTOK, 3072, F.G, (int)blockIdx.x);
                pg8::EpiInAttn<true> E{ws + WS_R1, (const float*)(ws + WS_ROPE), pg8::Fold{STATS(1), CSBW(layer), CSBW(layer) + 8192}};
                pg8::gemm_phase(F.lds, F.wave, g, S, E);
            } SEAM();
                    if (RUN(base + 2)) { { PH(); phase_attn_mfma(F, a, j); } { PH(); phase_memattn_mfma(F, a, layer, (bf16_t*)(ws + WS_R1 + R1_CONCAT)); } } SEAM();
                    if (RUN(base + 6)) { PH();
                pg8::GemmPlain g{(const bf16_t*)(ws + WS_R1 + R1_CONCAT), (const bf16_t*)(ws + WS_WOUT), DM, DM}; pg8::StaticOrder S; S.init(MTOK, DM, F.G, (int)blockIdx.x);
                constexpr int lp = layer > 0 ? layer - 1 : 0; pg8::EpiResidB<1> E{nullptr, nullptr, 0, STATS(1), a->in[22] + (size_t)lp * DM, a->in[23] + (size_t)lp * DM, (bf16_t*)(ws + WS_XB), PARTP, 0, F.lds};
                pg8::gemm_phase(F.lds, F.wave, g, S, E);
            } SEAM();
            if (RUN(base + 7)) { PH(); phase_finalize(F, PARTP, STATS(0), CSBW(layer) + 16384); } SEAM();
        }

        { constexpr int half = 0; constexpr int roff = half * (MTOK / NSPLIT);

                        if (RUN(base + 8 + 2 * half)) { PH();
                pg8::GemmPlain g{(const bf16_t*)(ws + WS_XB) + (size_t)roff * DM, (const bf16_t*)(ws + WS_WFF1), DM, DM}; pg8::StaticOrder S; S.init(MTOK / NSPLIT, DFF, F.G, (int)blockIdx.x);
                pg8::EpiSqRelu E{(bf16_t*)(ws + WS_R1 + R1_H), DFF, pg8::Fold{STATS(0) + 2 * (size_t)roff, CSBW(layer) + 16384, CSBW(layer) + 24576}};
                pg8::gemm_phase(F.lds, F.wave, g, S, E);
            } GSEAM();
                        if (RUN(base + 9 + 2 * half)) { PH();
                pg8::GemmPlain g{(const bf16_t*)(ws + WS_R1 + R1_H), (const bf16_t*)(ws + WS_WFF2), DFF, DFF}; pg8::StaticOrder S; S.init(MTOK / NSPLIT, DM, F.G, (int)blockIdx.x);
                pg8::EpiResidB<1> E{nullptr, nullptr, 0, STATS(0), a->in[18] + (size_t)layer * DM, a->in[19] + (size_t)layer * DM, (bf16_t*)(ws + WS_XB), PARTP, roff, F.lds};
                pg8::gemm_phase(F.lds, F.wave, g, S, E);
            } if constexpr (half + 1 < NSPLIT) GSEAM(); else SEAM();
                }
        { constexpr int half = 1; constexpr int roff = half * (MTOK / NSPLIT);

                        if (RUN(base + 8 + 2 * half)) { PH();
                pg8::GemmPlain g{(const bf16_t*)(ws + WS_XB) + (size_t)roff * DM, (const bf16_t*)(ws + WS_WFF1), DM, DM}; pg8::StaticOrder S; S.init(MTOK / NSPLIT, DFF, F.G, (int)blockIdx.x);
                pg8::EpiSqRelu E{(bf16_t*)(ws + WS_R1 + R1_H), DFF, pg8::Fold{STATS(0) + 2 * (size_t)roff, CSBW(layer) + 16384, CSBW(layer) + 24576}};
                pg8::gemm_phase(F.lds, F.wave, g, S, E);
            } GSEAM();
                        if (RUN(base + 9 + 2 * half)) { PH();
                pg8::GemmPlain g{(const bf16_t*)(ws + WS_R1 + R1_H), (const bf16_t*)(ws + WS_WFF2), DFF, DFF}; pg8::StaticOrder S; S.init(MTOK / NSPLIT, DM, F.G, (int)blockIdx.x);
                pg8::EpiResidB<1> E{nullptr, nullptr, 0, STATS(0), a->in[18] + (size_t)layer * DM, a->in[19] + (size_t)layer * DM, (bf16_t*)(ws + WS_XB), PARTP, roff, F.lds};
                pg8::gemm_phase(F.lds, F.wave, g, S, E);
            } if constexpr (half + 1 < NSPLIT) GSEAM(); else SEAM();
                }
            if constexpr (layer < 3) { if (RUN(base + 24)) { { PH(); phase_finalize(F, PARTP, STATS(1)); } { PH(); phase_wconv(F, a, layer + 1); } } SEAM(); }
                if constexpr (layer == 3) { if (RUN(base + 25)) { PH(); phase_ln_final(F, (const bf16_t*)(ws + WS_XB), a->out, a->in[22] + (size_t)layer * DM, a->in[23] + (size_t)layer * DM); } }
        }
    { constexpr int layer = 3; constexpr int base = 2 + 32 * layer; constexpr bool attn = layer & 1; constexpr int j = layer >> 1; (void)j;

                if constexpr (layer == 0) { if (RUN(base + 0)) { PH(); phase_wconv(F, a, layer); } SEAM(); }
        if constexpr (!attn) {
                    if (RUN(base + 1)) { PH();
                pg8::GemmPlain g{(const bf16_t*)(ws + WS_XB), (const bf16_t*)(ws + WS_WIN), DM, DM}; pg8::StaticOrder S; S.init(MTOK, 2048, F.G, (int)blockIdx.x);
                pg8::EpiInSsm<(layer > 0)> E{(bf16_t*)(ws + WS_R1 + R1_UH), (bf16_t*)(ws + WS_R1 + R1_QM), pg8::Fold{STATS(1), CSBW(layer), CSBW(layer) + 8192}};
                pg8::gemm_phase(F.lds, F.wave, g, S, E);
            } SEAM();
        if (RUN(base + 2)) {
            { PH();
                pg8::GemmSsm g{(const bf16_t*)(ws + WS_R1 + R1_UH), (const bf16_t*)(ws + WS_SWG), 256, 512}; pg8::SsmOrder S{F.G, (int)blockIdx.x};
                pg8::EpiG1 E{(bf16_t*)(ws + WS_R1 + R1_G)};
                pg8::gemm_phase(F.lds, F.wave, g, S, E); }
            __builtin_amdgcn_fence(__ATOMIC_ACQUIRE, "agent");
            { PH(); phase_scan(F, a, j); }
            asm volatile("s_waitcnt vmcnt(0)" ::: "memory"); __syncthreads(); __builtin_amdgcn_fence(__ATOMIC_ACQUIRE, "agent");
            { PH();
                pg8::GemmSsm g{(const bf16_t*)(ws + WS_R1 + R1_UH), (const bf16_t*)(ws + WS_SWY), 512, 512}; pg8::SsmOrder S{F.G, (int)blockIdx.x};
                pg8::EpiG2 E{(bf16_t*)(ws + WS_R1 + R1_Z)};
                pg8::gemm_phase(F.lds, F.wave, g, S, E); }
        } SEAM();
            constexpr size_t ZOFF = WS_R1 + R1_Z, CCOFF = WS_R1 + R1_CONCAT;
                    if (RUN(base + 5)) {
                { PH();
                pg8::GemmPlain g{(const bf16_t*)(ws + ZOFF), (const bf16_t*)(ws + WS_WGLU), MIXW, MIXW}; pg8::StaticOrder S; S.init(MTOK, 3072, F.G, (int)blockIdx.x);
                pg8::EpiGlu E{(bf16_t*)(ws + CCOFF)};
                pg8::gemm_phase(F.lds, F.wave, g, S, E); }
                { PH(); phase_memattn_mfma(F, a, layer, (bf16_t*)(ws + CCOFF)); }
            } SEAM();
                    if (RUN(base + 6)) { PH();
                pg8::GemmPlain g{(const bf16_t*)(ws + CCOFF), (const bf16_t*)(ws + WS_WOUT), DM, DM}; pg8::StaticOrder S; S.init(MTOK, DM, F.G, (int)blockIdx.x);
                if constexpr (layer == 0) { pg8::EpiResidB<0> E{a->in[0], a->in[1], MROWS_PROMPT, nullptr, nullptr, nullptr, (bf16_t*)(ws + WS_XB), PARTP, 0, F.lds};
                    pg8::gemm_phase(F.lds, F.wave, g, S, E); }
                else { constexpr int lp = layer > 0 ? layer - 1 : 0; pg8::EpiResidB<1> E{nullptr, nullptr, 0, STATS(1), a->in[22] + (size_t)lp * DM, a->in[23] + (size_t)lp * DM, (bf16_t*)(ws + WS_XB), PARTP, 0, F.lds};
                    pg8::gemm_phase(F.lds, F.wave, g, S, E); }
            } SEAM();
            if (RUN(base + 7)) { PH(); phase_finalize(F, PARTP, STATS(0), CSBW(layer) + 16384); } SEAM();
        } else {
                    if (RUN(base + 1)) { PH();
                pg8::GemmPlain g{(const bf16_t*)(ws + WS_XB), (const bf16_t*)(ws + WS_WIN), DM, DM}; pg8::StaticOrder S; S.init(MTOK, 3072, F.G, (int)blockIdx.x);
                pg8::EpiInAttn<true> E{ws + WS_R1, (const float*)(ws + WS_ROPE), pg8::Fold{STATS(1), CSBW(layer), CSBW(layer) + 8192}};
                pg8::gemm_phase(F.lds, F.wave, g, S, E);
            } SEAM();
                    if (RUN(base + 2)) { { PH(); phase_attn_mfma(F, a, j); } { PH(); phase_memattn_mfma(F, a, layer, (bf16_t*)(ws + WS_R1 + R1_CONCAT)); } } SEAM();
                    if (RUN(base + 6)) { PH();
                pg8::GemmPlain g{(const bf16_t*)(ws + WS_R1 + R1_CONCAT), (const bf16_t*)(ws + WS_WOUT), DM, DM}; pg8::StaticOrder S; S.init(MTOK, DM, F.G, (int)blockIdx.x);
                constexpr int lp = layer > 0 ? layer - 1 : 0; pg8::EpiResidB<1> E{nullptr, nullptr, 0, STATS(1), a->in[22] + (size_t)lp * DM, a->in[23] + (size_t)lp * DM, (bf16_t*)(ws + WS_XB), PARTP, 0, F.lds};
                pg8::gemm_phase(F.lds, F.wave, g, S, E);
            } SEAM();
            if (RUN(base + 7)) { PH(); phase_finalize(F, PARTP, STATS(0), CSBW(layer) + 16384); } SEAM();
        }

        { constexpr int half = 0; constexpr int roff = half * (MTOK / NSPLIT);

                        if (RUN(base + 8 + 2 * half)) { PH();
                pg8::GemmPlain g{(const bf16_t*)(ws + WS_XB) + (size_t)roff * DM, (const bf16_t*)(ws + WS_WFF1), DM, DM}; pg8::StaticOrder S; S.init(MTOK / NSPLIT, DFF, F.G, (int)blockIdx.x);
                pg8::EpiSqRelu E{(bf16_t*)(ws + WS_R1 + R1_H), DFF, pg8::Fold{STATS(0) + 2 * (size_t)roff, CSBW(layer) + 16384, CSBW(layer) + 24576}};
                pg8::gemm_phase(F.lds, F.wave, g, S, E);
            } GSEAM();
                        if (RUN(base + 9 + 2 * half)) { PH();
                pg8::GemmPlain g{(const bf16_t*)(ws + WS_R1 + R1_H), (const bf16_t*)(ws + WS_WFF2), DFF, DFF}; pg8::StaticOrder S; S.init(MTOK / NSPLIT, DM, F.G, (int)blockIdx.x);
                pg8::EpiResidB<1> E{nullptr, nullptr, 0, STATS(0), a->in[18] + (size_t)layer * DM, a->in[19] + (size_t)layer * DM, (bf16_t*)(ws + WS_XB), PARTP, roff, F.lds};
                pg8::gemm_phase(F.lds, F.wave, g, S, E);
            } if constexpr (half + 1 < NSPLIT) GSEAM(); else SEAM();
                }
        { constexpr int half = 1; constexpr int roff = half * (MTOK / NSPLIT);

                        if (RUN(base + 8 + 2 * half)) { PH();
                pg8::GemmPlain g{(const bf16_t*)(ws + WS_XB) + (size_t)roff * DM, (const bf16_t*)(ws + WS_WFF1), DM, DM}; pg8::StaticOrder S; S.init(MTOK / NSPLIT, DFF, F.G, (int)blockIdx.x);
                pg8::EpiSqRelu E{(bf16_t*)(ws + WS_R1 + R1_H), DFF, pg8::Fold{STATS(0) + 2 * (size_t)roff, CSBW(layer) + 16384, CSBW(layer) + 24576}};
                pg8::gemm_phase(F.lds, F.wave, g, S, E);
            } GSEAM();
                        if (RUN(base + 9 + 2 * half)) { PH();
                pg8::GemmPlain g{(const bf16_t*)(ws + WS_R1 + R1_H), (const bf16_t*)(ws + WS_WFF2), DFF, DFF}; pg8::StaticOrder S; S.init(MTOK / NSPLIT, DM, F.G, (int)blockIdx.x);
                pg8::EpiResidB<1> E{nullptr, nullptr, 0, STATS(0), a->in[18] + (size_t)layer * DM, a->in[19] + (size_t)layer * DM, (bf16_t*)(ws + WS_XB), PARTP, roff, F.lds};
                pg8::gemm_phase(F.lds, F.wave, g, S, E);
            } if constexpr (half + 1 < NSPLIT) GSEAM(); else SEAM();
                }
            if constexpr (layer < 3) { if (RUN(base + 24)) { { PH(); phase_finalize(F, PARTP, STATS(1)); } { PH(); phase_wconv(F, a, layer + 1); } } SEAM(); }
                if constexpr (layer == 3) { if (RUN(base + 25)) { PH(); phase_ln_final(F, (const bf16_t*)(ws + WS_XB), a->out, a->in[22] + (size_t)layer * DM, a->in[23] + (size_t)layer * DM); } }
        }
#undef RUN
#undef SEAM
#undef PH
}

extern "C" void kernel_launch(void* const* d_in, const int* in_sizes, int n_in, void* d_out, int out_size, void* d_ws, size_t ws_size, hipStream_t stream) {
    static int grid = 0;
    if (grid == 0) {
        if (n_in != 24 || out_size != MTOK * DM || ws_size < WS_END) { fprintf(stderr, "kernel_launch: unexpected shapes: n_in %d out %d ws %zu (need %zu)\n", n_in, out_size, ws_size, (size_t)WS_END); grid = -1; return; }
        int dev = 0, cus = 0;
        if (hipGetDevice(&dev) != hipSuccess || hipDeviceGetAttribute(&cus, hipDeviceAttributeMultiprocessorCount, dev) != hipSuccess) { grid = -1; return; }
        if (hipFuncSetAttribute((const void*)mk_fwd, hipFuncAttributeMaxDynamicSharedMemorySize, LDS_BYTES) != hipSuccess) { fprintf(stderr, "kernel_launch: hipFuncSetAttribute failed\n"); grid = -1; return; }
        int per_cu = 0;
        if (hipOccupancyMaxActiveBlocksPerMultiprocessor(&per_cu, (const void*)mk_fwd, NWAVES * 64, LDS_BYTES) != hipSuccess || per_cu < 1) fprintf(stderr, "kernel_launch: occupancy query says %d\n", per_cu);
        (void)hipGetLastError();
        grid = cus;
    }
    if (grid < 0) return;
    (void)hipMemsetAsync((char*)d_ws + WS_CTL, 0, CTL_ZERO_BYTES, stream);
    Args a{};
    for (int i = 0; i < 24; ++i) a.in[i] = (const float*)d_in[i];
    a.out = (float*)d_out; a.ws = (unsigned char*)d_ws;
#if MK_MULTI
    for (int id = 0; id < 2 + 32 * 4; ++id) { a.lin_lo = id; a.lin_hi = id + 1; hipLaunchKernelGGL(mk_fwd, dim3(grid), dim3(NWAVES * 64), LDS_BYTES, stream, a); }
#else
    a.lin_lo = 0; a.lin_hi = 1 << 20;
    hipLaunchKernelGGL(mk_fwd, dim3(grid), dim3(NWAVES * 64), LDS_BYTES, stream, a);
#endif
    const hipError_t le = hipPeekAtLastError();
    if (le != hipSuccess) fprintf(stderr, "kernel_launch: launch failed: %s\n", hipGetErrorName(le));
}
```

```cpp
#include <hip/hip_runtime.h>
#include <cstdio>
#include <cstdint>

#ifndef MK_MULTI
#define MK_MULTI 0
#endif

#define GAS __attribute__((address_space(1)))
#define LAS __attribute__((address_space(3)))
typedef unsigned short bf16_t;
typedef short bf16x8 __attribute__((ext_vector_type(8)));
typedef float f32x4 __attribute__((ext_vector_type(4)));
typedef float f32x2 __attribute__((ext_vector_type(2)));
typedef unsigned u32x4 __attribute__((ext_vector_type(4)));
typedef unsigned u32x2 __attribute__((ext_vector_type(2)));
typedef int i32x4 __attribute__((ext_vector_type(4)));

constexpr int DM = 2048, NBATCH = 12, SEQ = 4096, MTOK = NBATCH * SEQ;
constexpr int MROWS_PROMPT = 8 * SEQ;
constexpr int MIXW = 1536, MEMW = 512, HD = 128, NQH = 12, NKVH = 4, KVW = 512, NMEM = 256;
constexpr int SSG = 96, SSP = 64, SSC = 16, DFF = 8192;
constexpr int NMEMROWS = NBATCH * NMEM;
constexpr float ALPHA = 1.6817928305074290f;
constexpr float LN_EPS = 1e-5f;
constexpr int NWAVES = 8;

constexpr size_t MiB = 1u << 20;
constexpr size_t WS_CTL = 0, CTL_ZERO_BYTES = 3 * MiB;
constexpr size_t WS_STATS = 1 * MiB;
constexpr size_t WS_PART = 3 * MiB;
constexpr size_t WS_CSBW = 2 * MiB;
constexpr size_t WS_ROPE = 6 * MiB;
constexpr size_t WS_POW = 8 * MiB;
constexpr size_t WS_BBAR = 12 * MiB;
constexpr size_t WS_KT = 16 * MiB;
constexpr size_t WS_MEMKV = 24 * MiB;
constexpr size_t WS_WIN = 48 * MiB;
constexpr size_t WS_WGLU = 60 * MiB;
constexpr size_t WS_WOUT = 69 * MiB;
constexpr size_t WS_WFF1 = 77 * MiB;
constexpr size_t WS_WFF2 = 109 * MiB;
constexpr size_t WS_SWG = 141 * MiB;
constexpr size_t WS_SWY = 153 * MiB;
constexpr size_t WS_XB = 177 * MiB;
constexpr size_t WS_R1 = 369 * MiB;
constexpr size_t WS_END = 993 * MiB;
constexpr size_t R1_UH = 0;
constexpr size_t R1_G = 288 * MiB;
constexpr size_t R1_Z = 432 * MiB;
constexpr size_t R1_QM = 576 * MiB;
constexpr size_t R1_CONCAT = 0;
constexpr size_t R1_Q = 192 * MiB;
constexpr size_t R1_K = 336 * MiB;
constexpr size_t R1_V = 384 * MiB;
#ifndef NSPLIT
#define NSPLIT 2
#endif
constexpr size_t R1_H = 240 * MiB;
constexpr size_t R1_MEMB = 0;
constexpr size_t R1_WMKV = 16 * MiB;
constexpr int CW_BAR = 4096;

constexpr int RING_BYTES = 131072;
constexpr int LDSCTL_OFF = RING_BYTES, MISC_OFF = LDSCTL_OFF + 320;
constexpr int LDS_BYTES = 163840;
constexpr int FOLD_SLOT_OFF = LDSCTL_OFF + 9216;

#define LDS_WAIT() asm volatile("s_waitcnt lgkmcnt(0)" ::: "memory")
#define VM_WAIT() asm volatile("s_waitcnt vmcnt(0)" ::: "memory")
__device__ __forceinline__ unsigned f2bf(float f) { unsigned u = __builtin_bit_cast(unsigned, f); return (u + 0x7fffu + ((u >> 16) & 1u)) >> 16; }
__device__ __forceinline__ unsigned pk2(float lo, float hi) { return f2bf(lo) | (f2bf(hi) << 16); }
__device__ __forceinline__ float bf2f(unsigned short b) { return __builtin_bit_cast(float, ((unsigned)b) << 16); }
__device__ __forceinline__ float bflo(unsigned w) { return __builtin_bit_cast(float, w << 16); }
__device__ __forceinline__ float bfhi(unsigned w) { return __builtin_bit_cast(float, w & 0xffff0000u); }

namespace pg8 {
constexpr int BM = 256, BK = 64, HALF = 128, HTB = HALF * BK * 2, NXCD = 8, WGM = 4;
__host__ __device__ __forceinline__ int lds_byte(int r, int c) { const int st = (r >> 4) * 2 + (c >> 5), rr = r & 15, cc = c & 31, ob = rr * 64 + cc * 2; return st * 1024 + (ob ^ (((ob >> 9) & 1) << 5)); }
__host__ __device__ __forceinline__ void stage_rc(int b, int& R, int& C) { const int st = b / 1024, sb = b % 1024, swz = sb ^ (((sb >> 9) & 1) << 5); R = (st >> 1) * 16 + swz / 64; C = (st & 1) * 32 + (swz % 64) / 2; }
__host__ __device__ __forceinline__ int perm32(int rho) { const int n = rho >> 4, i = rho & 15; return 8 * (i >> 2) + 4 * n + (i & 3); }

struct Unit { int pm, pn; };
struct GemmPlain {
    const bf16_t* A; const bf16_t* Bt; int K, lda;
    __device__ __forceinline__ const char* a_tile(const Unit& u) const { return (const char*)(A + (size_t)u.pm * BM * lda); }
    __device__ __forceinline__ const char* b_tile(const Unit& u) const { return (const char*)(Bt + (size_t)u.pn * BM * K); }
};
struct GemmSsm {
    const bf16_t* A; const bf16_t* Bt; int K, lda;
    __device__ __forceinline__ const char* a_tile(const Unit& u) const { return (const char*)(A + (size_t)(u.pm * SSG + u.pn) * 256 * 512); }
    __device__ __forceinline__ const char* b_tile(const Unit& u) const { return (const char*)(Bt + (size_t)u.pn * 256 * K); }
};
struct StaticOrder {
    int nM, nN, nwg, G, c, ffn = 0;
    __device__ void init(int M, int N, int G_, int c_) { nM = M / BM; nN = N / BM; nwg = nM * nN; G = G_; c = c_; }
    __device__ bool next(int i, Unit& u) const {
        const long L = (long)i * G + c; if (L >= nwg) return false;
        int wgid = (int)L; { const int q = nwg / NXCD, r = nwg % NXCD, xcd = wgid % NXCD, off = wgid / NXCD; wgid = (xcd < r ? xcd * (q + 1) : r * (q + 1) + (xcd - r) * q) + off; }
        const int nig = WGM * nN; int gid = wgid / nig;
        if (ffn) { constexpr int GP = MTOK / NSPLIT / BM / WGM / NXCD; const int x = gid / (GP * NSPLIT), k = gid % (GP * NSPLIT); gid = (k / GP) * (GP * NXCD) + x * GP + k % GP; }
        const int fm = gid * WGM, gsz = (nM - fm) < WGM ? (nM - fm) : WGM;
        u.pm = fm + ((wgid % nig) % gsz); u.pn = (wgid % nig) / gsz; return true;
    }
    __device__ __forceinline__ void a_ready(const Unit&) const {}
    __device__ __forceinline__ void done(const Unit&) const {}
};
struct SsmOrder {
    int G, c;
    __device__ bool next(int i, Unit& u) const { const int L = i * G + c; if (L >= NBATCH * SSG) return false; u.pm = L % NBATCH; u.pn = L / NBATCH; return true; }
    __device__ __forceinline__ void a_ready(const Unit&) const {}
    __device__ __forceinline__ void done(const Unit&) const {}
};
typedef __bf16 bf16x2_t __attribute__((ext_vector_type(2)));
__device__ __forceinline__ unsigned cvt_pk_bf16(float lo, float hi) { const f32x2 v = {lo, hi}; return __builtin_bit_cast(unsigned, __builtin_convertvector(v, bf16x2_t)); }

#ifndef RELAX
#define RELAX 0
#endif
template <class E, class = void> struct EpiPre { static constexpr bool v = false; };
template <class E> struct EpiPre<E, decltype((void)E::PRE)> { static constexpr bool v = E::PRE; };
#ifndef STAGGER
#define STAGGER 0
#endif
#ifndef SPLITST
#define SPLITST 0
#endif
template <class Epi, class GM, class Sched, int PROBE = 0>
__device__ __forceinline__ void gemm_phase(LAS unsigned char* lds, int wave, const GM g, const Sched& S, const Epi& E) {
    int lane_; asm volatile("v_mbcnt_lo_u32_b32 %0, -1, 0\n\tv_mbcnt_hi_u32_b32 %0, -1, %0" : "=v"(lane_));
    const int wid = wave, lane = lane_, tid = wid * 64 + lane, wr = wid >> 2, wc = wid & 3, fr = lane & 15, fq = lane >> 4;
    const int K = g.K, nt = K / BK;
    unsigned voffA[2], voffB[2];
#pragma unroll
    for (int i = 0; i < 2; ++i) { int R, C; stage_rc(tid * 16 + i * 8192, R, C); const int Rb = Epi::PERM ? ((R & ~31) + perm32(R & 31)) : R;
        voffA[i] = (unsigned)(R * g.lda + C) * 2u; voffB[i] = (unsigned)(Rb * K + C) * 2u; }
    const size_t kstep = (size_t)(BK * 2);
    const size_t hstepA = (size_t)HALF * g.lda * 2, hstepB = (size_t)HALF * K * 2;
    const unsigned ldsw = (unsigned)wid * 1024u;
    const int aoff = lds_byte(wr * 64 + fr, fq * 8), boff = lds_byte(wc * 32 + fr, fq * 8);
#define PG8_SA(b, h) (((b) * 2 + (h)) * HTB)
#define PG8_SB(b, h) ((4 + (b) * 2 + (h)) * HTB)
#define PG8_STAGE(bufoff, gbase, voff) do { if (PROBE < 2 || (PROBE == 4 && (bufoff) >= 4 * HTB) || (PROBE == 5 && (bufoff) < 4 * HTB)) _Pragma("unroll") for (int _i = 0; _i < 2; ++_i) \
        __builtin_amdgcn_global_load_lds((const unsigned*)((const char*)(gbase) + (voff)[_i]), (LAS unsigned*)(lds + (bufoff) + ldsw + _i * 8192), 16, 0, 0); } while (0)
#define PG8_LDA(dst, b, h) do { _Pragma("unroll") for (int m = 0; m < 4; ++m) _Pragma("unroll") for (int k = 0; k < 2; ++k) dst[m][k] = *(const LAS bf16x8*)(lds + PG8_SA(b, h) + aoff + m * 2048 + k * 1024); } while (0)
#define PG8_LDB(dst, b, h) do { _Pragma("unroll") for (int n = 0; n < 2; ++n) _Pragma("unroll") for (int k = 0; k < 2; ++k) dst[n][k] = *(const LAS bf16x8*)(lds + PG8_SB(b, h) + boff + n * 2048 + k * 1024); } while (0)
#define PG8_MMA(ai, bj, At, Bt) do { __builtin_amdgcn_s_setprio(1); _Pragma("unroll") for (int m = 0; m < 4; ++m) _Pragma("unroll") for (int n = 0; n < 2; ++n) _Pragma("unroll") for (int k = 0; k < 2; ++k) \
        acc[ai][bj][m][n] = __builtin_amdgcn_mfma_f32_16x16x32_bf16(Bt[n][k], At[m][k], acc[ai][bj][m][n], 0, 0, 0); __builtin_amdgcn_s_setprio(0); } while (0)
#define PG8_WAIT_V(n) asm volatile("s_waitcnt vmcnt(" #n ")" ::: "memory")
#define PG8_WAIT_L(n) asm volatile("s_waitcnt lgkmcnt(" #n ")" ::: "memory")
#define PG8_BAR __builtin_amdgcn_s_barrier()
#define PG8_SCHED __builtin_amdgcn_sched_barrier(0)
    Unit cur, nxt; int ui = 0;
    if (!S.next(0, cur)) return;
    f32x4 acc[2][2][4][2];
#pragma unroll
    for (int a = 0; a < 2; ++a)
#pragma unroll
        for (int b = 0; b < 2; ++b)
#pragma unroll
            for (int m = 0; m < 4; ++m)
#pragma unroll
                for (int n = 0; n < 2; ++n) acc[a][b][m][n] = (f32x4){0.f, 0.f, 0.f, 0.f};
    bf16x8 At[4][2], B0[2][2], B1[2][2];
    const char* cA = g.a_tile(cur); const char* cB = g.b_tile(cur);
    S.a_ready(cur);
    if (STAGGER > 0) { const int grp = (blockIdx.x >> 3) & 7; for (int i = 0; i < grp; ++i) __builtin_amdgcn_s_sleep(STAGGER); }
    PG8_STAGE(PG8_SB(0, 0), cB, voffB); PG8_STAGE(PG8_SB(0, 1), cB + hstepB, voffB); PG8_STAGE(PG8_SA(0, 0), cA, voffA); PG8_STAGE(PG8_SA(0, 1), cA + hstepA, voffA);
    PG8_STAGE(PG8_SB(1, 0), cB + kstep, voffB); PG8_STAGE(PG8_SA(1, 0), cA + kstep, voffA); PG8_STAGE(PG8_SB(1, 1), cB + hstepB + kstep, voffB);
    if (wr == 1) PG8_BAR;
    PG8_WAIT_V(6); PG8_BAR;
    PG8_BAR;
    for (;;) {
        const bool has_next = S.next(ui + 1, nxt);
        const char* nA = has_next ? g.a_tile(nxt) : cA; const char* nB = has_next ? g.b_tile(nxt) : cB;
        if constexpr (EpiPre<Epi>::v) E.prefetch(lds, cur, ui & 1, wid, lane);
#define PG8_TRIP(W12) do { \
            const bool last = (t == nt - 2); \
            const char* a1 = cA + (size_t)(t + 1) * kstep; \
            const char* a2 = last ? nA : cA + (size_t)(t + 2) * kstep; const char* b2 = last ? nB : cB + (size_t)(t + 2) * kstep; \
            const char* a3 = a2 + kstep; const char* b3 = b2 + kstep; \
            if (last && has_next) S.a_ready(nxt); \
            PG8_LDB(B0, 0, 0); PG8_LDB(B1, 0, 1); PG8_SCHED; PG8_LDA(At, 0, 0); PG8_STAGE(PG8_SA(1, 1), a1 + hstepA, voffA); \
            W12; PG8_WAIT_L(0); PG8_BAR; PG8_MMA(0, 0, At, B0); PG8_MMA(0, 1, At, B1); PG8_BAR; PG8_SCHED; \
            PG8_LDA(At, 0, 1); PG8_STAGE(PG8_SB(0, 0), b2, voffB); PG8_STAGE(PG8_SB(0, 1), b2 + hstepB, voffB); if (!SPLITST) PG8_STAGE(PG8_SA(0, 0), a2, voffA); \
            if (SPLITST) PG8_WAIT_V(6); else { W12; } PG8_WAIT_L(0); PG8_BAR; if (SPLITST) { PG8_STAGE(PG8_SA(0, 0), a2, voffA); PG8_SCHED; } PG8_MMA(1, 0, At, B0); PG8_MMA(1, 1, At, B1); PG8_BAR; PG8_SCHED; \
            PG8_LDB(B0, 1, 0); PG8_LDB(B1, 1, 1); PG8_SCHED; PG8_LDA(At, 1, 0); PG8_STAGE(PG8_SA(0, 1), a2 + hstepA, voffA); \
            PG8_WAIT_V(8); PG8_WAIT_L(0); PG8_BAR; PG8_MMA(0, 0, At, B0); PG8_MMA(0, 1, At, B1); PG8_BAR; PG8_SCHED; \
            PG8_LDA(At, 1, 1); PG8_STAGE(PG8_SB(1, 0), b3, voffB); PG8_STAGE(PG8_SB(1, 1), b3 + hstepB, voffB); if (!SPLITST) PG8_STAGE(PG8_SA(1, 0), a3, voffA); \
            if (SPLITST) PG8_WAIT_V(6); else PG8_WAIT_V(8); PG8_WAIT_L(0); PG8_BAR; if (SPLITST) { PG8_STAGE(PG8_SA(1, 0), a3, voffA); PG8_SCHED; } PG8_MMA(1, 0, At, B0); PG8_MMA(1, 1, At, B1); PG8_BAR; PG8_SCHED; \
        } while (0)
#define PG8_W12_16 asm volatile("s_waitcnt vmcnt(24)\n\ts_cmp_lg_u32 %0, 0\n\ts_cbranch_scc1 1f\n\ts_waitcnt vmcnt(8)\n1:" :: "s"(relax) : "scc", "memory")
#define PG8_W12_32 asm volatile("s_waitcnt vmcnt(40)\n\ts_cmp_lg_u32 %0, 0\n\ts_cbranch_scc1 1f\n\ts_waitcnt vmcnt(8)\n1:" :: "s"(relax) : "scc", "memory")
        for (int t = 0; t < nt; t += 2) {
            const int relax = __builtin_amdgcn_readfirstlane((RELAX && Epi::NST > 0 && ui > 0 && t == 0) ? 1 : 0);
            if constexpr (!RELAX || Epi::NST < 16) { PG8_TRIP(PG8_WAIT_V(8)); } else if constexpr (Epi::NST >= 32) { PG8_TRIP(PG8_W12_32); } else { PG8_TRIP(PG8_W12_16); }
        }
#undef PG8_TRIP
#undef PG8_W12_16
#undef PG8_W12_32
        if (wr == 0) PG8_BAR;
        if (PROBE >= 1) {
#pragma unroll
            for (int a = 0; a < 2; ++a)
#pragma unroll
                for (int b = 0; b < 2; ++b)
#pragma unroll
                    for (int m = 0; m < 4; ++m)
#pragma unroll
                        for (int n = 0; n < 2; ++n) asm volatile("" :: "v"(acc[a][b][m][n]));
        } else
        { int fr_ = fr, fq_ = fq; asm volatile("" : "+v"(fr_), "+v"(fq_)); if constexpr (EpiPre<Epi>::v) E.run(acc, cur, wr, wc, fr_, fq_, lds + FOLD_SLOT_OFF + (ui & 1) * 4096); else E(acc, cur, wr, wc, fr_, fq_); }
        S.done(cur);
        if (!has_next) break;
#pragma unroll
        for (int a = 0; a < 2; ++a)
#pragma unroll
            for (int b = 0; b < 2; ++b)
#pragma unroll
                for (int m = 0; m < 4; ++m)
#pragma unroll
                    for (int n = 0; n < 2; ++n) acc[a][b][m][n] = (f32x4){0.f, 0.f, 0.f, 0.f};
        cur = nxt; cA = nA; cB = nB; ++ui;
        if (wr == 1) PG8_BAR;
    }
    PG8_WAIT_V(0);
    PG8_BAR;
#undef PG8_SA
#undef PG8_SB
#undef PG8_STAGE
#undef PG8_LDA
#undef PG8_LDB
#undef PG8_MMA
#undef PG8_WAIT_V
#undef PG8_WAIT_L
#undef PG8_BAR
#undef PG8_SCHED
}

typedef const f32x4 (&AccRef)[2][2][4][2];
#define EPI_ROWS_BEGIN _Pragma("unroll") for (int ai = 0; ai < 2; ++ai) _Pragma("unroll") for (int m = 0; m < 4; ++m) { const int r = u.pm * BM + ai * HALF + wr * 64 + m * 16 + fr;
#define EPI_ROWS_END }
__device__ __forceinline__ u32x4 pack8(f32x4 v0, f32x4 v1) { u32x4 w; w.x = cvt_pk_bf16(v0[0], v0[1]); w.y = cvt_pk_bf16(v0[2], v0[3]); w.z = cvt_pk_bf16(v1[0], v1[1]); w.w = cvt_pk_bf16(v1[2], v1[3]); return w; }

struct Fold { const float* st; const float* cs; const float* bw; };
__device__ __forceinline__ void row_stats(const float* st, int r, float& mu, float& rs) { const f32x2 sq = *(const f32x2*)(st + 2 * (size_t)r); mu = sq.x; rs = sq.y; }
struct EpiPlainBf16 {
    static constexpr bool PERM = true; static constexpr int NST = 16;
    bf16_t* O; int ldc;
    __device__ __forceinline__ void operator()(AccRef acc, const Unit& u, int wr, int wc, int fr, int fq) const {
        const int c0 = u.pn * BM + wc * 32 + 8 * fq;
        EPI_ROWS_BEGIN  bf16_t* rowp = O + (size_t)r * ldc + c0;
#pragma unroll
            for (int bj = 0; bj < 2; ++bj) *(u32x4*)(rowp + bj * HALF) = pack8(acc[ai][bj][m][0], acc[ai][bj][m][1]);  EPI_ROWS_END
    }
};
#define FOLD_COLS() f32x4 csv[2][2], bwv[2][2]; if (FOLD) { _Pragma("unroll") for (int bj = 0; bj < 2; ++bj) _Pragma("unroll") for (int n = 0; n < 2; ++n) { \
        const i32x4 ci_ = *(const i32x4*)(fo.cs + cfull + bj * HALF + 4 * n), bi_ = *(const i32x4*)(fo.bw + cfull + bj * HALF + 4 * n); \
        csv[bj][n] = __builtin_convertvector(ci_, f32x4) * 5.9604644775390625e-08f; bwv[bj][n] = __builtin_convertvector(bi_, f32x4) * 5.9604644775390625e-08f; } } \
    f32x2 stv[2][4]; if (FOLD) { _Pragma("unroll") for (int ai = 0; ai < 2; ++ai) _Pragma("unroll") for (int m = 0; m < 4; ++m) stv[ai][m] = *(const f32x2*)(fo.st + 2 * (size_t)(u.pm * BM + ai * HALF + wr * 64 + m * 16 + fr)); }
#define FOLD_ROW() const float mu = FOLD ? stv[ai][m].x : 0.f, rs = FOLD ? stv[ai][m].y : 1.f;
#define FOLD_COLS_LDS() f32x4 csv[2][2], bwv[2][2]; f32x2 stv[2][4]; if (FOLD) { _Pragma("unroll") for (int bj = 0; bj < 2; ++bj) _Pragma("unroll") for (int n = 0; n < 2; ++n) { \
        const i32x4 ci_ = *(const LAS i32x4*)(slot + (cl + bj * HALF + 4 * n) * 4), bi_ = *(const LAS i32x4*)(slot + 1024 + (cl + bj * HALF + 4 * n) * 4); \
        csv[bj][n] = __builtin_convertvector(ci_, f32x4) * 5.9604644775390625e-08f; bwv[bj][n] = __builtin_convertvector(bi_, f32x4) * 5.9604644775390625e-08f; } \
        _Pragma("unroll") for (int ai = 0; ai < 2; ++ai) _Pragma("unroll") for (int m = 0; m < 4; ++m) stv[ai][m] = *(const LAS f32x2*)(slot + 2048 + (ai * HALF + wr * 64 + m * 16 + fr) * 8); }
#define FOLD_COLS_LDS_F() f32x4 csv[2][2], bwv[2][2]; f32x2 stv[2][4]; if (FOLD) { _Pragma("unroll") for (int bj = 0; bj < 2; ++bj) _Pragma("unroll") for (int n = 0; n < 2; ++n) { \
        csv[bj][n] = *(const LAS f32x4*)(slot + (cl + bj * HALF + 4 * n) * 4); bwv[bj][n] = *(const LAS f32x4*)(slot + 1024 + (cl + bj * HALF + 4 * n) * 4); } \
        _Pragma("unroll") for (int ai = 0; ai < 2; ++ai) _Pragma("unroll") for (int m = 0; m < 4; ++m) stv[ai][m] = *(const LAS f32x2*)(slot + 2048 + (ai * HALF + wr * 64 + m * 16 + fr) * 8); }
#define FOLD_PREFETCH() static constexpr bool PRE = FOLD; \
    __device__ __forceinline__ void prefetch(LAS unsigned char* lds, const Unit& u, int par, int wid, int lane) const { \
        if (wid < 4) { const char* src = wid == 0 ? (const char*)(fo.cs + u.pn * BM) : wid == 1 ? (const char*)(fo.bw + u.pn * BM) : (const char*)(fo.st + 2 * (size_t)(u.pm * BM + (wid - 2) * HALF)); \
            __builtin_amdgcn_global_load_lds((const unsigned*)(src + lane * 16), (LAS unsigned*)(lds + FOLD_SLOT_OFF + par * 4096 + wid * 1024), 16, 0, 0); } }
#define FOLDV(bj, n) (FOLD ? (acc[ai][bj][m][n] - csv[bj][n] * mu) * rs + bwv[bj][n] : acc[ai][bj][m][n])
template <bool FOLD> struct EpiInSsm {
    static constexpr bool PERM = true; static constexpr int NST = 16;
    bf16_t* UH; bf16_t* QM; Fold fo;
    FOLD_PREFETCH()
    __device__ __forceinline__ void operator()(AccRef acc, const Unit& u, int wr, int wc, int fr, int fq) const { run(acc, u, wr, wc, fr, fq, nullptr); }
    __device__ __forceinline__ void run(AccRef acc, const Unit& u, int wr, int wc, int fr, int fq, const LAS unsigned char* slot) const {
        const int cl = wc * 32 + 8 * fq; const bool isu = u.pn < 6;
        FOLD_COLS_LDS()
        const int ou = ((((u.pm >> 4) * SSG + u.pn * 16 + wc * 2 + (fq >> 1)) * 256 + (u.pm & 15) * 16 + wr * 4) * 512 + fr * 16 + 8 * (fq & 1));
        const int oq = (u.pm * BM + wr * 64 + fr) * MEMW + (u.pn * BM + wc * 32 + 8 * fq - MIXW);
        char* const obase = isu ? (char*)UH : (char*)QM; const unsigned bo = 2u * (unsigned)(isu ? ou : oq);
        const unsigned sm = isu ? 1024u : 16384u, sai = isu ? 8192u : 131072u, sbj = isu ? 2097152u : 256u;
        EPI_ROWS_BEGIN  (void)r; FOLD_ROW()
#pragma unroll
            for (int bj = 0; bj < 2; ++bj) *(u32x4*)(obase + (bo + ai * sai + m * sm + bj * sbj)) = pack8(FOLDV(bj, 0), FOLDV(bj, 1));  EPI_ROWS_END
    }
};
template <bool FOLD> struct EpiInAttn {
    static constexpr bool PERM = true; static constexpr int NST = 16;
    unsigned char* r1; const float* rope; Fold fo;
    FOLD_PREFETCH()
    __device__ __forceinline__ void operator()(AccRef acc, const Unit& u, int wr, int wc, int fr, int fq) const { run(acc, u, wr, wc, fr, fq, nullptr); }
    __device__ __forceinline__ void run(AccRef acc, const Unit& u, int wr, int wc, int fr, int fq, const LAS unsigned char* slot) const {
        const int ct = u.pn * BM + wc * 32 + 8 * fq, cl = wc * 32 + 8 * fq; const bool ro = u.pn < 8;
        const size_t boff = R1_Q + (size_t)(u.pn >= 6) * (R1_K - R1_Q) + (size_t)(u.pn >= 8) * (R1_V - R1_K) + (size_t)(u.pn >= 10) * (R1_QM - R1_V);
        bf16_t* base = (bf16_t*)(r1 + boff); const int ld = u.pn < 6 ? MIXW : KVW;
        const int c0 = ct - (u.pn >= 6) * MIXW - (u.pn >= 8) * KVW - (u.pn >= 10) * KVW;
        const int i0 = 16 * wc + 4 * fq;
        FOLD_COLS_LDS()
#ifndef RP_DIST
#define RP_DIST 2
#endif
        f32x4 rc0[8], rc1[8];
#define RP_LOAD(s) do { const int pos_ = (u.pm * BM + ((s) >> 2) * HALF + wr * 64 + ((s) & 3) * 16 + fr) & 4095; rc0[s] = *(const f32x4*)(rope + (size_t)(pos_ * 64 + i0) * 2); rc1[s] = *(const f32x4*)(rope + (size_t)(pos_ * 64 + i0) * 2 + 4); } while (0)
#pragma unroll
        for (int s = 0; s < RP_DIST; ++s) RP_LOAD(s);
        EPI_ROWS_BEGIN  if (ai * 4 + m + RP_DIST < 8) RP_LOAD(ai * 4 + m + RP_DIST);
            f32x4 cs0 = rc0[ai * 4 + m], cs1 = rc1[ai * 4 + m];
            if (!ro) { cs0 = (f32x4){1.f, 0.f, 1.f, 0.f}; cs1 = cs0; }
            bf16_t* rowp = base + (size_t)r * ld + c0; FOLD_ROW()
#pragma unroll
            for (int bj = 0; bj < 2; ++bj) { const f32x4 v0 = FOLDV(bj, 0), v1 = FOLDV(bj, 1); f32x4 o0, o1;
                o0[0] = v0[0] * cs0[0] - v0[1] * cs0[1]; o0[1] = v0[1] * cs0[0] + v0[0] * cs0[1]; o0[2] = v0[2] * cs0[2] - v0[3] * cs0[3]; o0[3] = v0[3] * cs0[2] + v0[2] * cs0[3];
                o1[0] = v1[0] * cs1[0] - v1[1] * cs1[1]; o1[1] = v1[1] * cs1[0] + v1[0] * cs1[1]; o1[2] = v1[2] * cs1[2] - v1[3] * cs1[3]; o1[3] = v1[3] * cs1[2] + v1[2] * cs1[3];
                *(u32x4*)(rowp + bj * HALF) = pack8(o0, o1); }  EPI_ROWS_END
#undef RP_LOAD
    }
};
struct EpiG1 {
    static constexpr bool PERM = true; static constexpr int NST = 16;
    bf16_t* G;
    __device__ __forceinline__ void operator()(AccRef acc, const Unit& u, int wr, int wc, int fr, int fq) const {
        char* base = (char*)(G + (size_t)(u.pm * SSG + u.pn) * 65536); const unsigned bo = 2u * (unsigned)((wr * 64 + fr) * 256 + wc * 32 + 8 * fq);
#pragma unroll
        for (int ai = 0; ai < 2; ++ai)
#pragma unroll
            for (int m = 0; m < 4; ++m)
#pragma unroll
                for (int bj = 0; bj < 2; ++bj) *(u32x4*)(base + (bo + 2u * (unsigned)((ai * HALF + m * 16) * 256 + bj * HALF))) = pack8(acc[ai][bj][m][0], acc[ai][bj][m][1]);
    }
};
__device__ __forceinline__ f32x4 gelu_tanh4(f32x4 x) {
    const f32x4 t = x * (x * x * (-2.885390081777927f * 0.7978845608028654f * 0.044715f) + (-2.885390081777927f * 0.7978845608028654f));
    f32x4 r;
#pragma unroll
    for (int j = 0; j < 4; ++j) r[j] = __builtin_amdgcn_rcpf(1.0f + __builtin_amdgcn_exp2f(t[j]));
    return x * r;
}
struct EpiG2 {
    static constexpr bool PERM = true; static constexpr int NST = 16;
    bf16_t* Z;
    __device__ __forceinline__ void operator()(AccRef acc, const Unit& u, int wr, int wc, int fr, int fq) const {
        const int c0 = wc * 32 + 8 * fq;
#pragma unroll
        for (int ai = 0; ai < 2; ++ai)
#pragma unroll
            for (int m = 0; m < 4; ++m) { const int kk = ai * HALF + wr * 64 + m * 16 + fr;
#pragma unroll
                for (int bj = 0; bj < 2; ++bj) { const int c = c0 + bj * HALF; f32x4 v0 = acc[ai][bj][m][0], v1 = acc[ai][bj][m][1];
                    v0 = gelu_tanh4(v0); v1 = gelu_tanh4(v1);
                    bf16_t* p = Z + (size_t)(u.pm * SEQ + kk * 16 + (c >> 4)) * MIXW + u.pn * 16 + (c & 15);
                    *(u32x4*)p = pack8(v0, v1); } }
    }
};
struct EpiGlu {
    static constexpr bool PERM = true; static constexpr int NST = 16;
    bf16_t* O;
    __device__ __forceinline__ void operator()(AccRef acc, const Unit& u, int wr, int wc, int fr, int fq) const {
        const int c0 = u.pn * BM + wc * 32 + 8 * fq;
        EPI_ROWS_BEGIN  bf16_t* rowp = O + (size_t)r * DM;
#pragma unroll
            for (int bj = 0; bj < 2; ++bj) { const int q4 = (c0 + bj * HALF) >> 1; const f32x4 a = acc[ai][bj][m][0], gt = acc[ai][bj][m][1]; float o[4];
#pragma unroll
                for (int j = 0; j < 4; ++j) o[j] = a[j] * __builtin_amdgcn_rcpf(1.0f + __builtin_amdgcn_exp2f(-1.4426950408889634f * gt[j]));
                u32x2 w; w.x = cvt_pk_bf16(o[0], o[1]); w.y = cvt_pk_bf16(o[2], o[3]); *(u32x2*)(rowp + q4) = w; }  EPI_ROWS_END
    }
};
template <int MODE> struct EpiResidB {
    static constexpr bool PERM = true; static constexpr int NST = 16;
    const float* xa; const float* xb2; int split; const float* stp; const float* gam; const float* bet;
    bf16_t* vb; float* part; int row_off; LAS unsigned char* lds;
    static constexpr bool PRE = MODE == 1;
    __device__ __forceinline__ void prefetch(LAS unsigned char* lds_, const Unit& u, int par, int wid, int lane) const {
        if (wid < 4) { const char* src = wid == 0 ? (const char*)(gam + u.pn * BM) : wid == 1 ? (const char*)(bet + u.pn * BM) : (const char*)(stp + 2 * (size_t)(u.pm * BM + row_off + (wid - 2) * HALF));
            __builtin_amdgcn_global_load_lds((const unsigned*)(src + lane * 16), (LAS unsigned*)(lds_ + FOLD_SLOT_OFF + par * 4096 + wid * 1024), 16, 0, 0); } }
    __device__ __forceinline__ void operator()(AccRef acc, const Unit& u, int wr, int wc, int fr, int fq) const { run(acc, u, wr, wc, fr, fq, nullptr); }
    __device__ __forceinline__ void run(AccRef acc, const Unit& u, int wr, int wc, int fr, int fq, const LAS unsigned char* slot) const {
        const int c0 = u.pn * BM + wc * 32 + 8 * fq, cl = wc * 32 + 8 * fq;
        LAS f32x2* P = (LAS f32x2*)(lds + LDSCTL_OFF + 1024);
        f32x4 gv[2][2], bv[2][2];
        if (MODE == 1) {
#pragma unroll
            for (int bj = 0; bj < 2; ++bj)
#pragma unroll
                for (int n = 0; n < 2; ++n) { gv[bj][n] = *(const LAS f32x4*)(slot + (cl + bj * HALF + 4 * n) * 4); bv[bj][n] = *(const LAS f32x4*)(slot + 1024 + (cl + bj * HALF + 4 * n) * 4); } }
#ifndef RB_DIST
#define RB_DIST 8
#endif
        constexpr int DIST = MODE == 1 ? RB_DIST : 4;
        const int row0 = u.pm * BM + row_off;
        const char* xbase = MODE == 1 ? (const char*)vb : (row0 < split ? (const char*)xa : (const char*)(xb2 - (size_t)split * DM));
        const unsigned eo = (unsigned)((row0 + wr * 64 + fr) * DM + c0);
#define RB_EO(s) (eo + (unsigned)((((s) >> 3) * HALF + (((s) >> 1) & 3) * 16) * DM + ((s) & 1) * HALF))
#define RB_LOAD(s) do { if (MODE == 1) wq[s] = *(const u32x4*)(xbase + 2 * RB_EO(s)); else { xq0[s] = *(const f32x4*)(xbase + 4 * RB_EO(s)); xq1[s] = *(const f32x4*)(xbase + 4 * RB_EO(s) + 16); } } while (0)
        u32x4 wq[16]; f32x4 xq0[16], xq1[16];
#pragma unroll
        for (int s = 0; s < DIST; ++s) RB_LOAD(s);
        float s1 = 0.f, s2 = 0.f;
#pragma unroll
        for (int s = 0; s < 16; ++s) { const int ai = s >> 3, m = (s >> 1) & 3, bj = s & 1;
            if (s + DIST < 16) RB_LOAD(s + DIST);
            f32x2 st_ = {0.f, 1.f}; if (MODE == 1) st_ = *(const LAS f32x2*)(slot + 2048 + (ai * HALF + wr * 64 + m * 16 + fr) * 8);
            const float rs = st_.y, nmr = -st_.x * rs;
            f32x4 x0, x1;
            if (MODE == 1) { const u32x4 w = wq[s];
                x0 = (f32x4){bflo(w.x), bfhi(w.x), bflo(w.y), bfhi(w.y)}; x1 = (f32x4){bflo(w.z), bfhi(w.z), bflo(w.w), bfhi(w.w)};
                x0 = (x0 * rs + nmr) * gv[bj][0] + bv[bj][0]; x1 = (x1 * rs + nmr) * gv[bj][1] + bv[bj][1]; }
            else { x0 = xq0[s]; x1 = xq1[s]; }
            const f32x4 v0 = x0 * ALPHA + acc[ai][bj][m][0], v1 = x1 * ALPHA + acc[ai][bj][m][1];
            *(u32x4*)((char*)vb + 2 * RB_EO(s)) = pack8(v0, v1);
            { const f32x4 q = v0 + v1, q2 = v0 * v0 + v1 * v1; s1 += (q[0] + q[1]) + (q[2] + q[3]); s2 += (q2[0] + q2[1]) + (q2[2] + q2[3]); }
            if (bj == 1) { s1 += __shfl_xor(s1, 16); s1 += __shfl_xor(s1, 32); s2 += __shfl_xor(s2, 16); s2 += __shfl_xor(s2, 32);
                if (fq == 0) P[(ai * HALF + wr * 64 + m * 16 + fr) * 4 + wc] = (f32x2){s1, s2};
                s1 = 0.f; s2 = 0.f; } }
#undef RB_EO
#undef RB_LOAD
        asm volatile("s_waitcnt lgkmcnt(0)" ::: "memory"); __builtin_amdgcn_s_barrier(); asm volatile("" ::: "memory");
        if (wr == 0) { const int rl = wc * 64 + fq * 16 + fr; const f32x4 p01 = *(const LAS f32x4*)(P + rl * 4), p23 = *(const LAS f32x4*)(P + rl * 4 + 2);
            *(f32x2*)(part + ((size_t)(u.pm * BM + row_off + rl) * 8 + u.pn) * 2) = (f32x2){(p01[0] + p01[2]) + (p23[0] + p23[2]), (p01[1] + p01[3]) + (p23[1] + p23[3])}; }
    }
};
template <bool FOLD> struct EpiSqReluT {
    static constexpr bool PERM = true; static constexpr int NST = 16;
    bf16_t* O; int ldc; Fold fo;
    FOLD_PREFETCH()
    __device__ __forceinline__ void operator()(AccRef acc, const Unit& u, int wr, int wc, int fr, int fq) const { run(acc, u, wr, wc, fr, fq, nullptr); }
    __device__ __forceinline__ void run(AccRef acc, const Unit& u, int wr, int wc, int fr, int fq, const LAS unsigned char* slot) const {
        const int c0 = u.pn * BM + wc * 32 + 8 * fq, cl = wc * 32 + 8 * fq;
        FOLD_COLS_LDS_F()
        const unsigned bo = 2u * (unsigned)((u.pm * BM + wr * 64 + fr) * ldc + c0);
        EPI_ROWS_BEGIN  (void)r; FOLD_ROW()
#pragma unroll
            for (int bj = 0; bj < 2; ++bj) { f32x4 v0 = FOLDV(bj, 0), v1 = FOLDV(bj, 1);
#pragma unroll
                for (int j = 0; j < 4; ++j) { const float a = fmaxf(v0[j], 0.f), b = fmaxf(v1[j], 0.f); v0[j] = a * a; v1[j] = b * b; }
                *(u32x4*)((char*)O + (bo + 2u * (unsigned)((ai * HALF + m * 16) * ldc + bj * HALF))) = pack8(v0, v1); }  EPI_ROWS_END
    }
};
typedef EpiSqReluT<true> EpiSqRelu;
}

#define XB_TMO      128
#define XB_XCNT(j)  (256  + 64 * (j))
#define XB_XSUB(j)  (1280 + 64 * (j))
#define XB_XGEN(j)  (2304 + 64 * (j))
#define XB_TOP      3328
#define XB_TOPGEN   3392
#define XCD_BAR_WORDS 3456
#define XB_SPIN_CAP (1u << 22)
__device__ __forceinline__ unsigned xb_ld(unsigned* p)              { return __hip_atomic_load(p, __ATOMIC_RELAXED, __HIP_MEMORY_SCOPE_AGENT); }
__device__ __forceinline__ unsigned xb_add(unsigned* p, unsigned v) { return __hip_atomic_fetch_add(p, v, __ATOMIC_RELAXED, __HIP_MEMORY_SCOPE_AGENT); }
__device__ __forceinline__ unsigned xb_xcc_id() { return (unsigned)__builtin_amdgcn_s_getreg((3 << 11) | 20) & 0xFu; }
#define XB_SPIN(cond, bar) do { unsigned _sp = 0; while (cond) { __builtin_amdgcn_s_sleep(1); \
    if ((++_sp & 255u) == 0u) { if (xb_ld(&(bar)[XB_TMO])) break; if (_sp > XB_SPIN_CAP) { atomicAdd(&(bar)[XB_TMO], 1u); break; } } } } while (0)
struct XcdBarrier { unsigned* bar; unsigned x; volatile LAS unsigned* st; };
__device__ __forceinline__ XcdBarrier xcd_barrier_post(unsigned* bar, volatile LAS unsigned* st, bool leader) {
    XcdBarrier b; b.bar = bar; b.x = xb_xcc_id(); b.st = st;
    if (leader) (void)xb_add(&bar[XB_XCNT(b.x)], 1u);
    return b;
}
__device__ __forceinline__ void xcd_barrier_complete(unsigned* bar, unsigned x, unsigned& nloc, unsigned& nx) {
    const unsigned G = gridDim.x * gridDim.y * gridDim.z;
    unsigned sum, cnt, mine, sp = 0u;
    for (;;) {
        sum = 0u; cnt = 0u; mine = 0u;
#pragma unroll
        for (unsigned j = 0; j < 16; ++j) { const unsigned c = xb_ld(&bar[XB_XCNT(j)]); sum += c; cnt += (c > 0u) ? 1u : 0u; mine = (j == x) ? c : mine; }
        if (sum == G) break;
        __builtin_amdgcn_s_sleep(1);
        if ((++sp & 255u) == 0u) { if (xb_ld(&bar[XB_TMO])) break; if (sp > XB_SPIN_CAP) { atomicAdd(&bar[XB_TMO], 1u); break; } }
    }
    nloc = mine > 0u ? mine : 1u; nx = cnt > 0u ? cnt : 1u;
}
__device__ __forceinline__ void xcd_barrier(const XcdBarrier& b, bool leader) {
    asm volatile("s_waitcnt vmcnt(0)" ::: "memory");
    __syncthreads();
    if (leader) {
        unsigned* bar = b.bar;
        __builtin_amdgcn_s_waitcnt(0);
        unsigned nloc = b.st[0], nx = b.st[1];
        if (nloc == 0u) { xcd_barrier_complete(bar, b.x, nloc, nx); b.st[0] = nloc; b.st[1] = nx; }
        const unsigned old = xb_add(&bar[XB_XSUB(b.x)], 1u);
        const unsigned gen = old / nloc;
        if (old + 1u == (gen + 1u) * nloc) {
            __builtin_amdgcn_fence(__ATOMIC_RELEASE, "agent");
            asm volatile("s_waitcnt vmcnt(0)" ::: "memory");
            const unsigned og = xb_add(&bar[XB_TOP], 1u);
            const unsigned tg = og / nx;
            if (og + 1u == (tg + 1u) * nx) xb_add(&bar[XB_TOPGEN], 1u);
            else XB_SPIN(xb_ld(&bar[XB_TOPGEN]) == tg, bar);
            __builtin_amdgcn_fence(__ATOMIC_ACQUIRE, "agent");
            xb_add(&bar[XB_XGEN(b.x)], 1u);
            asm volatile("s_waitcnt vmcnt(0)" ::: "memory");
        } else {
            XB_SPIN(xb_ld(&bar[XB_XGEN(b.x)]) == gen, bar);
            __builtin_amdgcn_fence(__ATOMIC_ACQUIRE, "agent");
            asm volatile("s_waitcnt vmcnt(0)" ::: "memory");
        }
    }
    __syncthreads();
}

#define GB_CNT(g) (4096 + 64 * (g))
#define GB_GEN(g) (4608 + 64 * (g))
#define GB_FLAG   5120
__device__ __forceinline__ void group_barrier(unsigned* bar, bool leader) {
    asm volatile("s_waitcnt vmcnt(0)" ::: "memory");
    __syncthreads();
    if (leader) {
        const unsigned g = blockIdx.x & 7u, n = (gridDim.x + 7u - g) / 8u;
        const unsigned old = xb_add(&bar[GB_CNT(g)], 1u);
        const unsigned gen = old / n;
        if (old + 1u == (gen + 1u) * n) xb_add(&bar[GB_GEN(g)], 1u);
        else XB_SPIN(xb_ld(&bar[GB_GEN(g)]) == gen, bar);
        __builtin_amdgcn_fence(__ATOMIC_ACQUIRE, "agent");
        asm volatile("s_waitcnt vmcnt(0)" ::: "memory");
    }
    __syncthreads();
}

struct Args { const float* in[24]; float* out; unsigned char* ws; int lin_lo, lin_hi; };
typedef const __attribute__((address_space(4))) Args* CAP;
struct Frame {
    LAS unsigned char* lds; int tid, lane, wave, G, gw, NGW;
};
__device__ __forceinline__ int lane_id_opaque() { int l; asm volatile("v_mbcnt_lo_u32_b32 %0, -1, 0\n\tv_mbcnt_hi_u32_b32 %0, -1, %0" : "=v"(l)); return l; }
__device__ __forceinline__ float wave_sum(float v) {
#pragma unroll
    for (int o = 1; o < 64; o <<= 1) v += __shfl_xor(v, o);
    return v;
}
__device__ __forceinline__ void sincos_d(double x, double& s, double& c) {
    const double TWO_PI = 6.283185307179586476925286766559;
    const double n = __builtin_rint(x * (1.0 / TWO_PI)); const double r = x - n * TWO_PI, r2 = r * r;
    double ts = 1.0, tc = 1.0, ss = 1.0, cc = 1.0;
#pragma unroll 1
    for (int k = 1; k <= 14; ++k) { tc *= -r2 / (double)((2 * k - 1) * (2 * k)); ts *= -r2 / (double)((2 * k) * (2 * k + 1)); cc += tc; ss += ts; }
    s = ss * r; c = cc;
}

template <class RowMap>
__device__ __forceinline__ void transpose_item(const float* W, int K, int N, bf16_t* WT, const RowMap& rm, LAS float* scr, int item, int lane,
                                               const float* gam = nullptr, const float* bet = nullptr, float* cs = nullptr, float* bw = nullptr) {
    const int nblk = N / 32, kb = item / nblk, nb = item % nblk, k0 = 64 * kb, n0 = 32 * nb;
    const int r = lane >> 3, c4 = 4 * (lane & 7);
    f32x4 w[8];
#pragma unroll
    for (int i = 0; i < 8; ++i) w[i] = *(const f32x4*)(W + (size_t)(k0 + 8 * i + r) * N + n0 + c4);
    if (gam) {
        float gk[8], bk[8];
#pragma unroll
        for (int i = 0; i < 8; ++i) { gk[i] = gam[k0 + 8 * i + r]; bk[i] = bet[k0 + 8 * i + r]; }
        f32x4 acs = {0.f, 0.f, 0.f, 0.f}, abw = {0.f, 0.f, 0.f, 0.f};
#pragma unroll
        for (int i = 0; i < 8; ++i) { const int kk = 8 * i + r;
#pragma unroll
            for (int e = 0; e < 4; ++e) { const float gw = bf2f((unsigned short)f2bf(gk[i] * w[i][e])); scr[kk * 33 + c4 + e] = gw; acs[e] += gw; abw[e] += bk[i] * w[i][e]; } }
#pragma unroll
        for (int e = 0; e < 4; ++e) {
#pragma unroll
            for (int o = 8; o < 64; o <<= 1) { acs[e] += __shfl_xor(acs[e], o); abw[e] += __shfl_xor(abw[e], o); } }
        if (lane < 8) {
#pragma unroll
            for (int e = 0; e < 4; ++e) { const int rn = rm(n0 + c4 + e);
                __hip_atomic_fetch_add((int*)cs + rn, (int)rintf(acs[e] * 16777216.f), __ATOMIC_RELAXED, __HIP_MEMORY_SCOPE_AGENT); __hip_atomic_fetch_add((int*)bw + rn, (int)rintf(abw[e] * 16777216.f), __ATOMIC_RELAXED, __HIP_MEMORY_SCOPE_AGENT); } }
    } else {
#pragma unroll
        for (int i = 0; i < 8; ++i)
#pragma unroll
            for (int e = 0; e < 4; ++e) scr[(8 * i + r) * 33 + c4 + e] = w[i][e];
    }
    LDS_WAIT(); asm volatile("" ::: "memory");
    const int c = lane & 7;
#pragma unroll
    for (int j = 0; j < 4; ++j) { const int n = (lane >> 3) + 8 * j; const LAS float* s = scr + (8 * c) * 33 + n;
        u32x4 o; o.x = pk2(s[0 * 33], s[1 * 33]); o.y = pk2(s[2 * 33], s[3 * 33]); o.z = pk2(s[4 * 33], s[5 * 33]); o.w = pk2(s[6 * 33], s[7 * 33]);
        *(u32x4*)(WT + (size_t)rm(n0 + n) * K + k0 + 8 * c) = o; }
    LDS_WAIT(); asm volatile("" ::: "memory");
}
struct RowIdent { int off; __device__ __forceinline__ int operator()(int n) const { return n + off; } };
struct RowRope { __device__ __forceinline__ int operator()(int n) const { if (n >= MIXW + KVW) return n; const int d = n & 127, base = n - d; return base + (d < 64 ? 2 * d : 2 * (d - 64) + 1); } };
struct RowGlu { __device__ __forceinline__ int operator()(int n) const { const int e = n >= MIXW ? 1 : 0, cc = n - e * MIXW; return 8 * (cc >> 2) + 4 * e + (cc & 3); } };

__device__ __forceinline__ void cvt_rows(const Frame& F, const float* src, bf16_t* dst, size_t n8) {
    const size_t st = (size_t)F.G * 512;
    for (size_t i = (size_t)blockIdx.x * 512 + F.tid; i < n8; i += 4 * st) {
        f32x4 a[4], b[4];
#pragma unroll
        for (int u = 0; u < 4; ++u) { const size_t k = i + u * st < n8 ? i + u * st : i; a[u] = *(const f32x4*)(src + k * 8); b[u] = *(const f32x4*)(src + k * 8 + 4); }
#pragma unroll
        for (int u = 0; u < 4; ++u) if (i + u * st < n8) { u32x4 o; o.x = pk2(a[u][0], a[u][1]); o.y = pk2(a[u][2], a[u][3]); o.z = pk2(b[u][0], b[u][1]); o.w = pk2(b[u][2], b[u][3]);
            *(u32x4*)(dst + (i + u * st) * 8) = o; }
    }
}

__device__ __forceinline__ void phase_pr0(const Frame& F, CAP a) {
    unsigned char* ws = a->ws;
    bf16_t* XB = (bf16_t*)(ws + WS_XB);
    cvt_rows(F, a->in[0], XB, (size_t)MROWS_PROMPT * DM / 8);
    cvt_rows(F, a->in[1], XB + (size_t)MROWS_PROMPT * DM, (size_t)(MTOK - MROWS_PROMPT) * DM / 8);
    bf16_t* MEMB = (bf16_t*)(ws + WS_R1 + R1_MEMB);
    cvt_rows(F, a->in[2], MEMB, (size_t)8 * NMEM * DM / 8);
    cvt_rows(F, a->in[3], MEMB + (size_t)8 * NMEM * DM, (size_t)4 * NMEM * DM / 8);
    LAS float* scr = (LAS float*)(F.lds + F.wave * 16384);
    constexpr int I_MKV = (DM / 64) * (1024 / 32);
    for (int it = F.gw; it < 4 * I_MKV; it += F.NGW) { const int l = it / I_MKV, r = it % I_MKV;
        transpose_item(a->in[16] + (size_t)l * DM * 1024, DM, 1024, (bf16_t*)(ws + WS_R1 + R1_WMKV), RowIdent{l * 1024}, scr, r, F.lane); }
    float* rope = (float*)(ws + WS_ROPE);
    for (int i = blockIdx.x * 512 + F.tid; i < SEQ * 64; i += F.G * 512) { const int pos = i >> 6, f = i & 63;
        double inv = 1.0; const double rr = 0.86596432336006535;
        for (int k = 0; k < f; ++k) inv *= rr;
        double s, c; sincos_d((double)pos * inv, s, c); rope[2 * i] = (float)c; rope[2 * i + 1] = (float)s; }
    f32x2* POW = (f32x2*)(ws + WS_POW); f32x2* BBAR = (f32x2*)(ws + WS_BBAR);
    for (int i = blockIdx.x * 512 + F.tid; i < 2 * 2 * SSG * SSP; i += F.G * 512) {
        const int p = i & 63, gdj = i >> 6;
        const double lr = (double)a->in[5][i], li = (double)a->in[6][i];
        const double dt = (double)__expf(a->in[7][gdj]) ;
        double er; { const double x = lr * dt; double t = 1.0; er = 1.0;
#pragma unroll 1
            for (int k = 1; k <= 12; ++k) { t *= x / (double)k; er += t; } }
        double s1, c1; sincos_d(li * dt, s1, c1);
        const double br = er * c1, bi = er * s1;
        double pr = 1.0, pi_ = 0.0;
        for (int e = 0; e <= 16; ++e) { POW[(size_t)i * 17 + e] = (f32x2){(float)pr, (float)pi_}; const double nr = pr * br - pi_ * bi, ni = pr * bi + pi_ * br; pr = nr; pi_ = ni; }
        const double nr_ = br - 1.0, ni_ = bi, den = lr * lr + li * li; const double cr = (nr_ * lr + ni_ * li) / den, ci = (ni_ * lr - nr_ * li) / den;
        f32x4 brv[4], biv[4];
#pragma unroll
        for (int q = 0; q < 4; ++q) { brv[q] = *(const f32x4*)(a->in[8] + (size_t)i * 16 + 4 * q); biv[q] = *(const f32x4*)(a->in[9] + (size_t)i * 16 + 4 * q); }
#pragma unroll
        for (int c = 0; c < SSC; ++c) { const double b_r = (double)brv[c >> 2][c & 3], b_i = (double)biv[c >> 2][c & 3];
            BBAR[(size_t)i * 16 + c] = (f32x2){(float)(cr * b_r - ci * b_i), (float)(cr * b_i + ci * b_r)}; }
    }
}
__device__ __forceinline__ void phase_kt(const Frame& F, CAP a) {
    const f32x2* POW = (const f32x2*)(a->ws + WS_POW); const f32x2* BBAR = (const f32x2*)(a->ws + WS_BBAR); float* KT = (float*)(a->ws + WS_KT);
    for (int i = blockIdx.x * 512 + F.tid; i < 2 * 2 * SSG * 16 * 256; i += F.G * 512) {
        const int cp = i & 15, c = (i >> 4) & 15, tau = (i >> 8) & 15, gdj = i >> 12;
        const float* cre = a->in[10] + ((size_t)gdj * 16 + c) * 64; const float* cim = a->in[11] + ((size_t)gdj * 16 + c) * 64;
        float s = 0.f;
        for (int p = 0; p < SSP; ++p) { const f32x2 pw = POW[((size_t)gdj * 64 + p) * 17 + tau], bb = BBAR[((size_t)gdj * 64 + p) * 16 + cp];
            const float wr_ = pw.x * bb.x - pw.y * bb.y, wi_ = pw.x * bb.y + pw.y * bb.x;
            s += cre[p] * wr_ - cim[p] * wi_; }
        KT[i] = s;
    }
}
__device__ __forceinline__ void phase_wconv(const Frame& F, CAP a, int layer) {
    unsigned char* ws = a->ws; const int j = layer >> 1; const bool attn = layer & 1;
    LAS float* scr = (LAS float*)(F.lds + F.wave * 16384);
    float* csbw = (float*)(ws + WS_CSBW) + (size_t)layer * 32768;
    const int NIN = attn ? 3072 : 2048;
    const int I_IN = (DM / 64) * (NIN / 32), I_GLU = attn ? 0 : (MIXW / 64) * (3072 / 32), I_OUT = (DM / 64) * (DM / 32), I_F1 = (DM / 64) * (DFF / 32), I_F2 = (DFF / 64) * (DM / 32);
    const int NIT = I_IN + I_GLU + I_OUT + I_F1 + I_F2;
    for (int it = F.gw; it < NIT; it += F.NGW) {
        int r = it;
        if (r < I_IN) { const float* gp = layer > 0 ? a->in[22] + (size_t)(layer - 1) * DM : nullptr; const float* bp = layer > 0 ? a->in[23] + (size_t)(layer - 1) * DM : nullptr;
                        if (attn) transpose_item(a->in[14] + (size_t)j * DM * 3072, DM, 3072, (bf16_t*)(ws + WS_WIN), RowRope{}, scr, r, F.lane, gp, bp, csbw + 0, csbw + 8192);
                        else transpose_item(a->in[4] + (size_t)j * DM * DM, DM, DM, (bf16_t*)(ws + WS_WIN), RowIdent{0}, scr, r, F.lane, gp, bp, csbw + 0, csbw + 8192); continue; } r -= I_IN;
        if (r < I_GLU) { transpose_item(a->in[13] + (size_t)j * MIXW * 3072, MIXW, 3072, (bf16_t*)(ws + WS_WGLU), RowGlu{}, scr, r, F.lane); continue; } r -= I_GLU;
        if (r < I_OUT) { transpose_item(a->in[17] + (size_t)layer * DM * DM, DM, DM, (bf16_t*)(ws + WS_WOUT), RowIdent{0}, scr, r, F.lane); continue; } r -= I_OUT;
        if (r < I_F1) { transpose_item(a->in[20] + (size_t)layer * DM * DFF, DM, DFF, (bf16_t*)(ws + WS_WFF1), RowIdent{0}, scr, r, F.lane, a->in[18] + (size_t)layer * DM, a->in[19] + (size_t)layer * DM, csbw + 16384, csbw + 24576); continue; } r -= I_F1;
        transpose_item(a->in[21] + (size_t)layer * DFF * DM, DFF, DM, (bf16_t*)(ws + WS_WFF2), RowIdent{0}, scr, r, F.lane);
    }
    if (!attn) {
        const f32x2* POW = (const f32x2*)(ws + WS_POW) + (size_t)j * 2 * SSG * SSP * 17; const f32x2* BBAR = (const f32x2*)(ws + WS_BBAR) + (size_t)j * 2 * SSG * SSP * 16;
        const float* KT = (const float*)(ws + WS_KT) + (size_t)j * 2 * SSG * 4096;
        const float* CRE = a->in[10] + (size_t)j * 2 * SSG * 1024; const float* CIM = a->in[11] + (size_t)j * 2 * SSG * 1024; const float* DSK = a->in[12] + (size_t)j * MIXW;
        bf16_t* WG = (bf16_t*)(ws + WS_SWG); bf16_t* WY = (bf16_t*)(ws + WS_SWY);
        const int st = F.G * 512;
        for (int i0 = blockIdx.x * 512 + F.tid; i0 < SSG * 256 * 128; i0 += 4 * st) {
            unsigned o[4];
#pragma unroll
            for (int u = 0; u < 4; ++u) { const int i = i0 + u * st < SSG * 256 * 128 ? i0 + u * st : i0;
                const int k2 = (i & 127) * 2, n = (i >> 7) & 255, g = i >> 15; const int dir = n >> 7, comp = n & 1, p = (n & 127) >> 1, s = k2 >> 4, cp = k2 & 15;
                const int e = dir == 0 ? 15 - s : s; const size_t gd = (size_t)(dir * SSG + g) * 64 + p; const f32x2 pw = POW[gd * 17 + e];
                float v[2];
#pragma unroll
                for (int q = 0; q < 2; ++q) { const f32x2 bb = BBAR[gd * 16 + cp + q]; v[q] = comp == 0 ? pw.x * bb.x - pw.y * bb.y : pw.x * bb.y + pw.y * bb.x; }
                o[u] = pk2(v[0], v[1]); }
#pragma unroll
            for (int u = 0; u < 4; ++u) if (i0 + u * st < SSG * 256 * 128) *(unsigned*)(WG + (size_t)(i0 + u * st) * 2) = o[u];
        }
        for (int i0 = blockIdx.x * 512 + F.tid; i0 < SSG * 256 * 256; i0 += 4 * st) {
            unsigned o[4]; const int k2 = (i0 & 255) * 2;
            if (k2 < 256) { const int s = k2 >> 4, cp = k2 & 15;
#pragma unroll
                for (int u = 0; u < 4; ++u) { const int i = i0 + u * st < SSG * 256 * 256 ? i0 + u * st : i0; const int n = (i >> 8) & 255, g = i >> 16, t = n >> 4, c = n & 15;
                    const int df = t - s > 0 ? t - s : 0, db = s - t > 0 ? s - t : 0;
                    const f32x2 kf = *(const f32x2*)(KT + ((size_t)(0 * SSG + g) * 16 + df) * 256 + c * 16 + cp), kb = *(const f32x2*)(KT + ((size_t)(1 * SSG + g) * 16 + db) * 256 + c * 16 + cp);
                    const float dsk = DSK[g * 16 + c];
                    float v0 = 0.f, v1 = 0.f;
                    if (s <= t) { v0 += kf.x; v1 += kf.y; }
                    if (s >= t) { v0 += kb.x; v1 += kb.y; }
                    if (s == t && cp == c) v0 += dsk;
                    if (s == t && cp + 1 == c) v1 += dsk;
                    o[u] = pk2(v0, v1); }
            } else { const int dir = (k2 - 256) >> 7, p = ((k2 - 256) & 127) >> 1;
#pragma unroll
                for (int u = 0; u < 4; ++u) { const int i = i0 + u * st < SSG * 256 * 256 ? i0 + u * st : i0; const int n = (i >> 8) & 255, g = i >> 16, t = n >> 4, c = n & 15;
                    const int e = dir == 0 ? t + 1 : 16 - t;
                    const f32x2 pw = POW[((size_t)(dir * SSG + g) * 64 + p) * 17 + e]; const size_t ci = ((size_t)(dir * SSG + g) * 16 + c) * 64 + p; const float cr = CRE[ci], cim = CIM[ci];
                    o[u] = pk2(cr * pw.x - cim * pw.y, -(cr * pw.y + cim * pw.x)); }
            }
#pragma unroll
            for (int u = 0; u < 4; ++u) if (i0 + u * st < SSG * 256 * 256) *(unsigned*)(WY + (size_t)(i0 + u * st) * 2) = o[u];
        }
    }
}
__device__ __forceinline__ void phase_scan(const Frame& F, CAP a, int j) {
    unsigned char* ws = a->ws; const char* G = (const char*)(ws + WS_R1 + R1_G); char* UH = (char*)(ws + WS_R1 + R1_UH);
    const f32x2* POW = (const f32x2*)(ws + WS_POW) + (size_t)j * 2 * SSG * SSP * 17;
    for (int it = F.wave; ; it += NWAVES) { const int L = it * F.G + (int)blockIdx.x; if (L >= NBATCH * SSG) break;
        const int bg = (L % NBATCH) * SSG + L / NBATCH;
        const int g = bg % SSG, dir = F.lane >> 5, p0 = 2 * (F.lane & 31);
        const f32x2 la = POW[((size_t)(dir * SSG + g) * 64 + p0) * 17 + 16], lb = POW[((size_t)(dir * SSG + g) * 64 + p0 + 1) * 17 + 16];
        const char* gb = G + (size_t)bg * 131072; char* hb = UH + (size_t)bg * 262144 + 512;
        const int sg = dir == 0 ? 512 : -512, g0 = (dir == 0 ? 0 : 255 * 512) + 8 * F.lane, h0 = (dir == 0 ? 0 : 255 * 1024) + 8 * F.lane;
        float ar = 0.f, ai = 0.f, br = 0.f, bi = 0.f;
        u32x2 wa[16], wb[16];
#define SCAN_LOAD(w, kb) _Pragma("unroll") for (int i = 0; i < 16; ++i) w[i] = *(const u32x2*)(gb + (unsigned)(g0 + ((kb) + i) * sg));
#define SCAN_STEPS(w, kb) _Pragma("unroll") for (int i = 0; i < 16; ++i) { u32x2 o; o.x = pg8::cvt_pk_bf16(ar, ai); o.y = pg8::cvt_pk_bf16(br, bi); *(u32x2*)(hb + (unsigned)(h0 + ((kb) + i) * 2 * sg)) = o; \
            const float nar = la.x * ar - la.y * ai + bflo(w[i].x), nai = la.x * ai + la.y * ar + bfhi(w[i].x), nbr = lb.x * br - lb.y * bi + bflo(w[i].y), nbi = lb.x * bi + lb.y * br + bfhi(w[i].y); \
            ar = nar; ai = nai; br = nbr; bi = nbi; }
        SCAN_LOAD(wa, 0)
#pragma unroll 1
        for (int kb = 0; kb < 256; kb += 32) {
            SCAN_LOAD(wb, kb + 16)
            SCAN_STEPS(wa, kb)
            const int kn = kb + 32 < 256 ? kb + 32 : 240;
            SCAN_LOAD(wa, kn)
            SCAN_STEPS(wb, kb + 16)
        }
#undef SCAN_LOAD
#undef SCAN_STEPS
    }
}
__device__ __forceinline__ void phase_finalize(const Frame& F, const float* part, float* st, float* fx = nullptr) {
    if (fx) for (int i = blockIdx.x * 512 + F.tid; i < 16384; i += F.G * 512) fx[i] = (float)((const int*)fx)[i] * 5.9604644775390625e-08f;
    for (int r = blockIdx.x * 512 + F.tid; r < MTOK; r += F.G * 512) { const f32x4* p = (const f32x4*)(part + (size_t)r * 16); const f32x4 a0 = p[0], a1 = p[1], a2 = p[2], a3 = p[3];
        const float S = ((a0[0] + a0[2]) + (a1[0] + a1[2])) + ((a2[0] + a2[2]) + (a3[0] + a3[2])), Q = ((a0[1] + a0[3]) + (a1[1] + a1[3])) + ((a2[1] + a2[3]) + (a3[1] + a3[3]));
        const float mu = S * (1.0f / DM); *(f32x2*)(st + 2 * (size_t)r) = (f32x2){mu, 1.0f / sqrtf(Q * (1.0f / DM) - mu * mu + LN_EPS)}; }
}
__device__ __forceinline__ void phase_finalize_cls(const Frame& F, const float* part, float* st) {
    constexpr int RPC = MTOK / 8, TPH = MTOK / NSPLIT / 256 / 8;
    const int x = blockIdx.x & 7, rank = blockIdx.x >> 3, nrank = F.G >> 3;
    for (int t = rank * 512 + F.tid; t < RPC; t += nrank * 512) { const int pmi = t >> 8, r = ((pmi / TPH) * (MTOK / NSPLIT / 256) + x * TPH + pmi % TPH) * 256 + (t & 255);
        const f32x4* p = (const f32x4*)(part + (size_t)r * 16); const f32x4 a0 = p[0], a1 = p[1], a2 = p[2], a3 = p[3];
        const float S = ((a0[0] + a0[2]) + (a1[0] + a1[2])) + ((a2[0] + a2[2]) + (a3[0] + a3[2])), Q = ((a0[1] + a0[3]) + (a1[1] + a1[3])) + ((a2[1] + a2[3]) + (a3[1] + a3[3]));
        const float mu = S * (1.0f / DM); *(f32x2*)(st + 2 * (size_t)r) = (f32x2){mu, 1.0f / sqrtf(Q * (1.0f / DM) - mu * mu + LN_EPS)}; }
}
__device__ __forceinline__ void cvt_fold(const Frame& F, float* fx) { for (int i = blockIdx.x * 512 + F.tid; i < 16384; i += F.G * 512) fx[i] = (float)((const int*)fx)[i] * 5.9604644775390625e-08f; }
__device__ __forceinline__ void phase_ln_final(const Frame& F, const bf16_t* vb, float* out, const float* gam, const float* bet) {
    u32x4 wn[4];
#pragma unroll
    for (int q = 0; q < 4; ++q) wn[q] = ((const u32x4*)(vb + (size_t)(F.gw < MTOK ? F.gw : 0) * DM) + F.lane)[64 * q];
    for (int m = F.gw; m < MTOK; m += F.NGW) {
        u32x4 wc[4];
#pragma unroll
        for (int q = 0; q < 4; ++q) wc[q] = wn[q];
        { const int mn = m + F.NGW < MTOK ? m + F.NGW : m; const u32x4* vr = (const u32x4*)(vb + (size_t)mn * DM) + F.lane;
#pragma unroll
          for (int q = 0; q < 4; ++q) wn[q] = vr[64 * q]; }
        float v[4][8]; float s = 0.f;
#pragma unroll
        for (int q = 0; q < 4; ++q) { const u32x4 w = wc[q]; v[q][0] = bflo(w.x); v[q][1] = bfhi(w.x); v[q][2] = bflo(w.y); v[q][3] = bfhi(w.y); v[q][4] = bflo(w.z); v[q][5] = bfhi(w.z); v[q][6] = bflo(w.w); v[q][7] = bfhi(w.w);
#pragma unroll
            for (int e = 0; e < 8; ++e) s += v[q][e]; }
        const float mean = wave_sum(s) * (1.f / DM); float s2 = 0.f;
#pragma unroll
        for (int q = 0; q < 4; ++q)
#pragma unroll
            for (int e = 0; e < 8; ++e) { v[q][e] -= mean; s2 += v[q][e] * v[q][e]; }
        const float rstd = 1.f / sqrtf(wave_sum(s2) * (1.f / DM) + LN_EPS);
#pragma unroll
        for (int q = 0; q < 4; ++q) { const int c = (F.lane + 64 * q) * 8; float* o = out + (size_t)m * DM + c;
#pragma unroll
            for (int h = 0; h < 2; ++h) { const f32x4 gv = *(const f32x4*)(gam + c + 4 * h), bv = *(const f32x4*)(bet + c + 4 * h);
                *(f32x4*)(o + 4 * h) = (f32x4){v[q][4 * h] * rstd, v[q][4 * h + 1] * rstd, v[q][4 * h + 2] * rstd, v[q][4 * h + 3] * rstd} * gv + bv; } }
    }
}
namespace att {
typedef short s16x4 __attribute__((ext_vector_type(4)));
typedef float f32x16 __attribute__((ext_vector_type(16)));
constexpr float SCALE = 0.088388347648318440f;
constexpr int KVB = 64;
constexpr int SHM_K = KVB * HD * 2, SHM_V = KVB * HD * 2;
constexpr int OFF_V = 0, OFF_K = 2 * SHM_V, OFF_WS = 2 * SHM_V + 2 * SHM_K, OFF_OST = 0;
#define KSWZ(row, colB) ((row) * 256 + ((colB) ^ (((row) & 7) << 4)))
#define SBAR() __builtin_amdgcn_sched_barrier(0)
__device__ __forceinline__ int crow(int r, int hi) { return (r & 3) + 8 * (r >> 2) + 4 * hi; }
__device__ __forceinline__ unsigned cvtpk(float lo, float hi) { unsigned r; asm volatile("v_cvt_pk_bf16_f32 %0, %1, %2" : "=v"(r) : "v"(lo), "v"(hi)); return r; }
__device__ __forceinline__ void partialSM(f32x16& p0, f32x16& p1, float& m_reg, float& mn, float& alpha) {
  constexpr float C = SCALE * 1.4426950408889634f;
  float pmax = p0[0];
#pragma unroll
  for (int r = 1; r < 16; ++r) pmax = fmaxf(pmax, p0[r]);
#pragma unroll
  for (int r = 0; r < 16; ++r) pmax = fmaxf(pmax, p1[r]);
  { auto rr = __builtin_amdgcn_permlane32_swap(__float_as_uint(pmax), __float_as_uint(pmax), false, false);
    pmax = fmaxf(__uint_as_float(rr[0]), __uint_as_float(rr[1])); }
  if (__all(pmax <= m_reg)) { mn = m_reg; alpha = 1.f; }
  else { mn = fmaxf(m_reg, pmax); alpha = __builtin_amdgcn_exp2f((m_reg - mn) * C); m_reg = mn; }
  const float mnC = -mn * C;
#pragma unroll
  for (int r = 0; r < 16; ++r) p0[r] = __builtin_amdgcn_exp2f(fmaf(p0[r], C, mnC));
#pragma unroll
  for (int r = 0; r < 16; ++r) p1[r] = __builtin_amdgcn_exp2f(fmaf(p1[r], C, mnC));
}
__device__ __forceinline__ void finishSM(f32x16& p0, f32x16& p1, float alpha, float& l_reg, bf16x8& pa0, bf16x8& pa1, bf16x8& pa2, bf16x8& pa3) {
  float ps = 0;
#pragma unroll
  for (int r = 0; r < 16; ++r) ps += p0[r];
#pragma unroll
  for (int r = 0; r < 16; ++r) ps += p1[r];
  { auto rr = __builtin_amdgcn_permlane32_swap(__float_as_uint(ps), __float_as_uint(ps), false, false);
    ps = __uint_as_float(rr[0]) + __uint_as_float(rr[1]); }
  l_reg = l_reg * alpha + ps;
#define PK4(P, BASE, OUT) do { unsigned a0 = cvtpk(P[BASE + 0], P[BASE + 1]), a1 = cvtpk(P[BASE + 2], P[BASE + 3]);   \
    unsigned b0 = cvtpk(P[BASE + 4], P[BASE + 5]), b1 = cvtpk(P[BASE + 6], P[BASE + 7]);                              \
    auto r0 = __builtin_amdgcn_permlane32_swap(a0, b0, false, false); auto r1 = __builtin_amdgcn_permlane32_swap(a1, b1, false, false); \
    u32x4 w = {r0[0], r1[0], r0[1], r1[1]}; OUT = *reinterpret_cast<bf16x8*>(&w); } while (0)
  PK4(p0, 0, pa0); PK4(p0, 8, pa1); PK4(p1, 0, pa2); PK4(p1, 8, pa3);
#undef PK4
}
__device__ __forceinline__ void qkt(f32x16& p0, f32x16& p1, const LAS char* Ks, const bf16x8* qr, int r32, int hi) {
  p0 = f32x16{}; p1 = f32x16{};
#pragma unroll
  for (int d0 = 0; d0 < 8; ++d0) { const int cb = (d0 * 16 + hi * 8) * 2;
    const bf16x8 b0 = *reinterpret_cast<const LAS bf16x8*>(Ks + KSWZ(r32, cb));
    const bf16x8 b1 = *reinterpret_cast<const LAS bf16x8*>(Ks + KSWZ(32 + r32, cb));
    p0 = __builtin_amdgcn_mfma_f32_32x32x16_bf16(b0, qr[d0], p0, 0, 0, 0);
    p1 = __builtin_amdgcn_mfma_f32_32x32x16_bf16(b1, qr[d0], p1, 0, 0, 0); }
}
__device__ __forceinline__ int v_st(int k, int c) { const int kk = (k & ~0xC) | ((k & 4) << 1) | ((k & 8) >> 1); return ((kk >> 3) * 4 + (c >> 5)) * 512 + ((kk & 7) * 32 + (c & 31)) * 2; }
__device__ __forceinline__ int v_rd_base(int lane) { return ((lane & 3) << 3) | (((lane >> 2) & 3) << 6) | (((lane >> 4) & 1) << 5) | (((lane >> 5) & 1) << 8); }
constexpr int v_rd_off(int d0, int ks, int half) { return d0 * 512 + ks * 4096 + half * 2048; }
template <int OFF> __device__ __forceinline__ s16x4 tr_read(int vb) { s16x4 r; asm volatile("ds_read_b64_tr_b16 %0, %1 offset:%2" : "=&v"(r) : "v"(vb), "i"(OFF) : "memory"); return r; }
template <int D0> __device__ __forceinline__ void pv_one(f32x16& od, int vb, bf16x8 pa0, bf16x8 pa1, bf16x8 pa2, bf16x8 pa3) {
  const s16x4 l0 = tr_read<v_rd_off(D0, 0, 0)>(vb), h0 = tr_read<v_rd_off(D0, 0, 1)>(vb), l1 = tr_read<v_rd_off(D0, 1, 0)>(vb), h1 = tr_read<v_rd_off(D0, 1, 1)>(vb);
  const s16x4 l2 = tr_read<v_rd_off(D0, 2, 0)>(vb), h2 = tr_read<v_rd_off(D0, 2, 1)>(vb), l3 = tr_read<v_rd_off(D0, 3, 0)>(vb), h3 = tr_read<v_rd_off(D0, 3, 1)>(vb);
  asm volatile("s_waitcnt lgkmcnt(0)" ::: "memory"); SBAR();
#define PKV(L, H) (bf16x8){L[0], L[1], L[2], L[3], H[0], H[1], H[2], H[3]}
  od = __builtin_amdgcn_mfma_f32_32x32x16_bf16(pa0, PKV(l0, h0), od, 0, 0, 0);
  od = __builtin_amdgcn_mfma_f32_32x32x16_bf16(pa1, PKV(l1, h1), od, 0, 0, 0);
  od = __builtin_amdgcn_mfma_f32_32x32x16_bf16(pa2, PKV(l2, h2), od, 0, 0, 0);
  od = __builtin_amdgcn_mfma_f32_32x32x16_bf16(pa3, PKV(l3, h3), od, 0, 0, 0);
#undef PKV
}
__device__ __forceinline__ void mask_tile(f32x16& p0, f32x16& p1, int dq) {
  const float NEG = -__builtin_inff();
#pragma unroll
  for (int r = 0; r < 16; ++r) { const int c = (r & 3) + 8 * (r >> 2);
    if ((unsigned)(dq - c) >= 257u) p0[r] = NEG;
    if ((unsigned)(dq - c - 32) >= 257u) p1[r] = NEG; }
}
__device__ __forceinline__ void partialSM2(f32x16& p0, f32x16& p1, float& m_reg, float& mn, float& alpha) {
  float pmax = p0[0];
#pragma unroll
  for (int r = 1; r < 16; ++r) pmax = fmaxf(pmax, p0[r]);
#pragma unroll
  for (int r = 0; r < 16; ++r) pmax = fmaxf(pmax, p1[r]);
  { auto rr = __builtin_amdgcn_permlane32_swap(__float_as_uint(pmax), __float_as_uint(pmax), false, false);
    pmax = fmaxf(__uint_as_float(rr[0]), __uint_as_float(rr[1])); }
  constexpr float C2 = 1.4426950408889634f * SCALE;
  if (__builtin_expect(__all(pmax <= m_reg), 1)) { mn = m_reg; alpha = 1.f; }
  else { mn = fmaxf(m_reg, pmax); alpha = __builtin_amdgcn_exp2f((m_reg - mn) * C2); m_reg = mn; }
  const float mnL = -mn * C2;
#pragma unroll
  for (int r = 0; r < 16; ++r) p0[r] = fmaf(p0[r], C2, mnL);
#pragma unroll
  for (int r = 0; r < 16; ++r) p1[r] = fmaf(p1[r], C2, mnL);
#pragma unroll
  for (int r = 0; r < 16; ++r) p0[r] = __builtin_amdgcn_exp2f(p0[r]);
}
__device__ __forceinline__ void finishSM2(f32x16& p0, f32x16& p1, float alpha, float& l_reg, bf16x8& pa0, bf16x8& pa1, bf16x8& pa2, bf16x8& pa3) {
#pragma unroll
  for (int r = 0; r < 16; ++r) p1[r] = __builtin_amdgcn_exp2f(p1[r]);
  float ps = 0;
#pragma unroll
  for (int r = 0; r < 16; ++r) ps += p0[r];
#pragma unroll
  for (int r = 0; r < 16; ++r) ps += p1[r];
  { auto rr = __builtin_amdgcn_permlane32_swap(__float_as_uint(ps), __float_as_uint(ps), false, false);
    ps = __uint_as_float(rr[0]) + __uint_as_float(rr[1]); }
  l_reg = l_reg * alpha + ps;
#define PK4(P, B_, OUT) do { unsigned a0 = cvtpk(P[B_+0], P[B_+1]), a1 = cvtpk(P[B_+2], P[B_+3]);                          \
      unsigned b0 = cvtpk(P[B_+4], P[B_+5]), b1 = cvtpk(P[B_+6], P[B_+7]);                                             \
      auto r0 = __builtin_amdgcn_permlane32_swap(a0, b0, false, false); auto r1 = __builtin_amdgcn_permlane32_swap(a1, b1, false, false); \
      u32x4 w = {r0[0], r1[0], r0[1], r1[1]}; OUT = *reinterpret_cast<bf16x8*>(&w); } while (0)
  PK4(p0, 0, pa0); PK4(p0, 8, pa1); PK4(p1, 0, pa2); PK4(p1, 8, pa3);
#undef PK4
}
template <int KB, bool SK>
__device__ __forceinline__ void qkt2(f32x16& p0, f32x16& p1, const LAS char* K_lds, int r32, int hi, const bf16x8* qr, bool act) {
  if (SK && !act) { const float NEG = -__builtin_inff();
#pragma unroll
    for (int r = 0; r < 16; ++r) { p0[r] = NEG; p1[r] = NEG; } return; }
  p0 = f32x16{}; p1 = f32x16{};
  const LAS char* kb[4];
#pragma unroll
  for (int dd = 0; dd < 4; ++dd) kb[dd] = K_lds + KB * SHM_K + KSWZ(r32, (dd * 16 + hi * 8) * 2);
#pragma unroll
  for (int d0 = 0; d0 < 8; ++d0) { const LAS char* a = kb[d0 & 3] + (d0 >> 2) * 128;
    const bf16x8 b0 = *reinterpret_cast<const LAS bf16x8*>(a);
    const bf16x8 b1 = *reinterpret_cast<const LAS bf16x8*>(a + 32 * 256);
    p0 = __builtin_amdgcn_mfma_f32_32x32x16_bf16(b0, qr[d0], p0, 0, 0, 0);
    p1 = __builtin_amdgcn_mfma_f32_32x32x16_bf16(b1, qr[d0], p1, 0, 0, 0); }
}
template <int VB, bool SK>
__device__ __forceinline__ void pv_tile2(f32x16* o, int vb0, bf16x8 pa0, bf16x8 pa1, bf16x8 pa2, bf16x8 pa3, bool act) {
  if (SK && !act) return;
#define TRRD(dst, off) asm volatile("ds_read_b64_tr_b16 %0, %1 offset:%2" : "=&v"(dst) : "v"(vb0), "i"(off) : "memory")
#define PV_D0(d0) do { s16x4 l0, l1, l2, l3, h0, h1, h2, h3; constexpr int b_ = VB * SHM_V + v_rd_off(d0, 0, 0); \
      TRRD(l0, b_); TRRD(h0, b_ + 2048); TRRD(l1, b_ + 4096); TRRD(h1, b_ + 6144); TRRD(l2, b_ + 8192); TRRD(h2, b_ + 10240); TRRD(l3, b_ + 12288); TRRD(h3, b_ + 14336); \
      asm volatile("s_waitcnt lgkmcnt(0)" ::: "memory"); SBAR(); \
      o[d0] = __builtin_amdgcn_mfma_f32_32x32x16_bf16(pa0, (bf16x8){l0[0], l0[1], l0[2], l0[3], h0[0], h0[1], h0[2], h0[3]}, o[d0], 0, 0, 0);   \
      o[d0] = __builtin_amdgcn_mfma_f32_32x32x16_bf16(pa1, (bf16x8){l1[0], l1[1], l1[2], l1[3], h1[0], h1[1], h1[2], h1[3]}, o[d0], 0, 0, 0);   \
      o[d0] = __builtin_amdgcn_mfma_f32_32x32x16_bf16(pa2, (bf16x8){l2[0], l2[1], l2[2], l2[3], h2[0], h2[1], h2[2], h2[3]}, o[d0], 0, 0, 0);   \
      o[d0] = __builtin_amdgcn_mfma_f32_32x32x16_bf16(pa3, (bf16x8){l3[0], l3[1], l3[2], l3[3], h3[0], h3[1], h3[2], h3[3]}, o[d0], 0, 0, 0); } while (0)
  PV_D0(0); PV_D0(1); PV_D0(2); PV_D0(3);
#undef PV_D0
#undef TRRD
}
struct Seam { bf16x8 qr[8]; bf16x8 st_v0, st_v1, st_k0, st_k1; };
constexpr int OFF2_V = 0, OFF2_K = 2 * SHM_V, OFF2_WS = 2 * SHM_V + 2 * SHM_K, OFF2_OST = OFF2_WS + 8 * 256;
template <bool WIN, int LDQ, int LDK, int LDO, class Gen>
__device__ __forceinline__ void attn_units(LAS char* lds, int wid, int lane, const Gen& G, int u0, int ustride, int ucount) {
  if (u0 >= ucount) return;
  constexpr bool SK = WIN;
  const int tid = wid * 64 + lane, r32 = lane & 31, hi = lane >> 5;
  LAS char* V_lds = lds + OFF2_V; LAS char* K_lds = lds + OFF2_K;
  LAS float* wsf = (LAS float*)(lds + OFF2_WS) + wid * 64; LAS float* li_l = wsf; LAS float* al_l = wsf + 32;
  LAS char* ost = lds + OFF2_OST + wid * 4096;
  const int sr = tid >> 4, sc = (tid & 15) * 8, vst0 = v_st(sr, sc), vst1 = v_st(32 + sr, sc), kws = KSWZ(sr, sc * 2);
  const int vb0 = (int)(unsigned)(size_t)V_lds + v_rd_base(lane);
  const unsigned kvo0 = (unsigned)((sr * LDK + sc) * 2), kvo1 = (unsigned)(((32 + sr) * LDK + sc) * 2), qo = (unsigned)((((wid * 32 + r32) * LDQ) + hi * 8) * 2);
  Seam S;
#define VMW() asm volatile("s_waitcnt vmcnt(0)" ::: "memory")
#define VMWN(n) asm volatile("s_waitcnt vmcnt(%0)" :: "i"(n) : "memory")
#define SLOAD_H(Kp, Vp, k0) do { const char* kb_ = (const char*)((Kp) + (size_t)(k0) * LDK); const char* vb_ = (const char*)((Vp) + (size_t)(k0) * LDK);     \
                                 S.st_v0 = *(const bf16x8*)(vb_ + kvo0); S.st_v1 = *(const bf16x8*)(vb_ + kvo1); S.st_k0 = *(const bf16x8*)(kb_ + kvo0); S.st_k1 = *(const bf16x8*)(kb_ + kvo1); } while (0)
#define SWRITE_HK(bf) do { *(LAS bf16x8*)(K_lds + (bf) * SHM_K + kws) = S.st_k0; *(LAS bf16x8*)(K_lds + (bf) * SHM_K + kws + 32 * 256) = S.st_k1; } while (0)
#define SWRITE_HV(bf) do { *(LAS bf16x8*)(V_lds + (bf) * SHM_V + vst0) = S.st_v0; *(LAS bf16x8*)(V_lds + (bf) * SHM_V + vst1) = S.st_v1; } while (0)
#define SWRITE_H(bf) do { SWRITE_HV(bf); SWRITE_HK(bf); } while (0)
#define LOADQ(P) do { const char* qb_ = (const char*)G.qb(P); _Pragma("unroll") for (int d0 = 0; d0 < 8; ++d0) S.qr[d0] = *(const bf16x8*)(qb_ + qo + d0 * 32); } while (0)
#define UMAP(uu) ((ucount % 8 == 0 && ustride % 8 == 0) ? (((uu) % ustride) & 7) * (ucount / 8) + ((uu) / ustride) * (ustride / 8) + (((uu) % ustride) >> 3) : (uu))
  int c = __builtin_amdgcn_readfirstlane(UMAP(u0));
  { LOADQ(c); const int kb0 = G.t_lo(c) * KVB; SLOAD_H(G.kh(c), G.vh(c), kb0); VMW(); SWRITE_HK(0); }
  __syncthreads();
  for (int u = u0; u < ucount; u += ustride) {
    const bool has_next = u + ustride < ucount; const int n = __builtin_amdgcn_readfirstlane(has_next ? UMAP(u + ustride) : c);
    const int j_lo = G.t_lo(c), NT = G.t_hi(c) - j_lo;
    const int kbn = G.t_lo(n) * KVB;
    const int qlo = G.qpos0(c) + wid * 32, qm = qlo + r32 - 4 * hi + 128;
    float m_reg = G.m_init(c), l_reg = G.l_init(); f32x16 o[4] = {};
    const bf16_t* Kh = G.kh(c); const bf16_t* Vh = G.vh(c);
#define RESC(a) do { if (__any((a) < 1.f)) { if (hi == 0) al_l[r32] = (a); asm volatile("s_waitcnt lgkmcnt(0)" ::: "memory");              \
                     _Pragma("unroll") for (int d_ = 0; d_ < 4; ++d_) _Pragma("unroll") for (int r = 0; r < 16; ++r) o[d_][r] *= al_l[crow(r, hi)]; } } while (0)
#define KBASE(t) ((j_lo + (t)) * KVB)
#define ACT(t) (!WIN || (KBASE(t) <= qlo + 31 + 128 && KBASE(t) + KVB - 1 >= qlo - 128))
#define MASKT(P0_, P1_, t) do { if (WIN) { const int kb_ = KBASE(t); if (ACT(t) && !(kb_ >= qlo - 97 && kb_ <= qlo + 65)) mask_tile(P0_, P1_, qm - kb_); } } while (0)
#define SEAM_K0() do { VMWN(8); SWRITE_HK(0); SBAR(); } while (0)
    f32x16 pA0, pA1, pB0, pB1; float mnA, mnB, alA, alB; bf16x8 pa0, pa1, pa2, pa3;
    SWRITE_HV(0); SBAR();
    if (NT > 1) SLOAD_H(Kh, Vh, KBASE(1));
    SBAR(); qkt2<0, SK>(pA0, pA1, K_lds, r32, hi, S.qr, ACT(0));
    MASKT(pA0, pA1, 0); partialSM2(pA0, pA1, m_reg, mnA, alA);
    if (NT > 1) { VMW(); SWRITE_H(1); }
    __syncthreads();
#define HALF_STEP(PX0, PX1, mnX, alX, PY0, PY1, alY, t, KB, VB, SB) do {                                                      \
        SBAR(); qkt2<KB, SK>(PX0, PX1, K_lds, r32, hi, S.qr, ACT(t));                                                         \
        finishSM2(PY0, PY1, alY, l_reg, pa0, pa1, pa2, pa3); SBAR();                                                          \
        if ((t) + 1 < NT) { SLOAD_H(Kh, Vh, KBASE((t) + 1)); SBAR(); }                                                        \
        pv_tile2<VB, SK>(o, vb0, pa0, pa1, pa2, pa3, ACT((t) - 1)); MASKT(PX0, PX1, (t)); partialSM2(PX0, PX1, m_reg, mnX, alX); \
        __syncthreads();                                                                                                      \
        if ((t) + 1 < NT) { VMW(); SWRITE_H(SB); }                                                                            \
        RESC(alX); __syncthreads(); } while (0)
    for (int t = 1; t + 1 < NT; t += 2) {
      HALF_STEP(pB0, pB1, mnB, alB, pA0, pA1, alA, t, 1, 0, 0);
      HALF_STEP(pA0, pA1, mnA, alA, pB0, pB1, alB, t + 1, 0, 1, 1);
    }
    const bool even = (NT & 1) == 0;
    if (even) { SBAR(); qkt2<1, SK>(pB0, pB1, K_lds, r32, hi, S.qr, ACT(NT - 1)); SBAR(); }
    SLOAD_H(G.kh(n), G.vh(n), kbn); SBAR();
    LOADQ(n);
    SBAR();
    finishSM2(pA0, pA1, alA, l_reg, pa0, pa1, pa2, pa3); SBAR();
    pv_tile2<0, SK>(o, vb0, pa0, pa1, pa2, pa3, ACT(even ? NT - 2 : NT - 1));
    if (even) { MASKT(pB0, pB1, NT - 1); partialSM2(pB0, pB1, m_reg, mnB, alB); __syncthreads(); RESC(alB);
      finishSM2(pB0, pB1, alB, l_reg, pa0, pa1, pa2, pa3); SBAR(); pv_tile2<1, SK>(o, vb0, pa0, pa1, pa2, pa3, ACT(NT - 1)); }
    SBAR(); SEAM_K0();
    if (hi == 0) li_l[r32] = l_reg; asm volatile("s_waitcnt lgkmcnt(0)" ::: "memory");
    char* obase = (char*)(G.ob(c) + (size_t)(wid * 32) * LDO); const unsigned loff = (unsigned)(((lane >> 4) * LDO + (lane & 15) * 8) * 2);
#pragma unroll
    for (int hf = 0; hf < 2; ++hf) {
#pragma unroll
      for (int rr = 0; rr < 8; ++rr) { const int r = hf * 8 + rr; const int orow = crow(r, hi); const float rl = __builtin_amdgcn_rcpf(li_l[orow]);
#pragma unroll
        for (int d0 = 0; d0 < 4; ++d0) *(LAS unsigned short*)(ost + (orow & 15) * 256 + (d0 * 32 + r32) * 2) = (unsigned short)f2bf(o[d0][r] * rl); }
      asm volatile("s_waitcnt lgkmcnt(0)" ::: "memory");
#pragma unroll
      for (int i = 0; i < 4; ++i) { const int ch = i * 64 + lane, row = ch >> 4, c16 = ch & 15;
        const u32x4 v = *(const LAS u32x4*)(ost + row * 256 + c16 * 16); *(u32x4*)(obase + (size_t)((hf * 16 + i * 4) * LDO * 2) + loff) = v; }
      asm volatile("s_waitcnt lgkmcnt(0)" ::: "memory");
    }
    __syncthreads();
    c = n;
#undef RESC
#undef KBASE
#undef ACT
#undef MASKT
#undef SEAM_K0
#undef HALF_STEP
  }
#undef VMW
#undef VMWN
#undef SLOAD_H
#undef SWRITE_HK
#undef SWRITE_HV
#undef SWRITE_H
#undef LOADQ
#undef UMAP
}
#undef KSWZ
#undef SBAR
}
struct GenWin {
    const bf16_t* Q; const bf16_t* Kb; const bf16_t* Vb; bf16_t* O; const float* sink;
    __device__ __forceinline__ int qblk(int u) const { return (u / 3) & 15; }
    __device__ __forceinline__ int head(int u) const { return ((u / 48) & 3) * 3 + u % 3; }
    __device__ __forceinline__ size_t row0(int u) const { return (size_t)(u / 192) * SEQ + 256 * qblk(u); }
    __device__ __forceinline__ const bf16_t* qb(int u) const { return Q + row0(u) * MIXW + head(u) * HD; }
    __device__ __forceinline__ const bf16_t* kh(int u) const { return Kb + (size_t)(u / 192) * SEQ * KVW + ((u / 48) & 3) * HD; }
    __device__ __forceinline__ const bf16_t* vh(int u) const { return Vb + (size_t)(u / 192) * SEQ * KVW + ((u / 48) & 3) * HD; }
    __device__ __forceinline__ bf16_t* ob(int u) const { return O + row0(u) * DM + head(u) * HD; }
    __device__ __forceinline__ int t_lo(int u) const { const int q = qblk(u); return 4 * q - 2 < 0 ? 0 : 4 * q - 2; }
    __device__ __forceinline__ int t_hi(int u) const { const int q = qblk(u); return 4 * q + 6 > 64 ? 64 : 4 * q + 6; }
    __device__ __forceinline__ int qpos0(int u) const { return 256 * qblk(u); }
    __device__ __forceinline__ float m_init(int u) const { return sink[head(u)] * (1.0f / att::SCALE); }
    __device__ __forceinline__ float l_init() const { return 1.0f; }
};
__device__ __forceinline__ void phase_attn_mfma(const Frame& F, CAP a, int jl) {
    unsigned char* ws = a->ws;
    const GenWin G{(const bf16_t*)(ws + WS_R1 + R1_Q), (const bf16_t*)(ws + WS_R1 + R1_K), (const bf16_t*)(ws + WS_R1 + R1_V), (bf16_t*)(ws + WS_R1 + R1_CONCAT), a->in[15] + (size_t)jl * NQH};
    att::attn_units<true, MIXW, KVW, DM>((LAS char*)F.lds, F.wave, F.lane, G, (int)blockIdx.x, F.G, NBATCH * NQH * 16);
}
struct GenMem {
    const bf16_t* QM; const bf16_t* KV; bf16_t* O; int layer;
    __device__ __forceinline__ size_t row0(int u) const { return (size_t)(u >> 6) * SEQ + 256 * (u & 15); }
    __device__ __forceinline__ const bf16_t* qb(int u) const { return QM + row0(u) * MEMW + ((u >> 4) & 3) * HD; }
    __device__ __forceinline__ const bf16_t* kh(int u) const { return KV + (size_t)(u >> 6) * NMEM * 4096 + layer * 1024 + ((u >> 4) & 3) * HD; }
    __device__ __forceinline__ const bf16_t* vh(int u) const { return kh(u) + 512; }
    __device__ __forceinline__ bf16_t* ob(int u) const { return O + row0(u) * DM + MIXW + ((u >> 4) & 3) * HD; }
    __device__ __forceinline__ int t_lo(int) const { return 0; }
    __device__ __forceinline__ int t_hi(int) const { return 4; }
    __device__ __forceinline__ int qpos0(int) const { return 0; }
    __device__ __forceinline__ float m_init(int) const { return -1e30f; }
    __device__ __forceinline__ float l_init() const { return 0.f; }
};
__device__ __forceinline__ void phase_memattn_mfma(const Frame& F, CAP a, int layer, bf16_t* O) {
    unsigned char* ws = a->ws;
    const GenMem G{(const bf16_t*)(ws + WS_R1 + R1_QM), (const bf16_t*)(ws + WS_MEMKV), O, layer};
    att::attn_units<false, MEMW, 4096, DM>((LAS char*)F.lds, F.wave, F.lane, G, (int)blockIdx.x, F.G, NBATCH * 4 * 16);
}

__device__ __forceinline__ CAP get_args() { CAP p = (CAP)__builtin_amdgcn_kernarg_segment_ptr(); asm volatile("" : "+s"(p)); return p; }
__device__ __forceinline__ bool run_ok(int id) { CAP a = get_args(); return a->lin_lo <= id && id < a->lin_hi; }
__device__ __forceinline__ Frame make_frame(unsigned char* lds_raw, int wave_s) {
    Frame F; const int l_ = lane_id_opaque();
    F.lds = (LAS unsigned char*)lds_raw; F.lane = l_; F.wave = wave_s; F.tid = wave_s * 64 + l_;
    F.G = gridDim.x; F.gw = blockIdx.x * NWAVES + F.wave; F.NGW = F.G * NWAVES; return F;
}
__global__ void __launch_bounds__(NWAVES * 64, 2) mk_fwd(Args args_unused) {
    extern __shared__ __attribute__((aligned(16))) unsigned char lds_raw[];
    int wave_s = __builtin_amdgcn_readfirstlane((int)threadIdx.x >> 6); asm volatile("" : "+s"(wave_s));
    { const int t = wave_s * 64 + lane_id_opaque(); for (int u = t; u < (LDS_BYTES - LDSCTL_OFF) / 4; u += NWAVES * 64) ((LAS unsigned*)((LAS unsigned char*)lds_raw + LDSCTL_OFF))[u] = 0u; }
    __syncthreads();
#if !MK_MULTI
    { CAP a = get_args(); if (wave_s == 0 && lane_id_opaque() == 0 && xb_xcc_id() != (blockIdx.x & 7u)) (void)xb_add((unsigned*)(a->ws + WS_CTL) + CW_BAR + GB_FLAG, 1u); }
    { CAP a = get_args(); (void)xcd_barrier_post((unsigned*)(a->ws + WS_CTL) + CW_BAR, (volatile LAS unsigned*)((LAS unsigned char*)lds_raw + MISC_OFF) + 8, wave_s == 0 && lane_id_opaque() == 0); }
#define SEAM() do { CAP a_ = get_args(); XcdBarrier bar_; bar_.bar = (unsigned*)(a_->ws + WS_CTL) + CW_BAR; bar_.x = xb_xcc_id(); bar_.st = (volatile LAS unsigned*)((LAS unsigned char*)lds_raw + MISC_OFF) + 8; xcd_barrier(bar_, wave_s == 0 && lane_id_opaque() == 0); } while (0)
#define GSEAM() do { CAP a_ = get_args(); unsigned* gb_ = (unsigned*)(a_->ws + WS_CTL) + CW_BAR; \
        const bool fast_ = (gridDim.x & 7u) == 0u && (MTOK / NSPLIT / pg8::BM / pg8::WGM) % pg8::NXCD == 0 && __builtin_amdgcn_readfirstlane(xb_ld(&gb_[GB_FLAG])) == 0u; \
        if (fast_) group_barrier(gb_, wave_s == 0 && lane_id_opaque() == 0); else SEAM(); } while (0)
#else
#define SEAM() do {} while (0)
#define GSEAM() do {} while (0)
#endif
#define CLS_OK ((gridDim.x & 7u) == 0u && (MTOK / NSPLIT / pg8::BM / pg8::WGM) % pg8::NXCD == 0 && (MTOK / pg8::BM / pg8::WGM) % (pg8::NXCD * NSPLIT) == 0)
#define RUN(id) run_ok(id)
#define PH() CAP a = get_args(); Frame F = make_frame(lds_raw, wave_s); unsigned char* const ws = a->ws; (void)ws; (void)F
#define STATS(which) ((float*)(ws + WS_STATS) + (size_t)(which) * MTOK * 2)
#define PARTP ((float*)(ws + WS_PART))
#define CSBW(l) ((float*)(ws + WS_CSBW) + (size_t)(l) * 32768)

    if (RUN(0)) { PH(); phase_pr0(F, a); } SEAM();
    if (RUN(1)) {
        { PH();
        pg8::GemmPlain g{(const bf16_t*)(ws + WS_R1 + R1_MEMB), (const bf16_t*)(ws + WS_R1 + R1_WMKV), DM, DM};
        pg8::StaticOrder S; S.init(NMEMROWS, 4096, F.G, (int)blockIdx.x);
        pg8::EpiPlainBf16 E{(bf16_t*)(ws + WS_MEMKV), 4096};
        pg8::gemm_phase(F.lds, F.wave, g, S, E); }
        { PH(); phase_kt(F, a); }
    } SEAM();

    { constexpr int layer = 0; constexpr int base = 2 + 32 * layer; constexpr bool attn = layer & 1; constexpr int j = layer >> 1; (void)j;

                if constexpr (layer == 0) { if (RUN(base + 0)) { PH(); phase_wconv(F, a, layer); } SEAM(); }
        if constexpr (!attn) {
                    if (RUN(base + 1)) { PH();
                cvt_fold(F, CSBW(layer) + 16384);
                pg8::GemmPlain g{(const bf16_t*)(ws + WS_XB), (const bf16_t*)(ws + WS_WIN), DM, DM}; pg8::StaticOrder S; S.init(MTOK, 2048, F.G, (int)blockIdx.x);
                pg8::EpiInSsm<(layer > 0)> E{(bf16_t*)(ws + WS_R1 + R1_UH), (bf16_t*)(ws + WS_R1 + R1_QM), pg8::Fold{STATS(1), CSBW(layer), CSBW(layer) + 8192}};
                pg8::gemm_phase(F.lds, F.wave, g, S, E);
            } SEAM();
        if (RUN(base + 2)) {
            { PH();
                pg8::GemmSsm g{(const bf16_t*)(ws + WS_R1 + R1_UH), (const bf16_t*)(ws + WS_SWG), 256, 512}; pg8::SsmOrder S{F.G, (int)blockIdx.x};
                pg8::EpiG1 E{(bf16_t*)(ws + WS_R1 + R1_G)};
                pg8::gemm_phase(F.lds, F.wave, g, S, E); }
            __builtin_amdgcn_fence(__ATOMIC_ACQUIRE, "agent");
            { PH(); phase_scan(F, a, j); }
            asm volatile("s_waitcnt vmcnt(0)" ::: "memory"); __syncthreads(); __builtin_amdgcn_fence(__ATOMIC_ACQUIRE, "agent");
            { PH();
                pg8::GemmSsm g{(const bf16_t*)(ws + WS_R1 + R1_UH), (const bf16_t*)(ws + WS_SWY), 512, 512}; pg8::SsmOrder S{F.G, (int)blockIdx.x};
                pg8::EpiG2 E{(bf16_t*)(ws + WS_R1 + R1_Z)};
                pg8::gemm_phase(F.lds, F.wave, g, S, E); }
        } SEAM();
            constexpr size_t ZOFF = WS_R1 + R1_Z, CCOFF = WS_R1 + R1_CONCAT;
                    if (RUN(base + 5)) {
                { PH();
                pg8::GemmPlain g{(const bf16_t*)(ws + ZOFF), (const bf16_t*)(ws + WS_WGLU), MIXW, MIXW}; pg8::StaticOrder S; S.init(MTOK, 3072, F.G, (int)blockIdx.x);
                pg8::EpiGlu E{(bf16_t*)(ws + CCOFF)};
                pg8::gemm_phase(F.lds, F.wave, g, S, E); }
                { PH(); phase_memattn_mfma(F, a, layer, (bf16_t*)(ws + CCOFF)); }
            } SEAM();
                    if (RUN(base + 6)) { PH();
                pg8::GemmPlain g{(const bf16_t*)(ws + CCOFF), (const bf16_t*)(ws + WS_WOUT), DM, DM}; pg8::StaticOrder S; S.init(MTOK, DM, F.G, (int)blockIdx.x); S.ffn = CLS_OK;
                if constexpr (layer == 0) { pg8::EpiResidB<0> E{a->in[0], a->in[1], MROWS_PROMPT, nullptr, nullptr, nullptr, (bf16_t*)(ws + WS_XB), PARTP, 0, F.lds};
                    pg8::gemm_phase(F.lds, F.wave, g, S, E); }
                else { constexpr int lp = layer > 0 ? layer - 1 : 0; pg8::EpiResidB<1> E{nullptr, nullptr, 0, STATS(1), a->in[22] + (size_t)lp * DM, a->in[23] + (size_t)lp * DM, (bf16_t*)(ws + WS_XB), PARTP, 0, F.lds};
                    pg8::gemm_phase(F.lds, F.wave, g, S, E); }
            } if (CLS_OK) GSEAM(); else SEAM();
            if (RUN(base + 7)) { PH(); if (CLS_OK) phase_finalize_cls(F, PARTP, STATS(0)); else phase_finalize(F, PARTP, STATS(0)); } if (CLS_OK) GSEAM(); else SEAM();
        } else {
                    if (RUN(base + 1)) { PH();
                cvt_fold(F, CSBW(layer) + 16384);
                pg8::GemmPlain g{(const bf16_t*)(ws + WS_XB), (const bf16_t*)(ws + WS_WIN), DM, DM}; pg8::StaticOrder S; S.init(MTOK, 3072, F.G, (int)blockIdx.x);
                pg8::EpiInAttn<true> E{ws + WS_R1, (const float*)(ws + WS_ROPE), pg8::Fold{STATS(1), CSBW(layer), CSBW(layer) + 8192}};
                pg8::gemm_phase(F.lds, F.wave, g, S, E);
            } SEAM();
                    if (RUN(base + 2)) { { PH(); phase_attn_mfma(F, a, j); } { PH(); phase_memattn_mfma(F, a, layer, (bf16_t*)(ws + WS_R1 + R1_CONCAT)); } } SEAM();
                    if (RUN(base + 6)) { PH();
                pg8::GemmPlain g{(const bf16_t*)(ws + WS_R1 + R1_CONCAT), (const bf16_t*)(ws + WS_WOUT), DM, DM}; pg8::StaticOrder S; S.init(MTOK, DM, F.G, (int)blockIdx.x); S.ffn = CLS_OK;
                constexpr int lp = layer > 0 ? layer - 1 : 0; pg8::EpiResidB<1> E{nullptr, nullptr, 0, STATS(1), a->in[22] + (size_t)lp * DM, a->in[23] + (size_t)lp * DM, (bf16_t*)(ws + WS_XB), PARTP, 0, F.lds};
                pg8::gemm_phase(F.lds, F.wave, g, S, E);
            } if (CLS_OK) GSEAM(); else SEAM();
            if (RUN(base + 7)) { PH(); if (CLS_OK) phase_finalize_cls(F, PARTP, STATS(0)); else phase_finalize(F, PARTP, STATS(0)); } if (CLS_OK) GSEAM(); else SEAM();
        }

        { constexpr int half = 0; constexpr int roff = half * (MTOK / NSPLIT);

                        if (RUN(base + 8 + 2 * half)) { PH();
                pg8::GemmPlain g{(const bf16_t*)(ws + WS_XB) + (size_t)roff * DM, (const bf16_t*)(ws + WS_WFF1), DM, DM}; pg8::StaticOrder S; S.init(MTOK / NSPLIT, DFF, F.G, (int)blockIdx.x);
                pg8::EpiSqRelu E{(bf16_t*)(ws + WS_R1 + R1_H), DFF, pg8::Fold{STATS(0) + 2 * (size_t)roff, CSBW(layer) + 16384, CSBW(layer) + 24576}};
                pg8::gemm_phase(F.lds, F.wave, g, S, E);
            } GSEAM();
                        if (RUN(base + 9 + 2 * half)) { PH();
                pg8::GemmPlain g{(const bf16_t*)(ws + WS_R1 + R1_H), (const bf16_t*)(ws + WS_WFF2), DFF, DFF}; pg8::StaticOrder S; S.init(MTOK / NSPLIT, DM, F.G, (int)blockIdx.x);
                pg8::EpiResidB<1> E{nullptr, nullptr, 0, STATS(0), a->in[18] + (size_t)layer * DM, a->in[19] + (size_t)layer * DM, (bf16_t*)(ws + WS_XB), PARTP, roff, F.lds};
                pg8::gemm_phase(F.lds, F.wave, g, S, E);
            } if constexpr (half + 1 < NSPLIT) GSEAM(); else SEAM();
                }
        { constexpr int half = 1; constexpr int roff = half * (MTOK / NSPLIT);

                        if (RUN(base + 8 + 2 * half)) { PH();
                pg8::GemmPlain g{(const bf16_t*)(ws + WS_XB) + (size_t)roff * DM, (const bf16_t*)(ws + WS_WFF1), DM, DM}; pg8::StaticOrder S; S.init(MTOK / NSPLIT, DFF, F.G, (int)blockIdx.x);
                pg8::EpiSqRelu E{(bf16_t*)(ws + WS_R1 + R1_H), DFF, pg8::Fold{STATS(0) + 2 * (size_t)roff, CSBW(layer) + 16384, CSBW(layer) + 24576}};
                pg8::gemm_phase(F.lds, F.wave, g, S, E);
            } GSEAM();
                        if (RUN(base + 9 + 2 * half)) { PH();
                pg8::GemmPlain g{(const bf16_t*)(ws + WS_R1 + R1_H), (const bf16_t*)(ws + WS_WFF2), DFF, DFF}; pg8::StaticOrder S; S.init(MTOK / NSPLIT, DM, F.G, (int)blockIdx.x);
                pg8::EpiResidB<1> E{nullptr, nullptr, 0, STATS(0), a->in[18] + (size_t)layer * DM, a->in[19] + (size_t)layer * DM, (bf16_t*)(ws + WS_XB), PARTP, roff, F.lds};
                pg8::gemm_phase(F.lds, F.wave, g, S, E);
            } if constexpr (half + 1 < NSPLIT) GSEAM(); else SEAM();
                }
            if constexpr (layer < 3) { if (RUN(base + 24)) { { PH(); phase_finalize(F, PARTP, STATS(1)); } { PH(); phase_wconv(F, a, layer + 1); } } SEAM(); }
                if constexpr (layer == 3) { if (RUN(base + 25)) { PH(); phase_ln_final(F, (const bf16_t*)(ws + WS_XB), a->out, a->in[22] + (size_t)layer * DM, a->in[23] + (size_t)layer * DM); } }
        }
    { constexpr int layer = 1; constexpr int base = 2 + 32 * layer; constexpr bool attn = layer & 1; constexpr int j = layer >> 1; (void)j;

                if constexpr (layer == 0) { if (RUN(base + 0)) { PH(); phase_wconv(F, a, layer); } SEAM(); }
        if constexpr (!attn) {
                    if (RUN(base + 1)) { PH();
                cvt_fold(F, CSBW(layer) + 16384);
                pg8::GemmPlain g{(const bf16_t*)(ws + WS_XB), (const bf16_t*)(ws + WS_WIN), DM, DM}; pg8::StaticOrder S; S.init(MTOK, 2048, F.G, (int)blockIdx.x);
                pg8::EpiInSsm<(layer > 0)> E{(bf16_t*)(ws + WS_R1 + R1_UH), (bf16_t*)(ws + WS_R1 + R1_QM), pg8::Fold{STATS(1), CSBW(layer), CSBW(layer) + 8192}};
                pg8::gemm_phase(F.lds, F.wave, g, S, E);
            } SEAM();
        if (RUN(base + 2)) {
            { PH();
                pg8::GemmSsm g{(const bf16_t*)(ws + WS_R1 + R1_UH), (const bf16_t*)(ws + WS_SWG), 256, 512}; pg8::SsmOrder S{F.G, (int)blockIdx.x};
                pg8::EpiG1 E{(bf16_t*)(ws + WS_R1 + R1_G)};
                pg8::gemm_phase(F.lds, F.wave, g, S, E); }
            __builtin_amdgcn_fence(__ATOMIC_ACQUIRE, "agent");
            { PH(); phase_scan(F, a, j); }
            asm volatile("s_waitcnt vmcnt(0)" ::: "memory"); __syncthreads(); __builtin_amdgcn_fence(__ATOMIC_ACQUIRE, "agent");
            { PH();
                pg8::GemmSsm g{(const bf16_t*)(ws + WS_R1 + R1_UH), (const bf16_t*)(ws + WS_SWY), 512, 512}; pg8::SsmOrder S{F.G, (int)blockIdx.x};
                pg8::EpiG2 E{(bf16_t*)(ws + WS_R1 + R1_Z)};
                pg8::gemm_phase(F.lds, F.wave, g, S, E); }
        } SEAM();
            constexpr size_t ZOFF = WS_R1 + R1_Z, CCOFF = WS_R1 + R1_CONCAT;
                    if (RUN(base + 5)) {
                { PH();
                pg8::GemmPlain g{(const bf16_t*)(ws + ZOFF), (const bf16_t*)(ws + WS_WGLU), MIXW, MIXW}; pg8::StaticOrder S; S.init(MTOK, 3072, F.G, (int)blockIdx.x);
                pg8::EpiGlu E{(bf16_t*)(ws + CCOFF)};
                pg8::gemm_phase(F.lds, F.wave, g, S, E); }
                { PH(); phase_memattn_mfma(F, a, layer, (bf16_t*)(ws + CCOFF)); }
            } SEAM();
                    if (RUN(base + 6)) { PH();
                pg8::GemmPlain g{(const bf16_t*)(ws + CCOFF), (const bf16_t*)(ws + WS_WOUT), DM, DM}; pg8::StaticOrder S; S.init(MTOK, DM, F.G, (int)blockIdx.x); S.ffn = CLS_OK;
                if constexpr (layer == 0) { pg8::EpiResidB<0> E{a->in[0], a->in[1], MROWS_PROMPT, nullptr, nullptr, nullptr, (bf16_t*)(ws + WS_XB), PARTP, 0, F.lds};
                    pg8::gemm_phase(F.lds, F.wave, g, S, E); }
                else { constexpr int lp = layer > 0 ? layer - 1 : 0; pg8::EpiResidB<1> E{nullptr, nullptr, 0, STATS(1), a->in[22] + (size_t)lp * DM, a->in[23] + (size_t)lp * DM, (bf16_t*)(ws + WS_XB), PARTP, 0, F.lds};
                    pg8::gemm_phase(F.lds, F.wave, g, S, E); }
            } if (CLS_OK) GSEAM(); else SEAM();
            if (RUN(base + 7)) { PH(); if (CLS_OK) phase_finalize_cls(F, PARTP, STATS(0)); else phase_finalize(F, PARTP, STATS(0)); } if (CLS_OK) GSEAM(); else SEAM();
        } else {
                    if (RUN(base + 1)) { PH();
                cvt_fold(F, CSBW(layer) + 16384);
                pg8::GemmPlain g{(const bf16_t*)(ws + WS_XB), (const bf16_t*)(ws + WS_WIN), DM, DM}; pg8::StaticOrder S; S.init(MTOK, 3072, F.G, (int)blockIdx.x);
                pg8::EpiInAttn<true> E{ws + WS_R1, (const float*)(ws + WS_ROPE), pg8::Fold{STATS(1), CSBW(layer), CSBW(layer) + 8192}};
                pg8::gemm_phase(F.lds, F.wave, g, S, E);
            } SEAM();
                    if (RUN(base + 2)) { { PH(); phase_attn_mfma(F, a, j); } { PH(); phase_memattn_mfma(F, a, layer, (bf16_t*)(ws + WS_R1 + R1_CONCAT)); } } SEAM();
                    if (RUN(base + 6)) { PH();
                pg8::GemmPlain g{(const bf16_t*)(ws + WS_R1 + R1_CONCAT), (const bf16_t*)(ws + WS_WOUT), DM, DM}; pg8::StaticOrder S; S.init(MTOK, DM, F.G, (int)blockIdx.x); S.ffn = CLS_OK;
                constexpr int lp = layer > 0 ? layer - 1 : 0; pg8::EpiResidB<1> E{nullptr, nullptr, 0, STATS(1), a->in[22] + (size_t)lp * DM, a->in[23] + (size_t)lp * DM, (bf16_t*)(ws + WS_XB), PARTP, 0, F.lds};
                pg8::gemm_phase(F.lds, F.wave, g, S, E);
            } if (CLS_OK) GSEAM(); else SEAM();
            if (RUN(base + 7)) { PH(); if (CLS_OK) phase_finalize_cls(F, PARTP, STATS(0)); else phase_finalize(F, PARTP, STATS(0)); } if (CLS_OK) GSEAM(); else SEAM();
        }

        { constexpr int half = 0; constexpr int roff = half * (MTOK / NSPLIT);

                        if (RUN(base + 8 + 2 * half)) { PH();
                pg8::GemmPlain g{(const bf16_t*)(ws + WS_XB) + (size_t)roff * DM, (const bf16_t*)(ws + WS_WFF1), DM, DM}; pg8::StaticOrder S; S.init(MTOK / NSPLIT, DFF, F.G, (int)blockIdx.x);
                pg8::EpiSqRelu E{(bf16_t*)(ws + WS_R1 + R1_H), DFF, pg8::Fold{STATS(0) + 2 * (size_t)roff, CSBW(layer) + 16384, CSBW(layer) + 24576}};
                pg8::gemm_phase(F.lds, F.wave, g, S, E);
            } GSEAM();
                        if (RUN(base + 9 + 2 * half)) { PH();
                pg8::GemmPlain g{(const bf16_t*)(ws + WS_R1 + R1_H), (const bf16_t*)(ws + WS_WFF2), DFF, DFF}; pg8::StaticOrder S; S.init(MTOK / NSPLIT, DM, F.G, (int)blockIdx.x);
                pg8::EpiResidB<1> E{nullptr, nullptr, 0, STATS(0), a->in[18] + (size_t)layer * DM, a->in[19] + (size_t)layer * DM, (bf16_t*)(ws + WS_XB), PARTP, roff, F.lds};
                pg8::gemm_phase(F.lds, F.wave, g, S, E);
            } if constexpr (half + 1 < NSPLIT) GSEAM(); else SEAM();
                }
        { constexpr int half = 1; constexpr int roff = half * (MTOK / NSPLIT);

                        if (RUN(base + 8 + 2 * half)) { PH();
                pg8::GemmPlain g{(const bf16_t*)(ws + WS_XB) + (size_t)roff * DM, (const bf16_t*)(ws + WS_WFF1), DM, DM}; pg8::StaticOrder S; S.init(MTOK / NSPLIT, DFF, F.G, (int)blockIdx.x);
                pg8::EpiSqRelu E{(bf16_t*)(ws + WS_R1 + R1_H), DFF, pg8::Fold{STATS(0) + 2 * (size_t)roff, CSBW(layer) + 16384, CSBW(layer) + 24576}};
                pg8::gemm_phase(F.lds, F.wave, g, S, E);
            } GSEAM();
                        if (RUN(base + 9 + 2 * half)) { PH();
                pg8::GemmPlain g{(const bf16_t*)(ws + WS_R1 + R1_H), (const bf16_t*)(ws + WS_WFF2), DFF, DFF}; pg8::StaticOrder S; S.init(MTOK / NSPLIT, DM, F.G, (int)blockIdx.x);
                pg8::EpiResidB<1> E{nullptr, nullptr, 0, STATS(0), a->in[18] + (size_t)layer * DM, a->in[19] + (size_t)layer * DM, (bf16_t*)(ws + WS_XB), PARTP, roff, F.lds};
                pg8::gemm_phase(F.lds, F.wave, g, S, E);
            } if constexpr (half + 1 < NSPLIT) GSEAM(); else SEAM();
                }
            if constexpr (layer < 3) { if (RUN(base + 24)) { { PH(); phase_finalize(F, PARTP, STATS(1)); } { PH(); phase_wconv(F, a, layer + 1); } } SEAM(); }
                if constexpr (layer == 3) { if (RUN(base + 25)) { PH(); phase_ln_final(F, (const bf16_t*)(ws + WS_XB), a->out, a->in[22] + (size_t)layer * DM, a->in[23] + (size_t)layer * DM); } }
        }
    { constexpr int layer = 2; constexpr int base = 2 + 32 * layer; constexpr bool attn = layer & 1; constexpr int j = layer >> 1; (void)j;

                if constexpr (layer == 0) { if (RUN(base + 0)) { PH(); phase_wconv(F, a, layer); } SEAM(); }
        if constexpr (!attn) {
                    if (RUN(base + 1)) { PH();
                cvt_fold(F, CSBW(layer) + 16384);
                pg8::GemmPlain g{(const bf16_t*)(ws + WS_XB), (const bf16_t*)(ws + WS_WIN), DM, DM}; pg8::StaticOrder S; S.init(MTOK, 2048, F.G, (int)blockIdx.x);
                pg8::EpiInSsm<(layer > 0)> E{(bf16_t*)(ws + WS_R1 + R1_UH), (bf16_t*)(ws + WS_R1 + R1_QM), pg8::Fold{STATS(1), CSBW(layer), CSBW(layer) + 8192}};
                pg8::gemm_phase(F.lds, F.wave, g, S, E);
            } SEAM();
        if (RUN(base + 2)) {
            { PH();
                pg8::GemmSsm g{(const bf16_t*)(ws + WS_R1 + R1_UH), (const bf16_t*)(ws + WS_SWG), 256, 512}; pg8::SsmOrder S{F.G, (int)blockIdx.x};
                pg8::EpiG1 E{(bf16_t*)(ws + WS_R1 + R1_G)};
                pg8::gemm_phase(F.lds, F.wave, g, S, E); }
            __builtin_amdgcn_fence(__ATOMIC_ACQUIRE, "agent");
            { PH(); phase_scan(F, a, j); }
            asm volatile("s_waitcnt vmcnt(0)" ::: "memory"); __syncthreads(); __builtin_amdgcn_fence(__ATOMIC_ACQUIRE, "agent");
            { PH();
                pg8::GemmSsm g{(const bf16_t*)(ws + WS_R1 + R1_UH), (const bf16_t*)(ws + WS_SWY), 512, 512}; pg8::SsmOrder S{F.G, (int)blockIdx.x};
                pg8::EpiG2 E{(bf16_t*)(ws + WS_R1 + R1_Z)};
                pg8::gemm_phase(F.lds, F.wave, g, S, E); }
        } SEAM();
            constexpr size_t ZOFF = WS_R1 + R1_Z, CCOFF = WS_R1 + R1_CONCAT;
                    if (RUN(base + 5)) {
                { PH();
                pg8::GemmPlain g{(const bf16_t*)(ws + ZOFF), (const bf16_t*)(ws + WS_WGLU), MIXW, MIXW}; pg8::StaticOrder S; S.init(MTOK, 3072, F.G, (int)blockIdx.x);
                pg8::EpiGlu E{(bf16_t*)(ws + CCOFF)};
                pg8::gemm_phase(F.lds, F.wave, g, S, E); }
                { PH(); phase_memattn_mfma(F, a, layer, (bf16_t*)(ws + CCOFF)); }
            } SEAM();
                    if (RUN(base + 6)) { PH();
                pg8::GemmPlain g{(const bf16_t*)(ws + CCOFF), (const bf16_t*)(ws + WS_WOUT), DM, DM}; pg8::StaticOrder S; S.init(MTOK, DM, F.G, (int)blockIdx.x); S.ffn = CLS_OK;
                if constexpr (layer == 0) { pg8::EpiResidB<0> E{a->in[0], a->in[1], MROWS_PROMPT, nullptr, nullptr, nullptr, (bf16_t*)(ws + WS_XB), PARTP, 0, F.lds};
                    pg8::gemm_phase(F.lds, F.wave, g, S, E); }
                else { constexpr int lp = layer > 0 ? layer - 1 : 0; pg8::EpiResidB<1> E{nullptr, nullptr, 0, STATS(1), a->in[22] + (size_t)lp * DM, a->in[23] + (size_t)lp * DM, (bf16_t*)(ws + WS_XB), PARTP, 0, F.lds};
                    pg8::gemm_phase(F.lds, F.wave, g, S, E); }
            } if (CLS_OK) GSEAM(); else SEAM();
            if (RUN(base + 7)) { PH(); if (CLS_OK) phase_finalize_cls(F, PARTP, STATS(0)); else phase_finalize(F, PARTP, STATS(0)); } if (CLS_OK) GSEAM(); else SEAM();
        } else {
                    if (RUN(base + 1)) { PH();
                cvt_fold(F, CSBW(layer) + 16384);
                pg8::GemmPlain g{(const bf16_t*)(ws + WS_XB), (const bf16_t*)(ws + WS_WIN), DM, DM}; pg8::StaticOrder S; S.init(MTOK, 3072, F.G, (int)blockIdx.x);
                pg8::EpiInAttn<true> E{ws + WS_R1, (const float*)(ws + WS_ROPE), pg8::Fold{STATS(1), CSBW(layer), CSBW(layer) + 8192}};
                pg8::gemm_phase(F.lds, F.wave, g, S, E);
            } SEAM();
                    if (RUN(base + 2)) { { PH(); phase_attn_mfma(F, a, j); } { PH(); phase_memattn_mfma(F, a, layer, (bf16_t*)(ws + WS_R1 + R1_CONCAT)); } } SEAM();
                    if (RUN(base + 6)) { PH();
                pg8::GemmPlain g{(const bf16_t*)(ws + WS_R1 + R1_CONCAT), (const bf16_t*)(ws + WS_WOUT), DM, DM}; pg8::StaticOrder S; S.init(MTOK, DM, F.G, (int)blockIdx.x); S.ffn = CLS_OK;
                constexpr int lp = layer > 0 ? layer - 1 : 0; pg8::EpiResidB<1> E{nullptr, nullptr, 0, STATS(1), a->in[22] + (size_t)lp * DM, a->in[23] + (size_t)lp * DM, (bf16_t*)(ws + WS_XB), PARTP, 0, F.lds};
                pg8::gemm_phase(F.lds, F.wave, g, S, E);
            } if (CLS_OK) GSEAM(); else SEAM();
            if (RUN(base + 7)) { PH(); if (CLS_OK) phase_finalize_cls(F, PARTP, STATS(0)); else phase_finalize(F, PARTP, STATS(0)); } if (CLS_OK) GSEAM(); else SEAM();
        }

        { constexpr int half = 0; constexpr int roff = half * (MTOK / NSPLIT);

                        if (RUN(base + 8 + 2 * half)) { PH();
                pg8::GemmPlain g{(const bf16_t*)(ws + WS_XB) + (size_t)roff * DM, (const bf16_t*)(ws + WS_WFF1), DM, DM}; pg8::StaticOrder S; S.init(MTOK / NSPLIT, DFF, F.G, (int)blockIdx.x);
                pg8::EpiSqRelu E{(bf16_t*)(ws + WS_R1 + R1_H), DFF, pg8::Fold{STATS(0) + 2 * (size_t)roff, CSBW(layer) + 16384, CSBW(layer) + 24576}};
                pg8::gemm_phase(F.lds, F.wave, g, S, E);
            } GSEAM();
                        if (RUN(base + 9 + 2 * half)) { PH();
                pg8::GemmPlain g{(const bf16_t*)(ws + WS_R1 + R1_H), (const bf16_t*)(ws + WS_WFF2), DFF, DFF}; pg8::StaticOrder S; S.init(MTOK / NSPLIT, DM, F.G, (int)blockIdx.x);
                pg8::EpiResidB<1> E{nullptr, nullptr, 0, STATS(0), a->in[18] + (size_t)layer * DM, a->in[19] + (size_t)layer * DM, (bf16_t*)(ws + WS_XB), PARTP, roff, F.lds};
                pg8::gemm_phase(F.lds, F.wave, g, S, E);
            } if constexpr (half + 1 < NSPLIT) GSEAM(); else SEAM();
                }
        { constexpr int half = 1; constexpr int roff = half * (MTOK / NSPLIT);

                        if (RUN(base + 8 + 2 * half)) { PH();
                pg8::GemmPlain g{(const bf16_t*)(ws + WS_XB) + (size_t)roff * DM, (const bf16_t*)(ws + WS_WFF1), DM, DM}; pg8::StaticOrder S; S.init(MTOK / NSPLIT, DFF, F.G, (int)blockIdx.x);
                pg8::EpiSqRelu E{(bf16_t*)(ws + WS_R1 + R1_H), DFF, pg8::Fold{STATS(0) + 2 * (size_t)roff, CSBW(layer) + 16384, CSBW(layer) + 24576}};
                pg8::gemm_phase(F.lds, F.wave, g, S, E);
            } GSEAM();
                        if (RUN(base + 9 + 2 * half)) { PH();
                pg8::GemmPlain g{(const bf16_t*)(ws + WS_R1 + R1_H), (const bf16_t*)(ws + WS_WFF2), DFF, DFF}; pg8::StaticOrder S; S.init(MTOK / NSPLIT, DM, F.G, (int)blockIdx.x);
                pg8::EpiResidB<1> E{nullptr, nullptr, 0, STATS(0), a->in[18] + (size_t)layer * DM, a->in[19] + (size_t)layer * DM, (bf16_t*)(ws + WS_XB), PARTP, roff, F.lds};
                pg8::gemm_phase(F.lds, F.wave, g, S, E);
            } if constexpr (half + 1 < NSPLIT) GSEAM(); else SEAM();
                }
            if constexpr (layer < 3) { if (RUN(base + 24)) { { PH(); phase_finalize(F, PARTP, STATS(1)); } { PH(); phase_wconv(F, a, layer + 1); } } SEAM(); }
                if constexpr (layer == 3) { if (RUN(base + 25)) { PH(); phase_ln_final(F, (const bf16_t*)(ws + WS_XB), a->out, a->in[22] + (size_t)layer * DM, a->in[23] + (size_t)layer * DM); } }
        }
    { constexpr int layer = 3; constexpr int base = 2 + 32 * layer; constexpr bool attn = layer & 1; constexpr int j = layer >> 1; (void)j;

                if constexpr (layer == 0) { if (RUN(base + 0)) { PH(); phase_wconv(F, a, layer); } SEAM(); }
        if constexpr (!attn) {
                    if (RUN(base + 1)) { PH();
                cvt_fold(F, CSBW(layer) + 16384);
                pg8::GemmPlain g{(const bf16_t*)(ws + WS_XB), (const bf16_t*)(ws + WS_WIN), DM, DM}; pg8::StaticOrder S; S.init(MTOK, 2048, F.G, (int)blockIdx.x);
                pg8::EpiInSsm<(layer > 0)> E{(bf16_t*)(ws + WS_R1 + R1_UH), (bf16_t*)(ws + WS_R1 + R1_QM), pg8::Fold{STATS(1), CSBW(layer), CSBW(layer) + 8192}};
                pg8::gemm_phase(F.lds, F.wave, g, S, E);
            } SEAM();
        if (RUN(base + 2)) {
            { PH();
                pg8::GemmSsm g{(const bf16_t*)(ws + WS_R1 + R1_UH), (const bf16_t*)(ws + WS_SWG), 256, 512}; pg8::SsmOrder S{F.G, (int)blockIdx.x};
                pg8::EpiG1 E{(bf16_t*)(ws + WS_R1 + R1_G)};
                pg8::gemm_phase(F.lds, F.wave, g, S, E); }
            __builtin_amdgcn_fence(__ATOMIC_ACQUIRE, "agent");
            { PH(); phase_scan(F, a, j); }
            asm volatile("s_waitcnt vmcnt(0)" ::: "memory"); __syncthreads(); __builtin_amdgcn_fence(__ATOMIC_ACQUIRE, "agent");
            { PH();
                pg8::GemmSsm g{(const bf16_t*)(ws + WS_R1 + R1_UH), (const bf16_t*)(ws + WS_SWY), 512, 512}; pg8::SsmOrder S{F.G, (int)blockIdx.x};
                pg8::EpiG2 E{(bf16_t*)(ws + WS_R1 + R1_Z)};
                pg8::gemm_phase(F.lds, F.wave, g, S, E); }
        } SEAM();
            constexpr size_t ZOFF = WS_R1 + R1_Z, CCOFF = WS_R1 + R1_CONCAT;
                    if (RUN(base + 5)) {
                { PH();
                pg8::GemmPlain g{(const bf16_t*)(ws + ZOFF), (const bf16_t*)(ws + WS_WGLU), MIXW, MIXW}; pg8::StaticOrder S; S.init(MTOK, 3072, F.G, (int)blockIdx.x);
                pg8::EpiGlu E{(bf16_t*)(ws + CCOFF)};
                pg8::gemm_phase(F.lds, F.wave, g, S, E); }
                { PH(); phase_memattn_mfma(F, a, layer, (bf16_t*)(ws + CCOFF)); }
            } SEAM();
                    if (RUN(base + 6)) { PH();
                pg8::GemmPlain g{(const bf16_t*)(ws + CCOFF), (const bf16_t*)(ws + WS_WOUT), DM, DM}; pg8::StaticOrder S; S.init(MTOK, DM, F.G, (int)blockIdx.x); S.ffn = CLS_OK;
                if constexpr (layer == 0) { pg8::EpiResidB<0> E{a->in[0], a->in[1], MROWS_PROMPT, nullptr, nullptr, nullptr, (bf16_t*)(ws + WS_XB), PARTP, 0, F.lds};
                    pg8::gemm_phase(F.lds, F.wave, g, S, E); }
                else { constexpr int lp = layer > 0 ? layer - 1 : 0; pg8::EpiResidB<1> E{nullptr, nullptr, 0, STATS(1), a->in[22] + (size_t)lp * DM, a->in[23] + (size_t)lp * DM, (bf16_t*)(ws + WS_XB), PARTP, 0, F.lds};
                    pg8::gemm_phase(F.lds, F.wave, g, S, E); }
            } if (CLS_OK) GSEAM(); else SEAM();
            if (RUN(base + 7)) { PH(); if (CLS_OK) phase_finalize_cls(F, PARTP, STATS(0)); else phase_finalize(F, PARTP, STATS(0)); } if (CLS_OK) GSEAM(); else SEAM();
        } else {
                    if (RUN(base + 1)) { PH();
                cvt_fold(F, CSBW(layer) + 16384);
                pg8::GemmPlain g{(const bf16_t*)(ws + WS_XB), (const bf16_t*)(ws + WS_WIN), DM, DM}; pg8::StaticOrder S; S.init(MTOK, 3072, F.G, (int)blockIdx.x);
                pg8::EpiInAttn<true> E{ws + WS_R1, (const float*)(ws + WS_ROPE), pg8::Fold{STATS(1), CSBW(layer), CSBW(layer) + 8192}};
                pg8::gemm_phase(F.lds, F.wave, g, S, E);
            } SEAM();
                    if (RUN(base + 2)) { { PH(); phase_attn_mfma(F, a, j); } { PH(); phase_memattn_mfma(F, a, layer, (bf16_t*)(ws + WS_R1 + R1_CONCAT)); } } SEAM();
                    if (RUN(base + 6)) { PH();
                pg8::GemmPlain g{(const bf16_t*)(ws + WS_R1 + R1_CONCAT), (const bf16_t*)(ws + WS_WOUT), DM, DM}; pg8::StaticOrder S; S.init(MTOK, DM, F.G, (int)blockIdx.x); S.ffn = CLS_OK;
                constexpr int lp = layer > 0 ? layer - 1 : 0; pg8::EpiResidB<1> E{nullptr, nullptr, 0, STATS(1), a->in[22] + (size_t)lp * DM, a->in[23] + (size_t)lp * DM, (bf16_t*)(ws + WS_XB), PARTP, 0, F.lds};
                pg8::gemm_phase(F.lds, F.wave, g, S, E);
            } if (CLS_OK) GSEAM(); else SEAM();
            if (RUN(base + 7)) { PH(); if (CLS_OK) phase_finalize_cls(F, PARTP, STATS(0)); else phase_finalize(F, PARTP, STATS(0)); } if (CLS_OK) GSEAM(); else SEAM();
        }

        { constexpr int half = 0; constexpr int roff = half * (MTOK / NSPLIT);

                        if (RUN(base + 8 + 2 * half)) { PH();
                pg8::GemmPlain g{(const bf16_t*)(ws + WS_XB) + (size_t)roff * DM, (const bf16_t*)(ws + WS_WFF1), DM, DM}; pg8::StaticOrder S; S.init(MTOK / NSPLIT, DFF, F.G, (int)blockIdx.x);
                pg8::EpiSqRelu E{(bf16_t*)(ws + WS_R1 + R1_H), DFF, pg8::Fold{STATS(0) + 2 * (size_t)roff, CSBW(layer) + 16384, CSBW(layer) + 24576}};
                pg8::gemm_phase(F.lds, F.wave, g, S, E);
            } GSEAM();
                        if (RUN(base + 9 + 2 * half)) { PH();
                pg8::GemmPlain g{(const bf16_t*)(ws + WS_R1 + R1_H), (const bf16_t*)(ws + WS_WFF2), DFF, DFF}; pg8::StaticOrder S; S.init(MTOK / NSPLIT, DM, F.G, (int)blockIdx.x);
                pg8::EpiResidB<1> E{nullptr, nullptr, 0, STATS(0), a->in[18] + (size_t)layer * DM, a->in[19] + (size_t)layer * DM, (bf16_t*)(ws + WS_XB), PARTP, roff, F.lds};
                pg8::gemm_phase(F.lds, F.wave, g, S, E);
            } if constexpr (half + 1 < NSPLIT) GSEAM(); else SEAM();
                }
        { constexpr int half = 1; constexpr int roff = half * (MTOK / NSPLIT);

                        if (RUN(base + 8 + 2 * half)) { PH();
                pg8::GemmPlain g{(const bf16_t*)(ws + WS_XB) + (size_t)roff * DM, (const bf16_t*)(ws + WS_WFF1), DM, DM}; pg8::StaticOrder S; S.init(MTOK / NSPLIT, DFF, F.G, (int)blockIdx.x);
                pg8::EpiSqRelu E{(bf16_t*)(ws + WS_R1 + R1_H), DFF, pg8::Fold{STATS(0) + 2 * (size_t)roff, CSBW(layer) + 16384, CSBW(layer) + 24576}};
                pg8::gemm_phase(F.lds, F.wave, g, S, E);
            } GSEAM();
                        if (RUN(base + 9 + 2 * half)) { PH();
                pg8::GemmPlain g{(const bf16_t*)(ws + WS_R1 + R1_H), (const bf16_t*)(ws + WS_WFF2), DFF, DFF}; pg8::StaticOrder S; S.init(MTOK / NSPLIT, DM, F.G, (int)blockIdx.x);
                pg8::EpiResidB<1> E{nullptr, nullptr, 0, STATS(0), a->in[18] + (size_t)layer * DM, a->in[19] + (size_t)layer * DM, (bf16_t*)(ws + WS_XB), PARTP, roff, F.lds};
                pg8::gemm_phase(F.lds, F.wave, g, S, E);
            } if constexpr (half + 1 < NSPLIT) GSEAM(); else SEAM();
                }
            if constexpr (layer < 3) { if (RUN(base + 24)) { { PH(); phase_finalize(F, PARTP, STATS(1)); } { PH(); phase_wconv(F, a, layer + 1); } } SEAM(); }
                if constexpr (layer == 3) { if (RUN(base + 25)) { PH(); phase_ln_final(F, (const bf16_t*)(ws + WS_XB), a->out, a->in[22] + (size_t)layer * DM, a->in[23] + (size_t)layer * DM); } }
        }
#undef RUN
#undef SEAM
#undef PH
}

extern "C" void kernel_launch(void* const* d_in, const int* in_sizes, int n_in, void* d_out, int out_size, void* d_ws, size_t ws_size, hipStream_t stream) {
    static int grid = 0;
    if (grid == 0) {
        if (n_in != 24 || out_size != MTOK * DM || ws_size < WS_END) { fprintf(stderr, "kernel_launch: unexpected shapes: n_in %d out %d ws %zu (need %zu)\n", n_in, out_size, ws_size, (size_t)WS_END); grid = -1; return; }
        int dev = 0, cus = 0;
        if (hipGetDevice(&dev) != hipSuccess || hipDeviceGetAttribute(&cus, hipDeviceAttributeMultiprocessorCount, dev) != hipSuccess) { grid = -1; return; }
        if (hipFuncSetAttribute((const void*)mk_fwd, hipFuncAttributeMaxDynamicSharedMemorySize, LDS_BYTES) != hipSuccess) { fprintf(stderr, "kernel_launch: hipFuncSetAttribute failed\n"); grid = -1; return; }
        int per_cu = 0;
        if (hipOccupancyMaxActiveBlocksPerMultiprocessor(&per_cu, (const void*)mk_fwd, NWAVES * 64, LDS_BYTES) != hipSuccess || per_cu < 1) fprintf(stderr, "kernel_launch: occupancy query says %d\n", per_cu);
        (void)hipGetLastError();
        grid = cus;
    }
    if (grid < 0) return;
    (void)hipMemsetAsync((char*)d_ws + WS_CTL, 0, CTL_ZERO_BYTES, stream);
    Args a{};
    for (int i = 0; i < 24; ++i) a.in[i] = (const float*)d_in[i];
    a.out = (float*)d_out; a.ws = (unsigned char*)d_ws;
#if MK_MULTI
    for (int id = 0; id < 2 + 32 * 4; ++id) { a.lin_lo = id; a.lin_hi = id + 1; hipLaunchKernelGGL(mk_fwd, dim3(grid), dim3(NWAVES * 64), LDS_BYTES, stream, a); }
#else
    a.lin_lo = 0; a.lin_hi = 1 << 20;
    hipLaunchKernelGGL(mk_fwd, dim3(grid), dim3(NWAVES * 64), LDS_BYTES, stream, a);
#endif
    const hipError_t le = hipPeekAtLastError();
    if (le != hipSuccess) fprintf(stderr, "kernel_launch: launch failed: %s\n", hipGetErrorName(le));
}
```
